# Optimizing an MI355X kernel written in HIP

```python
import jax, jax.numpy as jnp
from jax import lax
import numpy as np

D_MODEL = 1024
BATCH = 4
SEQ = 8192
DEPTH = 2

CHUNK = 64
D_MIX = 1024
M_HEADS = 4
M_HEAD_DIM = 128
M_WIDTH = M_HEADS * M_HEAD_DIM
CONV_W = 4
G_GROUPS = 4
G_GROUP_CH = 128
G_WIDTH = G_GROUPS * G_GROUP_CH
G_BLOCK = 128
D_IN = 2 * M_WIDTH + 2 * G_WIDTH
D_FF = 2752
N_EXPERTS = 8
TOP_K = 2
D_FF_EXPERT = 3584
N_DENSE = (DEPTH + 1) // 2
N_MOE = DEPTH // 2
EPS = 1e-6

kernel_name = "hybrid_mlstm_gmlp_moe_trunk"


def rmsnorm(x, g):
    xf = x.astype(jnp.float32)
    y = xf * lax.rsqrt(jnp.mean(xf * xf, axis=-1, keepdims=True) + EPS)
    return (y * g.astype(jnp.float32)).astype(x.dtype)


def layernorm_f32(xf, g):
    mu = jnp.mean(xf, axis=-1, keepdims=True)
    var = jnp.mean(jnp.square(xf - mu), axis=-1, keepdims=True)
    return (xf - mu) * lax.rsqrt(var + EPS) * g.astype(jnp.float32)


def causal_depthwise_conv(x, w, b):
    y = lax.conv_general_dilated(
        x, w[:, None, :].astype(x.dtype), window_strides=(1,),
        padding=[(w.shape[0] - 1, 0)],
        dimension_numbers=("NWC", "WIO", "NWC"),
        feature_group_count=x.shape[-1])
    return y + b.astype(x.dtype)


def mlstm_chunkwise(q, k, v, ig, lf):
    B, S, H, dh = q.shape
    nc = S // CHUNK

    def to_chunks(a):
        a = a.reshape((B, nc, CHUNK, H) + a.shape[3:])
        return jnp.moveaxis(jnp.moveaxis(a, 1, 0), 3, 2)

    tril = jnp.tril(jnp.ones((CHUNK, CHUNK), dtype=bool))

    def step(carry, xs):
        C, n, m = carry
        qc, kc, vc, igc, lfc = xs
        b = jnp.cumsum(lfc, axis=-1)
        d = b[..., :, None] - b[..., None, :] + igc[..., None, :]
        d = jnp.where(tril, d, -jnp.inf)
        inter = b + m[..., None]
        m_t = jnp.maximum(inter, jnp.max(d, axis=-1))
        w = jnp.exp(d - m_t[..., None])
        a = jnp.exp(inter - m_t)
        s = jnp.einsum("bhtk,bhsk->bhts", qc, kc) * w
        num = (a[..., None] * jnp.einsum("bhvk,bhtk->bhtv", C, qc)
               + jnp.einsum("bhts,bhsv->bhtv", s, vc))
        den = a * jnp.einsum("bhk,bhtk->bht", n, qc) + jnp.sum(s, axis=-1)
        den = jnp.maximum(jnp.abs(den), jnp.exp(-m_t))
        h = num / den[..., None]
        b_end = b[..., -1]
        log_prev = b_end + m
        log_s = b_end[..., None] - b + igc
        m_new = jnp.maximum(log_prev, jnp.max(log_s, axis=-1))
        a_prev = jnp.exp(log_prev - m_new)
        w_s = jnp.exp(log_s - m_new[..., None])
        C_new = a_prev[..., None, None] * C + jnp.einsum("bhs,bhsv,bhsk->bhvk", w_s, vc, kc)
        n_new = a_prev[..., None] * n + jnp.einsum("bhs,bhsk->bhk", w_s, kc)
        return (C_new, n_new, m_new), h

    init = (jnp.zeros((B, H, dh, dh), jnp.float32),
            jnp.zeros((B, H, dh), jnp.float32),
            jnp.zeros((B, H), jnp.float32))
    xs = (to_chunks(q), to_chunks(k), to_chunks(v), to_chunks(ig), to_chunks(lf))
    _, hs = lax.scan(step, init, xs)
    return jnp.transpose(hs, (1, 0, 3, 2, 4)).reshape(B, S, H, dh)


def hybrid_mixer(h, w_in, conv_w, conv_b, w_q, w_k, w_v, w_if, b_if, skip_m,
                 mh_norm_g, gm_v_g, w_sp, b_sp, gm_out_g, w_out):
    B, S, _ = h.shape
    proj = h @ w_in.astype(h.dtype)
    x_m, o_pre, u, v = jnp.split(proj, [M_WIDTH, 2 * M_WIDTH, 2 * M_WIDTH + G_WIDTH], axis=-1)

    x_c = jax.nn.silu(causal_depthwise_conv(x_m, conv_w, conv_b))
    xc_h = x_c.reshape(B, S, M_HEADS, M_HEAD_DIM)
    xm_h = x_m.reshape(B, S, M_HEADS, M_HEAD_DIM)
    q = jnp.einsum("bshd,hde->bshe", xc_h, w_q.astype(h.dtype))
    k = jnp.einsum("bshd,hde->bshe", xc_h, w_k.astype(h.dtype))
    vm = jnp.einsum("bshd,hde->bshe", xm_h, w_v.astype(h.dtype))
    qkv = jnp.concatenate([q.reshape(B, S, -1), k.reshape(B, S, -1), vm.reshape(B, S, -1)], axis=-1)
    gates = (qkv @ w_if.astype(h.dtype) + b_if.astype(h.dtype)).astype(jnp.float32)
    ig = gates[..., :M_HEADS]
    lf = jax.nn.log_sigmoid(gates[..., M_HEADS:])
    hm = mlstm_chunkwise((q * (M_HEAD_DIM ** -0.5)).astype(jnp.float32),
                         k.astype(jnp.float32), vm.astype(jnp.float32), ig, lf)
    o = jax.nn.sigmoid(o_pre.astype(jnp.float32)).reshape(B, S, M_HEADS, M_HEAD_DIM)
    hm = o * hm
    mu = jnp.mean(hm, axis=-1, keepdims=True)
    var = jnp.mean(jnp.square(hm - mu), axis=-1, keepdims=True)
    hm = ((hm - mu) * lax.rsqrt(var + EPS)).reshape(B, S, M_WIDTH)
    y_m = (hm * mh_norm_g.astype(jnp.float32)
           + skip_m.astype(jnp.float32) * x_c.astype(jnp.float32)).astype(h.dtype)

    u = jax.nn.gelu(u)
    vg = layernorm_f32(jax.nn.gelu(v).astype(jnp.float32), gm_v_g)
    vb = vg.reshape(B, S // G_BLOCK, G_BLOCK, G_GROUPS, G_GROUP_CH)
    pos = jnp.arange(G_BLOCK)
    chunk_mask = (pos[:, None] // CHUNK) >= (pos[None, :] // CHUNK)
    ws = jnp.where(chunk_mask[None], w_sp.astype(jnp.float32), 0.0)
    sv = jnp.einsum("gij,bnjgc->bnigc", ws, vb) + b_sp.astype(jnp.float32).T[:, :, None]
    y_g = u.astype(jnp.float32) * sv.reshape(B, S, G_WIDTH)
    y_g = rmsnorm(y_g, gm_out_g).astype(h.dtype)

    y = jnp.concatenate([y_m, y_g], axis=-1)
    return y @ w_out.astype(h.dtype)


def swiglu(t, w1, w3, w2):
    return (jax.nn.silu(t @ w1.astype(t.dtype)) * (t @ w3.astype(t.dtype))) @ w2.astype(t.dtype)


def moe_ffn(h, w_router, w1, w3, w2):
    B, S, D = h.shape
    t = h.reshape(-1, D)
    logits = (t @ w_router.astype(t.dtype)).astype(jnp.float32)
    top_v, top_i = lax.top_k(logits, TOP_K)
    gate = jax.nn.softmax(top_v, axis=-1)
    combine = jnp.sum(jax.nn.one_hot(top_i, N_EXPERTS, dtype=jnp.float32) * gate[..., None], axis=1)
    out = jnp.zeros_like(t)
    for e in range(N_EXPERTS):
        out = out + combine[:, e:e + 1].astype(t.dtype) * swiglu(t, w1[e], w3[e], w2[e])
    return out.reshape(B, S, D)


def setup_inputs(seed: int = 0) -> dict:
    key = jax.random.key(seed)
    ks = jax.random.split(key, 32)
    f32 = jnp.float32

    def nrm(k, shape, scale):
        return jax.random.normal(k, shape, f32) * scale

    def gain(k, shape):
        return 1.0 + 0.02 * jax.random.normal(k, shape, f32)

    b_i = 0.1 * jax.random.normal(ks[9], (DEPTH, M_HEADS), f32)
    b_f = jnp.linspace(3.0, 6.0, M_HEADS, dtype=f32)[None, :] + 0.1 * jax.random.normal(ks[10], (DEPTH, M_HEADS), f32)
    return {
        "x": nrm(ks[0], (BATCH, SEQ, D_MODEL), 1.0),
        "mix_norm_g": gain(ks[1], (DEPTH, D_MODEL)),
        "w_in": nrm(ks[2], (DEPTH, D_MODEL, D_IN), D_MODEL ** -0.5),
        "conv_w": nrm(ks[3], (DEPTH, CONV_W, M_WIDTH), CONV_W ** -0.5),
        "conv_b": nrm(ks[4], (DEPTH, M_WIDTH), 0.02),
        "w_q": nrm(ks[5], (DEPTH, M_HEADS, M_HEAD_DIM, M_HEAD_DIM), M_HEAD_DIM ** -0.5),
        "w_k": nrm(ks[6], (DEPTH, M_HEADS, M_HEAD_DIM, M_HEAD_DIM), M_HEAD_DIM ** -0.5),
        "w_v": nrm(ks[7], (DEPTH, M_HEADS, M_HEAD_DIM, M_HEAD_DIM), M_HEAD_DIM ** -0.5),
        "w_if": nrm(ks[8], (DEPTH, 3 * M_WIDTH, 2 * M_HEADS), 0.5 * (3 * M_WIDTH) ** -0.5),
        "b_if": jnp.concatenate([b_i, b_f], axis=-1),
        "skip_m": gain(ks[11], (DEPTH, M_WIDTH)),
        "mh_norm_g": gain(ks[12], (DEPTH, M_WIDTH)),
        "gm_v_g": gain(ks[13], (DEPTH, G_WIDTH)),
        "w_sp": nrm(ks[14], (DEPTH, G_GROUPS, G_BLOCK, G_BLOCK), 0.5 * G_BLOCK ** -0.5),
        "b_sp": gain(ks[15], (DEPTH, G_GROUPS, G_BLOCK)),
        "gm_out_g": gain(ks[16], (DEPTH, G_WIDTH)),
        "w_out": nrm(ks[17], (DEPTH, D_MIX, D_MODEL), D_MIX ** -0.5),
        "ffn_norm_g": gain(ks[18], (DEPTH, D_MODEL)),
        "dense_w1": nrm(ks[19], (N_DENSE, D_MODEL, D_FF), D_MODEL ** -0.5),
        "dense_w3": nrm(ks[20], (N_DENSE, D_MODEL, D_FF), D_MODEL ** -0.5),
        "dense_w2": nrm(ks[21], (N_DENSE, D_FF, D_MODEL), D_FF ** -0.5),
        "moe_router": nrm(ks[22], (N_MOE, D_MODEL, N_EXPERTS), D_MODEL ** -0.5),
        "moe_w1": nrm(ks[23], (N_MOE, N_EXPERTS, D_MODEL, D_FF_EXPERT), D_MODEL ** -0.5),
        "moe_w3": nrm(ks[24], (N_MOE, N_EXPERTS, D_MODEL, D_FF_EXPERT), D_MODEL ** -0.5),
        "moe_w2": nrm(ks[25], (N_MOE, N_EXPERTS, D_FF_EXPERT, D_MODEL), D_FF_EXPERT ** -0.5),
        "final_norm_g": gain(ks[26], (D_MODEL,)),
    }


def reference(x, mix_norm_g, w_in, conv_w, conv_b, w_q, w_k, w_v, w_if, b_if, skip_m,
              mh_norm_g, gm_v_g, w_sp, b_sp, gm_out_g, w_out, ffn_norm_g,
              dense_w1, dense_w3, dense_w2, moe_router, moe_w1, moe_w3, moe_w2,
              final_norm_g):
    for l in range(DEPTH):
        h = rmsnorm(x, mix_norm_g[l])
        x = x + hybrid_mixer(h, w_in[l], conv_w[l], conv_b[l], w_q[l], w_k[l], w_v[l],
                             w_if[l], b_if[l], skip_m[l], mh_norm_g[l], gm_v_g[l],
                             w_sp[l], b_sp[l], gm_out_g[l], w_out[l])
        h = rmsnorm(x, ffn_norm_g[l])
        if l % 2 == 0:
            i = l // 2
            x = x + swiglu(h, dense_w1[i], dense_w3[i], dense_w2[i])
        else:
            i = l // 2
            x = x + moe_ffn(h, moe_router[i], moe_w1[i], moe_w3[i], moe_w2[i])
    return rmsnorm(x, final_norm_g)
```

```cpp
#include <hip/hip_runtime.h>
#include <cstdio>
#include <cstdint>

#define LAS __attribute__((address_space(3)))
#define GAS __attribute__((address_space(1)))
typedef unsigned short bf16;
typedef short bf16x8 __attribute__((ext_vector_type(8)));
typedef short s16x4 __attribute__((ext_vector_type(4)));
typedef float f32x4 __attribute__((ext_vector_type(4)));
typedef float f32x2 __attribute__((ext_vector_type(2)));
typedef unsigned u32x4 __attribute__((ext_vector_type(4)));
typedef unsigned u32x2 __attribute__((ext_vector_type(2)));
typedef int i32x4 __attribute__((ext_vector_type(4)));
#define DI __device__ __forceinline__

constexpr int NB = 4, SEQ = 8192, T = NB * SEQ, D = 1024, DIN = 2048;
constexpr int CH = 64, NCH = SEQ / CH;
constexpr int NU = T / CH;
constexpr int DFF = 2752, DFFP = 2816;
constexpr int NE = 8, DFE = 3584;
constexpr int MAXRT = 136;
constexpr float EPS = 1e-6f;

constexpr size_t MiB = 1u << 20;
constexpr size_t WS_CTL = 0, CTL_ZERO_BYTES = 1 * MiB;
constexpr size_t WS_SSQ = 1 * MiB;
constexpr size_t WS_VST = 1 * MiB + 512 * 1024;
constexpr size_t WS_WG = 3 * MiB + 512 * 1024;
constexpr size_t WS_WQ = WS_WG + 64 * 1024;
constexpr size_t WS_WSP = WS_WQ + 3 * 256 * 1024;
constexpr size_t WS_GB = 5 * MiB;
constexpr size_t WS_SC = 6 * MiB;
constexpr size_t WS_MP = WS_SC + 64 * 1024;
constexpr size_t WS_TOPI = 6 * MiB + 256 * 1024;
constexpr size_t WS_TOPG = WS_TOPI + 256 * 1024;
constexpr size_t WS_CNT = WS_TOPG + 256 * 1024;
constexpr size_t WS_ROWTOK = 7 * MiB;
constexpr size_t WS_ROWGATE = WS_ROWTOK + 512 * 1024;
constexpr size_t WS_TILE = WS_ROWGATE + 512 * 1024 - 4096;
constexpr size_t WS_WIN = 8 * MiB;
constexpr size_t WS_WOUT = 16 * MiB;
constexpr size_t WS_W13 = 20 * MiB;
constexpr size_t WS_W2 = 31 * MiB;
constexpr size_t WS_XB = 40 * MiB;
constexpr size_t WS_BIG = 104 * MiB;
constexpr size_t WS_PROJ = WS_BIG;
constexpr size_t WS_QG = WS_BIG + 128 * MiB;
constexpr size_t WS_KG = WS_BIG + 160 * MiB;
constexpr size_t WS_VG = WS_BIG + 192 * MiB;
constexpr size_t WS_ST = WS_BIG + 224 * MiB;
constexpr size_t WS_Y = WS_BIG + 296 * MiB;
constexpr size_t WS_XCG = WS_BIG + 360 * MiB;
constexpr size_t WS_HID = WS_BIG;
constexpr size_t WS_MW13 = WS_BIG;
constexpr size_t WS_XR8 = WS_BIG + 64 * MiB;
constexpr size_t WS_MW2 = WS_BIG + 112 * MiB;
constexpr size_t WS_MHID = WS_BIG + 168 * MiB;
constexpr size_t WS_END = WS_BIG + 408 * MiB;
static_assert(WS_MHID + (size_t)MAXRT * 256 * DFE * 2 <= WS_END && WS_Y + (size_t)T * D * 2 <= WS_END, "ws map");
constexpr int CW_BAR = 4096;
constexpr size_t WS_SWD = WS_CTL + 496 * 1024;
constexpr size_t WS_XB8D = WS_BIG + 200 * MiB;
constexpr size_t WS_SW13 = WS_CTL + 256 * 1024;
constexpr size_t WS_ROWSA = WS_GB;
constexpr size_t WS_SA = WS_GB + 512 * 1024;
constexpr int CW_HID = 16384;

constexpr int RING_BYTES = 131072;
constexpr int MISC_OFF = RING_BYTES + 12288;
constexpr int LDS_BYTES = 147456;

typedef __bf16 bf16x2_t __attribute__((ext_vector_type(2)));
DI unsigned pk2(float lo, float hi) { const f32x2 v = {lo, hi}; return __builtin_bit_cast(unsigned, __builtin_convertvector(v, bf16x2_t)); }
DI unsigned f2bf(float f) { return pk2(f, f) & 0xffffu; }
DI float bf2f(unsigned b) { return __builtin_bit_cast(float, b << 16); }
DI float bflo(unsigned w) { return __builtin_bit_cast(float, w << 16); }
DI float bfhi(unsigned w) { return __builtin_bit_cast(float, w & 0xffff0000u); }
DI float fexp(float x) { return __builtin_amdgcn_exp2f(x * 1.44269504089f); }
DI float softplus_neg(float a) { return __builtin_amdgcn_logf(1.0f + __builtin_amdgcn_exp2f(-1.44269504089f * a)) * 0.69314718056f; }
DI float sigmoidf(float x) { return __builtin_amdgcn_rcpf(1.0f + fexp(-x)); }
DI float siluf(float x) { return x * sigmoidf(x); }
DI float geluf(float x) { return x * sigmoidf(1.59576912161f * (x + 0.044715f * x * x * x)); }
DI float dpp_f(float v, const int ctrl_sel) {
    const int x = __builtin_bit_cast(int, v); int r;
    if (ctrl_sel == 0) r = __builtin_amdgcn_update_dpp(x, x, 0xB1, 0xF, 0xF, false);
    else if (ctrl_sel == 1) r = __builtin_amdgcn_update_dpp(x, x, 0x4E, 0xF, 0xF, false);
    else if (ctrl_sel == 2) r = __builtin_amdgcn_update_dpp(x, x, 0x141, 0xF, 0xF, false);
    else r = __builtin_amdgcn_update_dpp(x, x, 0x140, 0xF, 0xF, false);
    return __builtin_bit_cast(float, r);
}
DI float rl_f(float v, int l) { return __builtin_bit_cast(float, __builtin_amdgcn_readlane(__builtin_bit_cast(int, v), l)); }
DI float wave_sum(float v) {
    v += dpp_f(v, 0); v += dpp_f(v, 1); v += dpp_f(v, 2); v += dpp_f(v, 3);
    return (rl_f(v, 0) + rl_f(v, 16)) + (rl_f(v, 32) + rl_f(v, 48));
}
DI float wave_max(float v) {
    v = fmaxf(v, dpp_f(v, 0)); v = fmaxf(v, dpp_f(v, 1)); v = fmaxf(v, dpp_f(v, 2)); v = fmaxf(v, dpp_f(v, 3));
    return fmaxf(fmaxf(rl_f(v, 0), rl_f(v, 16)), fmaxf(rl_f(v, 32), rl_f(v, 48)));
}
#define MFMA16(a, b, c) __builtin_amdgcn_mfma_f32_16x16x32_bf16((a), (b), (c), 0, 0, 0)
#define LDS_WAIT() asm volatile("s_waitcnt lgkmcnt(0)" ::: "memory")
#define LBAR() do { asm volatile("s_waitcnt lgkmcnt(0)" ::: "memory"); __builtin_amdgcn_s_barrier(); asm volatile("" ::: "memory"); } while (0)
#define VM_WAIT() asm volatile("s_waitcnt vmcnt(0)" ::: "memory")

DI int lane_asm() { int l; asm volatile("v_mbcnt_lo_u32_b32 %0, -1, 0\n\tv_mbcnt_hi_u32_b32 %0, -1, %0" : "=v"(l)); return l; }
namespace pg8 {
constexpr int BM = 256, BK = 64, HALF = 128, HTB = HALF * BK * 2, STAGE_BYTES = 8 * HTB, NXCD = 8, WGM = 8;
__host__ __device__ __forceinline__ int lds_byte(int r, int c) { const int st = (r >> 4) * 2 + (c >> 5), rr = r & 15, cc = c & 31, ob = rr * 64 + cc * 2; return st * 1024 + (ob ^ (((ob >> 9) & 1) << 5)); }
__host__ __device__ __forceinline__ void stage_rc(int b, int& R, int& C) { const int st = b / 1024, sb = b % 1024, swz = sb ^ (((sb >> 9) & 1) << 5); R = (st >> 1) * 16 + swz / 64; C = (st & 1) * 32 + (swz % 64) / 2; }
__host__ __device__ __forceinline__ int perm32(int rho) { const int n = rho >> 4, i = rho & 15; return 8 * (i >> 2) + 4 * n + (i & 3); }

struct Unit { int pm, pn, e, ph; };
struct Gemm { const bf16* A; const bf16* Bt; int K; size_t estride; const int* rowtok; };

DI void tile_of(int wgid, int nM, int nN, int& pm, int& pn) {
    const int nwg = nM * nN;
    { const int q = nwg / NXCD, r = nwg % NXCD, xcd = wgid % NXCD, off = wgid / NXCD; wgid = (xcd < r ? xcd * (q + 1) : r * (q + 1) + (xcd - r) * q) + off; }
    const int nig = WGM * nN, gid = wgid / nig, fm = gid * WGM, gsz = (nM - fm) < WGM ? (nM - fm) : WGM;
    pm = fm + ((wgid % nig) % gsz); pn = (wgid % nig) / gsz;
}
struct StaticOrder {
    int nM, nN, nwg, G, c;
    DI void init(int M, int N, int G_, int c_) { nM = M / BM; nN = N / BM; nwg = nM * nN; G = G_; c = c_; }
    DI bool next(int i, Unit& u) const {
        const long L = (long)i * G + c; if (L >= nwg) return false;
        tile_of((int)L, nM, nN, u.pm, u.pn); u.e = 0; u.ph = u.pm; return true;
    }
};
struct MoeOrder {
    const int* tile; int first, hid0, nM, nN, W, j, cnt, base, ex, SK;
    DI void init(const int* tile_, int first_, int nM_, int hid0_, int N, int G, int c, int prev_units, int SK_) {
        tile = tile_; first = first_; hid0 = hid0_; nM = nM_; nN = N / BM; SK = SK_;
        const int nwg = nM * nN; int x, nx;
        if (G % NXCD == 0) { x = c % NXCD; j = c / NXCD; W = G / NXCD; nx = NXCD; } else { x = 0; j = c; W = G; nx = 1; }
        const int q = nwg / nx, r = nwg % nx; cnt = q + (x < r ? 1 : 0); base = (x < r) ? x * (q + 1) : r * (q + 1) + (x - r) * q;
        const int q2 = prev_units / nx, r2 = prev_units % nx, cnt2 = q2 + (x < r2 ? 1 : 0); ex = cnt2 % W;
    }
    DI bool next(int i, Unit& u) const {
        const int R = i + (j < ex ? SK : 0);
        const int off = (R < SK) ? R * (W - ex) + (j - ex) : SK * (W - ex) + (R - SK) * W + j;
        if (off >= cnt) return false;
        const int wgid = base + off, nig = WGM * nN, gid = wgid / nig, fm = gid * WGM, gsz = (nM - fm) < WGM ? (nM - fm) : WGM;
        const int pl = fm + ((wgid % nig) % gsz); u.pn = (wgid % nig) / gsz; u.pm = first + pl; u.ph = hid0 + pl;
        u.e = __builtin_amdgcn_readfirstlane(tile[1 + u.pm]); return true;
    }
};

DI unsigned cvt_pk_bf16(float lo, float hi) { unsigned r; asm volatile("v_cvt_pk_bf16_f32 %0, %1, %2" : "=v"(r) : "v"(lo), "v"(hi)); return r; }

template <bool I8> struct AccT { typedef f32x4 type; };
template <> struct AccT<true> { typedef i32x4 type; };
template <class Epi, class Sched, bool GATHER, int Q = 0>
DI void gemm_phase(LAS unsigned char* lds, const Gemm g, const Sched& S, const Epi& E, const int wv) {
    constexpr bool I8 = Q == 1;
    typedef typename AccT<I8>::type acc_t;
    int wid = wv; asm volatile("" : "+s"(wid));
    const int tid = wid * 64 + lane_asm();
    const int lane = tid & 63, wr = wid >> 2, wc = wid & 3, fr = lane & 15, fq = lane >> 4;
    const int K = g.K, nt = K / BK;
    unsigned voffA[2], voffB[2];
#pragma unroll
    for (int i = 0; i < 2; ++i) { int R, C; stage_rc(tid * 16 + i * 8192, R, C); const int Rb = Epi::PERM ? ((R & ~31) + perm32(R & 31)) : R;
        voffA[i] = (unsigned)(R * K + C) * 2u; voffB[i] = (unsigned)(Rb * K + C) * 2u; }
    const unsigned kstep = (unsigned)(BK * 2);
    const size_t hstep = (size_t)HALF * K * 2;
    const size_t tstep = 2 * hstep;
    const unsigned ldsw = (unsigned)wid * 1024u;
    const int aoff = lds_byte(wr * 64 + fr, fq * 8), boff = lds_byte(wc * 32 + fr, fq * 8);
#define PG8_SA(b, h) (((b) * 2 + (h)) * HTB)
#define PG8_SB(b, h) ((4 + (b) * 2 + (h)) * HTB)
#define PG8_STAGE(bufoff, gbase, voff) do { _Pragma("unroll") for (int _i = 0; _i < 2; ++_i) { unsigned _vo = (voff)[_i]; asm volatile("" : "+v"(_vo)); \
        __builtin_amdgcn_global_load_lds((const unsigned*)((const char*)(gbase) + _vo), (LAS unsigned*)(lds + (bufoff) + ldsw + _i * 8192), 16, 0, 0); } } while (0)
#define PG8_STAGEA(bufoff, PA, OA, h, kb) do { if constexpr (GATHER) { _Pragma("unroll") for (int _i = 0; _i < 2; ++_i) { unsigned _vo = (OA)[h][_i]; asm volatile("" : "+v"(_vo)); \
        __builtin_amdgcn_global_load_lds((const unsigned*)((const char*)g.A + (size_t)_vo + (kb)), (LAS unsigned*)(lds + (bufoff) + ldsw + _i * 8192), 16, 0, 0); } } \
        else { PG8_STAGE(bufoff, (PA) + (h) * hstep + (kb), voffA); } } while (0)
#define PG8_LDA(dst, b, h) do { _Pragma("unroll") for (int m = 0; m < 4; ++m) _Pragma("unroll") for (int k = 0; k < 2; ++k) dst[m][k] = *(const LAS bf16x8*)(lds + PG8_SA(b, h) + aoff + m * 2048 + k * 1024); } while (0)
#define PG8_LDB(dst, b, h) do { _Pragma("unroll") for (int n = 0; n < 2; ++n) _Pragma("unroll") for (int k = 0; k < 2; ++k) dst[n][k] = *(const LAS bf16x8*)(lds + PG8_SB(b, h) + boff + n * 2048 + k * 1024); } while (0)
#define PG8_CAT(X) __builtin_shufflevector(__builtin_bit_cast(i32x4, X[0]), __builtin_bit_cast(i32x4, X[1]), 0, 1, 2, 3, 4, 5, 6, 7)
#define PG8_MMA(ai, bj, At, Bt) do { __builtin_amdgcn_s_setprio(1); _Pragma("unroll") for (int m = 0; m < 4; ++m) _Pragma("unroll") for (int n = 0; n < 2; ++n) _Pragma("unroll") for (int k = 0; k < 2; ++k) { \
        if constexpr (Q == 2) { if (k == 0) acc[ai][bj][m][n] = __builtin_amdgcn_mfma_scale_f32_16x16x128_f8f6f4(PG8_CAT(Bt[n]), PG8_CAT(At[m]), acc[ai][bj][m][n], 0, 0, 0, 0x7c7c7c7c, 0, 0x7c7c7c7c); } \
        else if constexpr (I8) acc[ai][bj][m][n] = __builtin_amdgcn_mfma_i32_16x16x64_i8(__builtin_bit_cast(i32x4, Bt[n][k]), __builtin_bit_cast(i32x4, At[m][k]), acc[ai][bj][m][n], 0, 0, 0); \
        else acc[ai][bj][m][n] = __builtin_amdgcn_mfma_f32_16x16x32_bf16(Bt[n][k], At[m][k], acc[ai][bj][m][n], 0, 0, 0); } __builtin_amdgcn_s_setprio(0); } while (0)
#define PG8_WAIT_V(n) asm volatile("s_waitcnt vmcnt(" #n ")" ::: "memory")
#define PG8_WAIT_L(n) asm volatile("s_waitcnt lgkmcnt(" #n ")" ::: "memory")
#define PG8_BAR __builtin_amdgcn_s_barrier()
#define PG8_SCHED __builtin_amdgcn_sched_barrier(0)
#define PG8_ARAW(dst, u) do { if constexpr (GATHER) { _Pragma("unroll") for (int _h = 0; _h < 2; ++_h) _Pragma("unroll") for (int _i = 0; _i < 2; ++_i) { \
        int _R, _C; stage_rc(tid * 16 + _i * 8192, _R, _C); dst[_h][_i] = g.rowtok[(u).pm * BM + _h * HALF + _R]; } } } while (0)
#define PG8_AOFFS(dst, raw) do { if constexpr (GATHER) { _Pragma("unroll") for (int _h = 0; _h < 2; ++_h) _Pragma("unroll") for (int _i = 0; _i < 2; ++_i) { \
        int _R, _C; stage_rc(tid * 16 + _i * 8192, _R, _C); int _t = raw[_h][_i]; _t = _t < 0 ? 0 : _t; \
        dst[_h][_i] = (unsigned)_t * (unsigned)(K * 2) + (unsigned)(_C * 2); } } } while (0)
    Unit cur, nxt, nn; int ui = 0;
    if (!S.next(0, cur)) return;
    bool has_next = S.next(1, nxt); if (!has_next) nxt = cur;
    acc_t acc[2][2][4][2];
#pragma unroll
    for (int a = 0; a < 2; ++a)
#pragma unroll
        for (int b = 0; b < 2; ++b)
#pragma unroll
            for (int m = 0; m < 4; ++m)
#pragma unroll
                for (int n = 0; n < 2; ++n) acc[a][b][m][n] = acc_t{};
    bf16x8 At[4][2], B0[2][2], B1[2][2];
    unsigned oa[2][2], na[2][2]; int rt2[2][2];
    PG8_ARAW(rt2, cur); PG8_AOFFS(oa, rt2); PG8_ARAW(rt2, nxt); PG8_AOFFS(na, rt2);
    const char* cA = (const char*)g.A + (GATHER ? (size_t)0 : (size_t)cur.ph * tstep);
    const char* cB = (const char*)g.Bt + ((size_t)cur.e * g.estride) * 2 + (size_t)cur.pn * tstep;
    PG8_STAGE(PG8_SB(0, 0), cB, voffB); PG8_STAGE(PG8_SB(0, 1), cB + hstep, voffB); PG8_STAGEA(PG8_SA(0, 0), cA, oa, 0, 0); PG8_STAGEA(PG8_SA(0, 1), cA, oa, 1, 0);
    if (wr == 1) PG8_BAR;
    PG8_WAIT_V(2); PG8_BAR;
    PG8_STAGE(PG8_SB(1, 0), cB + kstep, voffB); PG8_STAGEA(PG8_SA(1, 0), cA, oa, 0, kstep); PG8_STAGE(PG8_SB(1, 1), cB + hstep + kstep, voffB);
    PG8_WAIT_V(6); PG8_BAR;
    for (;;) {
        const char* nA = (const char*)g.A + (GATHER ? (size_t)0 : (size_t)nxt.ph * tstep);
        const char* nB = (const char*)g.Bt + ((size_t)nxt.e * g.estride) * 2 + (size_t)nxt.pn * tstep;
        for (int t = 0; t < nt; t += 2) {
            const bool last = (t == nt - 2);
            const unsigned k1 = (unsigned)(t + 1) * kstep, k2 = last ? 0u : (unsigned)(t + 2) * kstep, k3 = k2 + kstep;
            const char* a2 = last ? nA : cA;
            const char* b2 = last ? nB : cB + (size_t)(t + 2) * kstep; const char* b3 = b2 + kstep;
            PG8_LDB(B0, 0, 0); PG8_LDB(B1, 0, 1); PG8_SCHED; PG8_LDA(At, 0, 0); PG8_STAGEA(PG8_SA(1, 1), cA, oa, 1, k1);
            if constexpr (GATHER) { if (last) {
#pragma unroll
                for (int h = 0; h < 2; ++h)
#pragma unroll
                    for (int i = 0; i < 2; ++i) oa[h][i] = na[h][i]; } }
            PG8_WAIT_V(8); PG8_WAIT_L(0); PG8_BAR; PG8_MMA(0, 0, At, B0); PG8_MMA(0, 1, At, B1); PG8_BAR; PG8_SCHED;
            PG8_LDA(At, 0, 1); PG8_STAGE(PG8_SB(0, 0), b2, voffB); PG8_STAGE(PG8_SB(0, 1), b2 + hstep, voffB); PG8_STAGEA(PG8_SA(0, 0), a2, oa, 0, k2);
            PG8_WAIT_V(8); PG8_WAIT_L(0); PG8_BAR; PG8_MMA(1, 0, At, B0); PG8_MMA(1, 1, At, B1); PG8_BAR; PG8_SCHED;
            PG8_LDB(B0, 1, 0); PG8_LDB(B1, 1, 1); PG8_SCHED; PG8_LDA(At, 1, 0); PG8_STAGEA(PG8_SA(0, 1), a2, oa, 1, k2);
            PG8_WAIT_V(8); PG8_WAIT_L(0); PG8_BAR; PG8_MMA(0, 0, At, B0); PG8_MMA(0, 1, At, B1); PG8_BAR; PG8_SCHED;
            PG8_LDA(At, 1, 1); PG8_STAGE(PG8_SB(1, 0), b3, voffB); PG8_STAGE(PG8_SB(1, 1), b3 + hstep, voffB); PG8_STAGEA(PG8_SA(1, 0), a2, oa, 0, k3);
            PG8_WAIT_V(8); PG8_WAIT_L(0); PG8_BAR; PG8_MMA(1, 0, At, B0); PG8_MMA(1, 1, At, B1); PG8_BAR; PG8_SCHED;
        }
        if (wr == 0) PG8_BAR;
        bool has_nn = has_next && S.next(ui + 2, nn); if (!has_nn) nn = nxt;
        PG8_ARAW(rt2, nn);
        E.done(cur, wid * 64 + lane_asm());
        { const int l2 = lane_asm(); int wr_ = wr, wc_ = wc; asm volatile("" : "+s"(wr_), "+s"(wc_));
          E(acc, cur, wr_, wc_, l2 & 15, l2 >> 4); }
        if (!has_next) break;
        PG8_AOFFS(na, rt2);
#pragma unroll
        for (int a = 0; a < 2; ++a)
#pragma unroll
            for (int b = 0; b < 2; ++b)
#pragma unroll
                for (int m = 0; m < 4; ++m)
#pragma unroll
                    for (int n = 0; n < 2; ++n) acc[a][b][m][n] = acc_t{};
        cur = nxt; cA = nA; cB = nB; nxt = nn; has_next = has_nn; ++ui;
        if (wr == 1) PG8_BAR;
    }
    PG8_WAIT_V(0);
    PG8_BAR;
#undef PG8_SA
#undef PG8_SB
#undef PG8_STAGE
#undef PG8_STAGEA
#undef PG8_LDA
#undef PG8_LDB
#undef PG8_MMA
#undef PG8_CAT
#undef PG8_WAIT_V
#undef PG8_WAIT_L
#undef PG8_BAR
#undef PG8_SCHED
#undef PG8_ARAW
#undef PG8_AOFFS
}
}

#define XB_TMO      128
#define XB_XCNT(j)  (256  + 64 * (j))
#define XB_XSUB(j)  (1280 + 64 * (j))
#define XB_XGEN(j)  (2304 + 64 * (j))
#define XB_TOP      3328
#define XB_TOPGEN   3392
#define XCD_BAR_WORDS 3456
#define XB_SPIN_CAP (1u << 18)
__device__ __forceinline__ unsigned xb_ld(unsigned* p)              { return __hip_atomic_load(p, __ATOMIC_RELAXED, __HIP_MEMORY_SCOPE_AGENT); }
__device__ __forceinline__ unsigned xb_add(unsigned* p, unsigned v) { return __hip_atomic_fetch_add(p, v, __ATOMIC_RELAXED, __HIP_MEMORY_SCOPE_AGENT); }
__device__ __forceinline__ unsigned xb_xcc_id() { return (unsigned)__builtin_amdgcn_s_getreg((3 << 11) | 20) & 0xFu; }
#define XB_SPIN(cond, bar) do { unsigned _sp = 0; while (cond) { __builtin_amdgcn_s_sleep(1); \
    if ((++_sp & 255u) == 0u) { if (xb_ld(&(bar)[XB_TMO])) break; if (_sp > XB_SPIN_CAP) { atomicAdd(&(bar)[XB_TMO], 1u); break; } } } } while (0)
struct XcdBarrier { unsigned* bar; unsigned x; volatile LAS unsigned* st; int wv; };
__device__ __forceinline__ XcdBarrier xcd_barrier_post(unsigned* bar, volatile LAS unsigned* st, int wv) {
    XcdBarrier b; b.bar = bar; b.x = xb_xcc_id(); b.st = st; b.wv = wv;
    if (wv == 0 && lane_asm() == 0) (void)xb_add(&bar[XB_XCNT(b.x)], 1u);
    return b;
}
__device__ __forceinline__ void xcd_barrier_complete(unsigned* bar, unsigned x, unsigned& nloc, unsigned& nx) {
    const unsigned G = gridDim.x * gridDim.y * gridDim.z;
    unsigned sum, cnt, mine, sp = 0u;
    for (;;) {
        sum = 0u; cnt = 0u; mine = 0u;
#pragma unroll
        for (unsigned j = 0; j < 16; ++j) { const unsigned c = xb_ld(&bar[XB_XCNT(j)]); sum += c; cnt += (c > 0u) ? 1u : 0u; mine = (j == x) ? c : mine; }
        if (sum == G) break;
        __builtin_amdgcn_s_sleep(1);
        if ((++sp & 255u) == 0u) { if (xb_ld(&bar[XB_TMO])) break; if (sp > XB_SPIN_CAP) { atomicAdd(&bar[XB_TMO], 1u); break; } }
    }
    nloc = mine > 0u ? mine : 1u; nx = cnt > 0u ? cnt : 1u;
}
__device__ __forceinline__ void xcd_barrier(const XcdBarrier& b) {
    asm volatile("s_waitcnt vmcnt(0)" ::: "memory");
    __syncthreads();
    if (b.wv == 0 && lane_asm() == 0) {
        unsigned* bar = b.bar;
        __builtin_amdgcn_s_waitcnt(0);
        unsigned nloc = b.st[0], nx = b.st[1];
        if (nloc == 0u) { xcd_barrier_complete(bar, b.x, nloc, nx); b.st[0] = nloc; b.st[1] = nx; }
        const unsigned old = xb_add(&bar[XB_XSUB(b.x)], 1u);
        const unsigned gen = old / nloc;
        if (old + 1u == (gen + 1u) * nloc) {
            __builtin_amdgcn_fence(__ATOMIC_RELEASE, "agent");
            asm volatile("s_waitcnt vmcnt(0)" ::: "memory");
            const unsigned og = xb_add(&bar[XB_TOP], 1u);
            const unsigned tg = og / nx;
            if (og + 1u == (tg + 1u) * nx) xb_add(&bar[XB_TOPGEN], 1u);
            else XB_SPIN(xb_ld(&bar[XB_TOPGEN]) == tg, bar);
            __builtin_amdgcn_fence(__ATOMIC_ACQUIRE, "agent");
            xb_add(&bar[XB_XGEN(b.x)], 1u);
            asm volatile("s_waitcnt vmcnt(0)" ::: "memory");
        } else {
            XB_SPIN(xb_ld(&bar[XB_XGEN(b.x)]) == gen, bar);
            __builtin_amdgcn_fence(__ATOMIC_ACQUIRE, "agent");
            asm volatile("s_waitcnt vmcnt(0)" ::: "memory");
        }
    }
    __syncthreads();
}

struct Frame {
    LAS unsigned char* lds;
    int tid, lane, wave, vcu, G;
    unsigned char* ws;
};
struct Args { const float* in[26]; float* out; unsigned char* ws; int ph_lo, ph_hi; };
enum { I_X = 0, I_MIXG, I_WIN, I_CONVW, I_CONVB, I_WQ, I_WK, I_WV, I_WIF, I_BIF, I_SKIP, I_MHG, I_GMVG, I_WSP, I_BSP, I_GMOG, I_WOUT, I_FFNG,
       I_DW1, I_DW3, I_DW2, I_ROUTER, I_MW1, I_MW3, I_MW2, I_FING };

DI float rs_from(const f32x4 p) { return __builtin_amdgcn_rsqf(((p.x + p.y) + (p.z + p.w)) * (1.0f / D) + EPS); }
constexpr int L_SSL = RING_BYTES;

struct EpiIn {
    static constexpr bool PERM = true;
    bf16* O; const float* ssq; LAS unsigned char* lds; float* vst; bool scaled;
    DI void done(const pg8::Unit&, int) const {}
    DI void operator()(const f32x4 (&acc)[2][2][4][2], const pg8::Unit& u, int wr, int wc, int fr, int fq) const {
        const int row0 = u.pm * 256 + wr * 64 + fr, col0 = u.pn * 256 + wc * 32 + 8 * fq, act = u.pn >> 1;
        f32x4 pp[2][4];
#pragma unroll
        for (int ai = 0; ai < 2; ++ai)
#pragma unroll
            for (int m = 0; m < 4; ++m) { pp[ai][m] = (f32x4){0.f, 0.f, 0.f, 0.f}; if (!scaled) pp[ai][m] = *(const f32x4*)(ssq + (size_t)(row0 + ai * 128 + m * 16) * 4); }
#pragma unroll
        for (int ai = 0; ai < 2; ++ai)
#pragma unroll
            for (int m = 0; m < 4; ++m) { const int row = row0 + ai * 128 + m * 16; const float r = scaled ? 1.0f : rs_from(pp[ai][m]); bf16* rowp = O + (size_t)row * DIN + col0; float s1 = 0.f, s2 = 0.f;
#pragma unroll
                for (int bj = 0; bj < 2; ++bj) { float v[8];
#pragma unroll
                    for (int j = 0; j < 4; ++j) { v[j] = acc[ai][bj][m][0][j] * r; v[4 + j] = acc[ai][bj][m][1][j] * r; }
                    if (act == 1) {
#pragma unroll
                        for (int j = 0; j < 8; ++j) v[j] = sigmoidf(v[j]); }
                    else if (act >= 2) {
#pragma unroll
                        for (int j = 0; j < 8; ++j) v[j] = geluf(v[j]); }
                    u32x4 w; w.x = pg8::cvt_pk_bf16(v[0], v[1]); w.y = pg8::cvt_pk_bf16(v[2], v[3]); w.z = pg8::cvt_pk_bf16(v[4], v[5]); w.w = pg8::cvt_pk_bf16(v[6], v[7]);
                    *(u32x4*)(rowp + bj * 128) = w;
                    if (act == 3) { s1 += ((v[0] + v[1]) + (v[2] + v[3])) + ((v[4] + v[5]) + (v[6] + v[7])); s2 += ((v[0] * v[0] + v[1] * v[1]) + (v[2] * v[2] + v[3] * v[3])) + ((v[4] * v[4] + v[5] * v[5]) + (v[6] * v[6] + v[7] * v[7])); } }
                if (act == 3) { s1 += __shfl_xor(s1, 16); s1 += __shfl_xor(s1, 32); s2 += __shfl_xor(s2, 16); s2 += __shfl_xor(s2, 32);
                    if (fq == 0) *(f32x2*)(vst + ((size_t)row * 8 + (u.pn - 6) * 4 + wc) * 2) = (f32x2){s1, s2}; } }
    }
};
template <bool BF> struct EpiResT {
    static constexpr bool PERM = true;
    const float* base; bf16* xb; float* ssq; LAS unsigned char* lds;
    DI void done(const pg8::Unit&, int) const {}
    DI void operator()(const f32x4 (&acc)[2][2][4][2], const pg8::Unit& u, int wr, int wc, int fr, int fq) const {
        const int row0 = u.pm * 256 + wr * 64 + fr, col0 = u.pn * 256 + wc * 32 + 8 * fq;
        LAS float* SSL = (LAS float*)(lds + L_SSL);
#pragma unroll
        for (int ai = 0; ai < 2; ++ai) {
            f32x4 bs[4][2][2]; u32x4 bb[4][2];
#pragma unroll
            for (int m = 0; m < 4; ++m)
#pragma unroll
                for (int bj = 0; bj < 2; ++bj) { const size_t o_ = (size_t)(row0 + ai * 128 + m * 16) * D + col0 + bj * 128;
                    if constexpr (BF) bb[m][bj] = *(const u32x4*)(xb + o_); else { bs[m][bj][0] = *(const f32x4*)(base + o_); bs[m][bj][1] = *(const f32x4*)(base + o_ + 4); } }
#pragma unroll
            for (int m = 0; m < 4; ++m) { const int row = row0 + ai * 128 + m * 16; const size_t off = (size_t)row * D + col0; float ss = 0.f;
#pragma unroll
                for (int bj = 0; bj < 2; ++bj) { f32x4 b0, b1;
                    if constexpr (BF) { b0 = (f32x4){bflo(bb[m][bj].x), bfhi(bb[m][bj].x), bflo(bb[m][bj].y), bfhi(bb[m][bj].y)}; b1 = (f32x4){bflo(bb[m][bj].z), bfhi(bb[m][bj].z), bflo(bb[m][bj].w), bfhi(bb[m][bj].w)}; }
                    else { b0 = bs[m][bj][0]; b1 = bs[m][bj][1]; }
                    const f32x4 o0 = b0 + acc[ai][bj][m][0], o1 = b1 + acc[ai][bj][m][1];
                    ss += ((o0.x * o0.x + o0.y * o0.y) + (o0.z * o0.z + o0.w * o0.w)) + ((o1.x * o1.x + o1.y * o1.y) + (o1.z * o1.z + o1.w * o1.w));
                    u32x4 w; w.x = pg8::cvt_pk_bf16(o0.x, o0.y); w.y = pg8::cvt_pk_bf16(o0.z, o0.w); w.z = pg8::cvt_pk_bf16(o1.x, o1.y); w.w = pg8::cvt_pk_bf16(o1.z, o1.w);
                    *(u32x4*)(xb + off + bj * 128) = w; }
                ss += __shfl_xor(ss, 16); ss += __shfl_xor(ss, 32);
                if (fq == 0) SSL[(ai * 128 + wr * 64 + m * 16 + fr) * 4 + wc] = ss; }
            asm volatile("" ::: "memory"); }
        LDS_WAIT(); __builtin_amdgcn_s_barrier(); asm volatile("" ::: "memory");
        const int tix = (wr * 4 + wc) * 64 + fq * 16 + fr;
        if (tix < 256) { const f32x4 p = *(const LAS f32x4*)(SSL + tix * 4); ssq[(size_t)(u.pm * 256 + tix) * 4 + u.pn] = (p.x + p.y) + (p.z + p.w); }
    }
};
template <bool MOE> struct EpiGlu {
    static constexpr bool PERM = true;
    bf16* O; int ld; const float* ssq; const int* rowtok; unsigned* hidcnt; unsigned need;
    DI void done(const pg8::Unit&, int) const {}
    DI void operator()(const f32x4 (&acc)[2][2][4][2], const pg8::Unit& u, int wr, int wc, int fr, int fq) const {
        const int row0 = u.pm * 256 + wr * 64 + fr, orow0 = u.ph * 256 + wr * 64 + fr, col0 = u.pn * 128 + wc * 32 + 8 * fq;
        f32x4 pp[2][4];
#pragma unroll
        for (int ai = 0; ai < 2; ++ai)
#pragma unroll
            for (int m = 0; m < 4; ++m) { pp[ai][m] = (f32x4){0.f, 0.f, 0.f, 0.f}; if (!MOE) pp[ai][m] = *(const f32x4*)(ssq + (size_t)(row0 + ai * 128 + m * 16) * 4); }
        if (MOE) { if (need) { unsigned sp = 0; while ((unsigned)__builtin_amdgcn_readfirstlane(__hip_atomic_load(hidcnt + 64 * u.ph, __ATOMIC_RELAXED, __HIP_MEMORY_SCOPE_AGENT)) < need) { __builtin_amdgcn_s_sleep(2); if (++sp > (1u << 22)) break; } } }
#pragma unroll
        for (int ai = 0; ai < 2; ++ai)
#pragma unroll
            for (int m = 0; m < 4; ++m) { const float r = MOE ? 1.0f : rs_from(pp[ai][m]); float v[8];
#pragma unroll
                for (int j = 0; j < 4; ++j) { v[j] = siluf(acc[ai][0][m][0][j] * r) * (acc[ai][1][m][0][j] * r); v[4 + j] = siluf(acc[ai][0][m][1][j] * r) * (acc[ai][1][m][1][j] * r); }
                u32x4 w; w.x = pg8::cvt_pk_bf16(v[0], v[1]); w.y = pg8::cvt_pk_bf16(v[2], v[3]); w.z = pg8::cvt_pk_bf16(v[4], v[5]); w.w = pg8::cvt_pk_bf16(v[6], v[7]);
                *(u32x4*)(O + (size_t)(orow0 + ai * 128 + m * 16) * ld + col0) = w; }
    }
};
template <bool F8> struct EpiGluI8T {
    static constexpr bool PERM = true;
    bf16* O; int ld; const float* rowsa; const float* sw13; unsigned* hidcnt; unsigned need;
    DI void done(const pg8::Unit&, int) const {}
    DI void operator()(const i32x4 (&acc)[2][2][4][2], const pg8::Unit& u, int wr, int wc, int fr, int fq) const {
        const int row0 = u.pm * 256 + wr * 64 + fr, orow0 = u.ph * 256 + wr * 64 + fr, col0 = u.pn * 128 + wc * 32 + 8 * fq;
        float sa[2][4];
#pragma unroll
        for (int ai = 0; ai < 2; ++ai)
#pragma unroll
            for (int m = 0; m < 4; ++m) sa[ai][m] = rowsa[row0 + ai * 128 + m * 16];
        const float* swp = sw13 + (size_t)u.e * (2 * DFE) + u.pn * 256 + wc * 32 + 8 * fq;
        const f32x4 sg0 = *(const f32x4*)(swp), sg1 = *(const f32x4*)(swp + 4), su0 = *(const f32x4*)(swp + 128), su1 = *(const f32x4*)(swp + 132);
        if (need) { unsigned sp = 0; while ((unsigned)__builtin_amdgcn_readfirstlane(__hip_atomic_load(hidcnt + 64 * u.ph, __ATOMIC_RELAXED, __HIP_MEMORY_SCOPE_AGENT)) < need) { __builtin_amdgcn_s_sleep(2); if (++sp > (1u << 22)) break; } }
        const float sg[8] = {sg0.x, sg0.y, sg0.z, sg0.w, sg1.x, sg1.y, sg1.z, sg1.w}, su[8] = {su0.x, su0.y, su0.z, su0.w, su1.x, su1.y, su1.z, su1.w};
#pragma unroll
        for (int ai = 0; ai < 2; ++ai)
#pragma unroll
            for (int m = 0; m < 4; ++m) { const float r = sa[ai][m] * (1.0f / 127.0f); float v[8];
#pragma unroll
                for (int j = 0; j < 4; ++j) { v[j] = siluf((float)acc[ai][0][m][0][j] * (r * sg[j])) * ((float)acc[ai][1][m][0][j] * (r * su[j]));
                    v[4 + j] = siluf((float)acc[ai][0][m][1][j] * (r * sg[4 + j])) * ((float)acc[ai][1][m][1][j] * (r * su[4 + j])); }
                if constexpr (F8) { int w0 = __builtin_amdgcn_cvt_pk_fp8_f32(v[0], v[1], 0, false); w0 = __builtin_amdgcn_cvt_pk_fp8_f32(v[2], v[3], w0, true);
                    int w1 = __builtin_amdgcn_cvt_pk_fp8_f32(v[4], v[5], 0, false); w1 = __builtin_amdgcn_cvt_pk_fp8_f32(v[6], v[7], w1, true);
                    *(u32x2*)((unsigned char*)O + (size_t)(orow0 + ai * 128 + m * 16) * ld + col0) = (u32x2){(unsigned)w0, (unsigned)w1}; }
                else { u32x4 w; w.x = pg8::cvt_pk_bf16(v[0], v[1]); w.y = pg8::cvt_pk_bf16(v[2], v[3]); w.z = pg8::cvt_pk_bf16(v[4], v[5]); w.w = pg8::cvt_pk_bf16(v[6], v[7]);
                    *(u32x4*)(O + (size_t)(orow0 + ai * 128 + m * 16) * ld + col0) = w; } }
    }
};
typedef EpiGluI8T<false> EpiGluI8;
struct EpiGluF8 {
    static constexpr bool PERM = true;
    unsigned char* O; int ld; unsigned* hidcnt; unsigned need;
    DI void done(const pg8::Unit&, int) const {}
    DI void operator()(const f32x4 (&acc)[2][2][4][2], const pg8::Unit& u, int wr, int wc, int fr, int fq) const {
        const int orow0 = u.ph * 256 + wr * 64 + fr, col0 = u.pn * 128 + wc * 32 + 8 * fq;
        if (need) { unsigned sp = 0; while ((unsigned)__builtin_amdgcn_readfirstlane(__hip_atomic_load(hidcnt + 64 * u.ph, __ATOMIC_RELAXED, __HIP_MEMORY_SCOPE_AGENT)) < need) { __builtin_amdgcn_s_sleep(2); if (++sp > (1u << 22)) break; } }
#pragma unroll
        for (int ai = 0; ai < 2; ++ai)
#pragma unroll
            for (int m = 0; m < 4; ++m) { float v[8];
#pragma unroll
                for (int n = 0; n < 2; ++n)
#pragma unroll
                    for (int j = 0; j < 4; ++j) { const float t = acc[ai][0][m][n][j]; v[4 * n + j] = (t * acc[ai][1][m][n][j]) * __builtin_amdgcn_rcpf(1.0f + __builtin_amdgcn_exp2f(t)); }
                int w0 = __builtin_amdgcn_cvt_pk_fp8_f32(v[0], v[1], 0, false); w0 = __builtin_amdgcn_cvt_pk_fp8_f32(v[2], v[3], w0, true);
                int w1 = __builtin_amdgcn_cvt_pk_fp8_f32(v[4], v[5], 0, false); w1 = __builtin_amdgcn_cvt_pk_fp8_f32(v[6], v[7], w1, true);
                *(u32x2*)(O + (size_t)(orow0 + ai * 128 + m * 16) * ld + col0) = (u32x2){(unsigned)w0, (unsigned)w1}; }
    }
};
struct EpiMoe2 {
    static constexpr bool PERM = true;
    bf16* xb; const int* rowtok; const float* rowgate; unsigned* hidcnt;
    DI void done(const pg8::Unit& u, int tid) const { if (tid == 0) __hip_atomic_fetch_add(hidcnt + 64 * u.ph, 1u, __ATOMIC_RELAXED, __HIP_MEMORY_SCOPE_AGENT); }
    DI void operator()(const f32x4 (&acc)[2][2][4][2], const pg8::Unit& u, int wr, int wc, int fr, int fq) const {
        const int row0 = u.pm * 256 + wr * 64 + fr, col0 = u.pn * 256 + wc * 32 + 8 * fq;
        int tok[2][4]; float gt[2][4];
#pragma unroll
        for (int ai = 0; ai < 2; ++ai)
#pragma unroll
            for (int m = 0; m < 4; ++m) { const int row = row0 + ai * 128 + m * 16; tok[ai][m] = rowtok[row]; gt[ai][m] = rowgate[row]; }
        u32x4 bb[2][4][2];
#pragma unroll
        for (int ai = 0; ai < 2; ++ai)
#pragma unroll
            for (int m = 0; m < 4; ++m) { const size_t off = (size_t)(tok[ai][m] < 0 ? 0 : tok[ai][m]) * D + col0;
#pragma unroll
                for (int bj = 0; bj < 2; ++bj) bb[ai][m][bj] = *(const u32x4*)(xb + off + bj * 128); }
#pragma unroll
        for (int ai = 0; ai < 2; ++ai)
#pragma unroll
            for (int m = 0; m < 4; ++m) { if (tok[ai][m] >= 0) { const size_t off = (size_t)tok[ai][m] * D + col0;
#pragma unroll
                for (int bj = 0; bj < 2; ++bj) { const u32x4 b = bb[ai][m][bj];
                    const f32x4 o0 = (f32x4){bflo(b.x), bfhi(b.x), bflo(b.y), bfhi(b.y)} + gt[ai][m] * acc[ai][bj][m][0], o1 = (f32x4){bflo(b.z), bfhi(b.z), bflo(b.w), bfhi(b.w)} + gt[ai][m] * acc[ai][bj][m][1];
                    u32x4 w; w.x = pg8::cvt_pk_bf16(o0.x, o0.y); w.y = pg8::cvt_pk_bf16(o0.z, o0.w); w.z = pg8::cvt_pk_bf16(o1.x, o1.y); w.w = pg8::cvt_pk_bf16(o1.z, o1.w);
                    *(u32x4*)(xb + off + bj * 128) = w; } } }
    }
};

DI void tr_item(const float* W, int N, const float* kscale, bf16* WT, int ldk, int mode, int add, int item, LAS float* scr, int lane) {
    const int nblk = N / 64, kb = item / nblk, nb = item % nblk, k0 = 64 * kb, n0 = 64 * nb;
    const int drow0 = mode ? (((n0 >> 7) << 8) + (n0 & 127) + add) : n0;
    const int kr = lane >> 4, nc = (lane & 15) * 4;
    f32x4 v[16];
#pragma unroll
    for (int i = 0; i < 16; ++i) v[i] = *(const f32x4*)(W + (size_t)(k0 + 4 * i + kr) * N + n0 + nc);
#pragma unroll
    for (int i = 0; i < 16; ++i) { const int kk = 4 * i + kr; f32x4 x = v[i]; if (kscale) x = x * kscale[k0 + kk];
        LAS float* d = scr + kk * 65 + nc; d[0] = x.x; d[1] = x.y; d[2] = x.z; d[3] = x.w; }
    LDS_WAIT(); asm volatile("" ::: "memory");
    const int c = lane & 7;
#pragma unroll
    for (int j = 0; j < 8; ++j) { const int n = (lane >> 3) + 8 * j; const LAS float* sp = scr + (8 * c) * 65 + n;
        u32x4 o; o.x = pk2(sp[0 * 65], sp[1 * 65]); o.y = pk2(sp[2 * 65], sp[3 * 65]); o.z = pk2(sp[4 * 65], sp[5 * 65]); o.w = pk2(sp[6 * 65], sp[7 * 65]);
        *(u32x4*)(WT + (size_t)(drow0 + n) * ldk + k0 + 8 * c) = o; }
    LDS_WAIT(); asm volatile("" ::: "memory");
}
DI void absmax_item(const float* W, int N, const float* ks, unsigned* sw, int add, int item, int lane);
DI void f8_item(const float* W, int N, const float* ks, float mul, unsigned char* dst, int ldk, bool il, int add, int item, LAS float* scr, int lane);
DI void p0_prologue(const Frame& F, const Args& a) {
    LAS float* scr = (LAS float*)(F.lds + F.wave * 16896);
    const int gw = F.vcu * 8 + F.wave, NGW = F.G * 8, lane = F.lane;
    unsigned char* ws = F.ws;
    constexpr int I_IN = 16 * 32, I_OUT = 16 * 16, I_W1 = 16 * 43, I_W2 = 43 * 16, I_QKV = 2 * 2;
    constexpr int NITEMS = 2 * I_IN + 2 * I_OUT + 2 * I_W1 + 24 * I_QKV;
    for (int it = gw; it < NITEMS; it += NGW) {
        int r = it;
        if (r < 2 * I_IN) { const int l = r / I_IN; tr_item(a.in[I_WIN] + (size_t)l * D * DIN, DIN, a.in[I_MIXG] + l * D, (bf16*)(ws + WS_WIN) + (size_t)l * DIN * D, D, 0, 0, r % I_IN, scr, lane); continue; } r -= 2 * I_IN;
        if (r < 2 * I_OUT) { const int l = r / I_OUT; tr_item(a.in[I_WOUT] + (size_t)l * D * D, D, nullptr, (bf16*)(ws + WS_WOUT) + (size_t)l * D * D, D, 0, 0, r % I_OUT, scr, lane); continue; } r -= 2 * I_OUT;
        if (r < I_W1) { absmax_item(a.in[I_DW1], DFF, a.in[I_FFNG], (unsigned*)(ws + WS_SWD), 0, r, lane); continue; } r -= I_W1;
        if (r < I_W1) { absmax_item(a.in[I_DW3], DFF, a.in[I_FFNG], (unsigned*)(ws + WS_SWD), 128, r, lane); continue; } r -= I_W1;
        { const int mtx = r / I_QKV, m = mtx / 8, lh = mtx % 8;
          tr_item(a.in[I_WQ + m] + (size_t)lh * 128 * 128, 128, nullptr, (bf16*)(ws + WS_WQ) + (size_t)mtx * 128 * 128, 128, 0, 0, r % I_QKV, scr, lane); }
    }
    { const int gt = gw * 64 + lane, NGT = NGW * 64; const u32x4 z = (u32x4){0u, 0u, 0u, 0u};
      for (int i = gt; i < 128 * (D / 16); i += NGT) { const int rr = i / (D / 16), c16 = i % (D / 16); const int row = 21 * 256 + (rr < 64 ? 64 + rr : 192 + (rr - 64)); *(u32x4*)((signed char*)(ws + WS_W13) + (size_t)row * D + c16 * 16) = z; }
      for (int i = gt; i < D * 4; i += NGT) { const int row = i / 4, c4 = i % 4; *(u32x4*)(ws + WS_W2 + (size_t)row * DFFP + DFF + c4 * 16) = z; } }
    for (int m0 = gw * 4; m0 < T; m0 += NGW * 4) {
        f32x4 v[4][4];
#pragma unroll
        for (int r = 0; r < 4; ++r) { const f32x4* xr = (const f32x4*)(a.in[I_X] + (size_t)(m0 + r) * D) + lane;
#pragma unroll
            for (int j = 0; j < 4; ++j) v[r][j] = xr[64 * j]; }
#pragma unroll
        for (int r = 0; r < 4; ++r) { float s_ = 0.f;
#pragma unroll
            for (int j = 0; j < 4; ++j) s_ += (v[r][j].x * v[r][j].x + v[r][j].y * v[r][j].y) + (v[r][j].z * v[r][j].z + v[r][j].w * v[r][j].w);
            s_ = wave_sum(s_);
            u32x2* o8 = (u32x2*)((bf16*)(ws + WS_XB) + (size_t)(m0 + r) * D) + lane;
            const float rs_ = 1.0f / sqrtf(s_ * (1.0f / D) + EPS);
#pragma unroll
            for (int j = 0; j < 4; ++j) { u32x2 w; w.x = pk2(v[r][j].x * rs_, v[r][j].y * rs_); w.y = pk2(v[r][j].z * rs_, v[r][j].w * rs_); o8[64 * j] = w; }
            if (lane < 4) ((float*)(ws + WS_SSQ))[(size_t)(m0 + r) * 4 + lane] = lane == 0 ? s_ : 0.f; }
    }
    for (int it = gw; it < 2 * 16; it += NGW) {
        const int l = it / 16, c = (it % 16) * 64 + lane, part = c >> 9, cc = c & 511, h = cc >> 7, d = cc & 127;
        const float* wif = a.in[I_WIF] + (size_t)l * 1536 * 8;
        float accj[8];
#pragma unroll
        for (int j = 0; j < 8; ++j) accj[j] = 0.f;
        if (part == 0) {
            const float* wq = a.in[I_WQ] + ((size_t)(l * 4 + h) * 128 + d) * 128; const float* wk = a.in[I_WK] + ((size_t)(l * 4 + h) * 128 + d) * 128;
            for (int e = 0; e < 128; ++e) { const float q = wq[e], k = wk[e]; const float* fq_ = wif + (size_t)(128 * h + e) * 8; const float* fk_ = wif + (size_t)(512 + 128 * h + e) * 8;
#pragma unroll
                for (int j = 0; j < 8; ++j) accj[j] += q * fq_[j] + k * fk_[j]; }
        } else {
            const float* wv = a.in[I_WV] + ((size_t)(l * 4 + h) * 128 + d) * 128;
            for (int e = 0; e < 128; ++e) { const float v = wv[e]; const float* fv_ = wif + (size_t)(1024 + 128 * h + e) * 8;
#pragma unroll
                for (int j = 0; j < 8; ++j) accj[j] += v * fv_[j]; }
        }
        bf16* wg = (bf16*)(ws + WS_WG) + (size_t)l * 16 * 1024;
#pragma unroll
        for (int j = 0; j < 8; ++j) { wg[j * 1024 + c] = (bf16)f2bf(accj[j]); wg[(8 + j) * 1024 + c] = 0; }
    }
    { const int gt = gw * 64 + lane, NGT = NGW * 64;
      for (int i = gt; i < 2 * 4 * 128 * 128; i += NGT) { const int ii = (i >> 7) & 127, jj = i & 127; const float v = ((ii >> 6) >= (jj >> 6)) ? a.in[I_WSP][i] : 0.f; ((bf16*)(ws + WS_WSP))[i] = (bf16)f2bf(v); } }
}
DI void absmax_item(const float* W, int N, const float* ks, unsigned* sw, int add, int item, int lane) {
    const int nblk = N / 64, kb = item / nblk, nb = item % nblk, k0 = 64 * kb, n0 = 64 * nb, kr = lane >> 4, nc = (lane & 15) * 4;
    f32x4 v[16];
#pragma unroll
    for (int i = 0; i < 16; ++i) v[i] = *(const f32x4*)(W + (size_t)(k0 + 4 * i + kr) * N + n0 + nc);
    f32x4 mx = (f32x4){0.f, 0.f, 0.f, 0.f};
#pragma unroll
    for (int i = 0; i < 16; ++i) { const f32x4 x = v[i] * ks[k0 + 4 * i + kr]; mx.x = fmaxf(mx.x, fabsf(x.x)); mx.y = fmaxf(mx.y, fabsf(x.y)); mx.z = fmaxf(mx.z, fabsf(x.z)); mx.w = fmaxf(mx.w, fabsf(x.w)); }
#pragma unroll
    for (int c = 0; c < 4; ++c) { mx[c] = fmaxf(mx[c], __shfl_xor(mx[c], 16)); mx[c] = fmaxf(mx[c], __shfl_xor(mx[c], 32)); }
    if (kr == 0) { unsigned* p = sw + ((n0 >> 7) << 8) + (n0 & 127) + add + nc;
#pragma unroll
        for (int c = 0; c < 4; ++c) atomicMax(p + c, __builtin_bit_cast(unsigned, mx[c])); }
}
DI void quant_item(const float* W, int N, const float* ks, const float* sw, signed char* dst, int add, int item, LAS float* scr, int lane) {
    const int nblk = N / 64, kb = item / nblk, nb = item % nblk, k0 = 64 * kb, n0 = 64 * nb, kr = lane >> 4, nc = (lane & 15) * 4;
    const int drow0 = ((n0 >> 7) << 8) + (n0 & 127) + add;
    f32x4 v[16];
#pragma unroll
    for (int i = 0; i < 16; ++i) v[i] = *(const f32x4*)(W + (size_t)(k0 + 4 * i + kr) * N + n0 + nc);
    const int kq = lane & 3, nl = lane >> 2;
    float inv[4];
#pragma unroll
    for (int j = 0; j < 4; ++j) { const float amax = sw[drow0 + nl + 16 * j]; inv[j] = amax > 0.f ? 127.0f / amax : 0.f; }
#pragma unroll
    for (int i = 0; i < 16; ++i) { const int kk = 4 * i + kr; const f32x4 x = v[i] * ks[k0 + kk]; LAS float* p = scr + kk * 65 + nc; p[0] = x.x; p[1] = x.y; p[2] = x.z; p[3] = x.w; }
    LDS_WAIT(); asm volatile("" ::: "memory");
#pragma unroll
    for (int j = 0; j < 4; ++j) { const int n = nl + 16 * j; u32x4 o;
#pragma unroll
        for (int d = 0; d < 4; ++d) { unsigned wd = 0;
#pragma unroll
            for (int b = 0; b < 4; ++b) { const float q = rintf(scr[(16 * kq + 4 * d + b) * 65 + n] * inv[j]); const int qi = (int)fminf(fmaxf(q, -127.f), 127.f); wd |= ((unsigned)qi & 0xffu) << (8 * b); }
            o[d] = wd; }
        *(u32x4*)(dst + (size_t)(drow0 + n) * D + k0 + 16 * kq) = o; }
    LDS_WAIT(); asm volatile("" ::: "memory");
}
DI void f8_item(const float* W, int N, const float* ks, float mul, unsigned char* dst, int ldk, bool il, int add, int item, LAS float* scr, int lane) {
    const int nblk = N / 64, kb = item / nblk, nb = item % nblk, k0 = 64 * kb, n0 = 64 * nb, kr = lane >> 4, nc = (lane & 15) * 4;
    const int drow0 = il ? ((n0 >> 7) << 8) + (n0 & 127) + add : n0;
    f32x4 v[16];
#pragma unroll
    for (int i = 0; i < 16; ++i) v[i] = *(const f32x4*)(W + (size_t)(k0 + 4 * i + kr) * N + n0 + nc);
    const int kq = lane & 3, nl = lane >> 2;
#pragma unroll
    for (int i = 0; i < 16; ++i) { const int kk = 4 * i + kr; const f32x4 x = v[i] * (ks ? ks[k0 + kk] * mul : mul); LAS float* p = scr + kk * 65 + nc; p[0] = x.x; p[1] = x.y; p[2] = x.z; p[3] = x.w; }
    LDS_WAIT(); asm volatile("" ::: "memory");
#pragma unroll
    for (int j = 0; j < 4; ++j) { const int n = nl + 16 * j; u32x4 o;
#pragma unroll
        for (int d = 0; d < 4; ++d) { const LAS float* q = scr + (16 * kq + 4 * d) * 65 + n;
            int wd = __builtin_amdgcn_cvt_pk_fp8_f32(q[0], q[65], 0, false); wd = __builtin_amdgcn_cvt_pk_fp8_f32(q[130], q[195], wd, true); o[d] = (unsigned)wd; }
        *(u32x4*)(dst + (size_t)(drow0 + n) * ldk + k0 + 16 * kq) = o; }
    LDS_WAIT(); asm volatile("" ::: "memory");
}
DI void moe_weights(const Frame& F, const Args& a) {
    LAS float* scr = (LAS float*)(F.lds + F.wave * 16896);
    const int gw = F.vcu * 8 + F.wave, NGW = F.G * 8, lane = F.lane;
    constexpr int I_1 = 16 * 56, I_2 = 56 * 16;
    constexpr int NITEMS = 16 * I_1 + 8 * I_2;
    for (int it = gw; it < NITEMS; it += NGW) {
        int r = it;
        if (r < 16 * I_1) { const int m = r / I_1, e = m >> 1, w3 = m & 1;
            f8_item(a.in[w3 ? I_MW3 : I_MW1] + (size_t)e * D * DFE, DFE, a.in[I_FFNG] + D, w3 ? -64.0f * 0.69314718056f : -64.0f * 1.44269504089f, F.ws + WS_MW13 + (size_t)e * (2 * DFE) * D, D, true, w3 ? 128 : 0, r % I_1, scr, lane); continue; }
        r -= 16 * I_1;
        { const int e = r / I_2; f8_item(a.in[I_MW2] + (size_t)e * DFE * D, D, nullptr, 64.0f, F.ws + WS_MW2 + (size_t)e * D * DFE, DFE, false, 0, r % I_2, scr, lane); }
    }
}
DI void dense_quant(const Frame& F, const Args& a) {
    LAS float* scr = (LAS float*)(F.lds + F.wave * 16896);
    const int gw = F.vcu * 8 + F.wave, NGW = F.G * 8, lane = F.lane;
    constexpr int I_1 = 16 * 43, I_W2 = 43 * 16;
    for (int it = gw; it < 2 * I_1 + I_W2; it += NGW) { const int w3 = it / I_1;
        if (it >= 2 * I_1) { f8_item(a.in[I_DW2], D, nullptr, 64.0f, F.ws + WS_W2, DFFP, false, 0, it - 2 * I_1, scr, lane); continue; }
        quant_item(a.in[w3 ? I_DW3 : I_DW1], DFF, a.in[I_FFNG], (const float*)(F.ws + WS_SWD), (signed char*)(F.ws + WS_W13), w3 ? 128 : 0, it % I_1, scr, lane); }
}
DI void rows_to_int8(const Frame& F) {
    unsigned char* ws = F.ws; const int gw = F.vcu * 8 + F.wave, NGW = F.G * 8, lane = F.lane;
    const bf16* xb = (const bf16*)(ws + WS_XB); const float* ssq = (const float*)(ws + WS_SSQ);
    u32x4 va[4], vb[4], na[4], nb[4];
#define RQ_LOAD(A_, B_, mbase) do { _Pragma("unroll") for (int r = 0; r < 4; ++r) { const u32x4* p_ = (const u32x4*)(xb + (size_t)((mbase) + r) * D) + lane; A_[r] = p_[0]; B_[r] = p_[64]; } } while (0)
    int m0 = gw * 4; if (m0 >= T) return;
    RQ_LOAD(va, vb, m0);
#pragma unroll 1
    for (;;) { const int mn = m0 + NGW * 4; const bool more = mn < T;
        if (more) RQ_LOAD(na, nb, mn);
#pragma unroll
        for (int r = 0; r < 4; ++r) { const int m = m0 + r; const float rs = rs_from(*(const f32x4*)(ssq + (size_t)m * 4));
            const unsigned wv[8] = {va[r].x, va[r].y, va[r].z, va[r].w, vb[r].x, vb[r].y, vb[r].z, vb[r].w};
            float am = 0.f;
#pragma unroll
            for (int i = 0; i < 8; ++i) am = fmaxf(am, fmaxf(fabsf(bflo(wv[i])), fabsf(bfhi(wv[i]))));
            am = wave_max(am) * rs; const float inv = am > 0.f ? 127.0f / am : 0.f, qs = rs * inv;
            unsigned o[4];
#pragma unroll
            for (int i = 0; i < 4; ++i) { const int q0 = (int)rintf(bflo(wv[2 * i]) * qs), q1 = (int)rintf(bfhi(wv[2 * i]) * qs), q2 = (int)rintf(bflo(wv[2 * i + 1]) * qs), q3 = (int)rintf(bfhi(wv[2 * i + 1]) * qs);
                o[i] = ((unsigned)q0 & 0xffu) | (((unsigned)q1 & 0xffu) << 8) | (((unsigned)q2 & 0xffu) << 16) | (((unsigned)q3 & 0xffu) << 24); }
            u32x2* d8 = (u32x2*)((signed char*)(ws + WS_XB8D) + (size_t)m * D) + lane;
            d8[0] = (u32x2){o[0], o[1]}; d8[64] = (u32x2){o[2], o[3]};
            if (lane == 0) ((float*)(ws + WS_SA))[m] = am * (1.0f / 127.0f); }
        if (!more) break;
        m0 = mn;
#pragma unroll
        for (int r = 0; r < 4; ++r) { va[r] = na[r]; vb[r] = nb[r]; } }
#undef RQ_LOAD
}

struct Mix { int l; const bf16* proj; const float *convw, *convb, *bif, *skip, *mhg, *gmvg, *bsp, *gmog; const bf16 *wg, *wq, *wk, *wv, *wsp; };
constexpr int L_XM = 0, L_XC = 18432, L_Q = 35840, L_K = 53248, L_KTW = 70656, L_VT = 89088, L_SM = 110592;
constexpr int L_RED = L_Q;
constexpr int S128 = 272, S64 = 144;
DI bf16x8 ldf(const LAS unsigned char* p) { return *(const LAS bf16x8*)p; }

DI void load_xm_conv(const Frame& F, const Mix& M, int t0, bool first, int h) {
    LAS unsigned char* lds = F.lds; const int tid = F.tid;
#pragma unroll
    for (int it = 0; it < 3; ++it) { const int p = tid + 512 * it; if (p < 67 * 16) { const int row = p >> 4, c16 = p & 15; u32x4 v = (u32x4){0u, 0u, 0u, 0u};
        if (!(first && row < 3)) v = *(const u32x4*)(M.proj + (size_t)(t0 - 3 + row) * DIN + h * 128 + c16 * 8);
        *(LAS u32x4*)(lds + L_XM + row * S128 + c16 * 16) = v; } }
    const int cg = tid & 15, ch = h * 128 + cg * 8;
    float cw[4][8], cb[8];
#pragma unroll
    for (int j = 0; j < 4; ++j) { const f32x4 a = *(const f32x4*)(M.convw + j * 512 + ch), b = *(const f32x4*)(M.convw + j * 512 + ch + 4);
        cw[j][0] = a.x; cw[j][1] = a.y; cw[j][2] = a.z; cw[j][3] = a.w; cw[j][4] = b.x; cw[j][5] = b.y; cw[j][6] = b.z; cw[j][7] = b.w; }
    { const f32x4 a = *(const f32x4*)(M.convb + ch), b = *(const f32x4*)(M.convb + ch + 4); cb[0] = a.x; cb[1] = a.y; cb[2] = a.z; cb[3] = a.w; cb[4] = b.x; cb[5] = b.y; cb[6] = b.z; cb[7] = b.w; }
    __syncthreads();
#pragma unroll
    for (int it = 0; it < 2; ++it) { const int t = (tid >> 4) + 32 * it; float y[8];
#pragma unroll
        for (int c = 0; c < 8; ++c) y[c] = cb[c];
#pragma unroll
        for (int j = 0; j < 4; ++j) { const u32x4 x = *(const LAS u32x4*)(lds + L_XM + (t + j) * S128 + cg * 16);
            y[0] += cw[j][0] * bflo(x.x); y[1] += cw[j][1] * bfhi(x.x); y[2] += cw[j][2] * bflo(x.y); y[3] += cw[j][3] * bfhi(x.y);
            y[4] += cw[j][4] * bflo(x.z); y[5] += cw[j][5] * bfhi(x.z); y[6] += cw[j][6] * bflo(x.w); y[7] += cw[j][7] * bfhi(x.w); }
        u32x4 o; o.x = pk2(siluf(y[0]), siluf(y[1])); o.y = pk2(siluf(y[2]), siluf(y[3])); o.z = pk2(siluf(y[4]), siluf(y[5])); o.w = pk2(siluf(y[6]), siluf(y[7]));
        *(LAS u32x4*)(lds + L_XC + t * S128 + cg * 16) = o; }
    __syncthreads();
}

DI void mlstm_local_unit(const Frame& F, const Mix& M, int u) {
    LAS unsigned char* lds = F.lds; const int tid = F.tid, lane = F.lane, w = F.wave, fr = lane & 15, fq = lane >> 4;
    const int t0 = u * CH; const bool first = (u % NCH) == 0; const int bb = u / NCH, cc = u % NCH;
    LAS float* IG = (LAS float*)(lds + L_SM); LAS float* BBs = IG + 256; LAS float* WSC = IG + 512;
    unsigned char* ws = F.ws;
    if (tid < 16 * 8) { const int row = 128 + (tid >> 3), c = tid & 7; const unsigned v = (row == 128) ? 0x3f803f80u : 0u; *(LAS u32x4*)(lds + L_VT + row * S64 + c * 16) = (u32x4){v, v, v, v}; }
    f32x4 accg[4];
#pragma unroll
    for (int tt = 0; tt < 4; ++tt) accg[tt] = (f32x4){0.f, 0.f, 0.f, 0.f};
    for (int h = 0; h < 4; ++h) {
        load_xm_conv(F, M, t0, first, h);
        const int cbase = (w < 4) ? (h * 128 + 32 * w) : (512 + h * 128 + 32 * (w - 4));
        const bf16x8 a = *(const bf16x8*)(M.wg + (size_t)fr * 1024 + cbase + 8 * fq);
#pragma unroll
        for (int tt = 0; tt < 4; ++tt) { const int t = 16 * tt + fr;
            const bf16x8 b = (w < 4) ? ldf(lds + L_XC + t * S128 + (32 * w + 8 * fq) * 2) : ldf(lds + L_XM + (t + 3) * S128 + (32 * (w - 4) + 8 * fq) * 2);
            accg[tt] = MFMA16(a, b, accg[tt]); }
        __syncthreads();
    }
    if (fq < 2) {
#pragma unroll
        for (int tt = 0; tt < 4; ++tt)
#pragma unroll
            for (int r = 0; r < 4; ++r) *(LAS float*)(lds + L_RED + ((w * 8 + 4 * fq + r) * 64 + 16 * tt + fr) * 4) = accg[tt][r];
    }
    __syncthreads();
    { float pre = M.bif[w];
#pragma unroll
      for (int ww = 0; ww < 8; ++ww) pre += *(const LAS float*)(lds + L_RED + ((ww * 8 + w) * 64 + lane) * 4);
      if (w < 4) IG[w * 64 + lane] = pre;
      else { float lf = fminf(pre, 0.f) - softplus_neg(fabsf(pre));
#pragma unroll
          for (int o = 1; o < 64; o <<= 1) { const float v = __shfl_up(lf, o); if (lane >= o) lf += v; }
          BBs[(w - 4) * 64 + lane] = lf; } }
    __syncthreads();
    if (w < 4) { const float bt = BBs[w * 64 + lane], g = IG[w * 64 + lane] - bt, gmax = wave_max(g), bend = BBs[w * 64 + 63];
        WSC[w * 64 + lane] = fexp(g - gmax);
        float* gb = (float*)(ws + WS_GB) + (size_t)(u * 4 + w) * 128; gb[lane] = bt; gb[64 + lane] = g;
        if (lane == 0) { float* sc = (float*)(ws + WS_SC) + ((size_t)(bb * 4 + w) * NCH + cc) * 2; sc[0] = bend; sc[1] = bend + gmax; } }
    __syncthreads();
    for (int h = 0; h < 4; ++h) {
        load_xm_conv(F, M, t0, first, h);
        const int lh = M.l * 4 + h;
        bf16x8 aq[4], bk[4], bv[4];
#pragma unroll
        for (int ks = 0; ks < 4; ++ks) { const size_t o = ((size_t)lh * 128 + 16 * w + fr) * 128 + 32 * ks + 8 * fq;
            aq[ks] = *(const bf16x8*)(M.wq + o); bk[ks] = *(const bf16x8*)(M.wk + o); bv[ks] = *(const bf16x8*)(M.wv + o); }
#pragma unroll
        for (int tt = 0; tt < 4; ++tt) {
            bf16x8 xcf[4], xmf[4];
#pragma unroll
            for (int ks = 0; ks < 4; ++ks) { xcf[ks] = ldf(lds + L_XC + (16 * tt + fr) * S128 + (32 * ks + 8 * fq) * 2); xmf[ks] = ldf(lds + L_XM + (16 * tt + fr + 3) * S128 + (32 * ks + 8 * fq) * 2); }
            f32x4 cq = (f32x4){0.f, 0.f, 0.f, 0.f}, ck = cq, ckt = cq, cv = cq;
#pragma unroll
            for (int ks = 0; ks < 4; ++ks) { cq = MFMA16(aq[ks], xcf[ks], cq); ck = MFMA16(bk[ks], xcf[ks], ck); ckt = MFMA16(xcf[ks], bk[ks], ckt); cv = MFMA16(xmf[ks], bv[ks], cv); }
            { const int t = 16 * tt + fr, e = 16 * w + 4 * fq;
              u32x2 o; o.x = pk2(cq[0] * 0.08838834764831845f, cq[1] * 0.08838834764831845f); o.y = pk2(cq[2] * 0.08838834764831845f, cq[3] * 0.08838834764831845f);
              *(LAS u32x2*)(lds + L_Q + t * S128 + e * 2) = o;
              o.x = pk2(ck[0], ck[1]); o.y = pk2(ck[2], ck[3]); *(LAS u32x2*)(lds + L_K + t * S128 + e * 2) = o; }
            { const int s = 16 * tt + 4 * fq, e = 16 * w + fr;
              const f32x4 wv = *(const LAS f32x4*)(WSC + h * 64 + s);
              u32x2 o; o.x = pk2(ckt[0] * wv.x, ckt[1] * wv.y); o.y = pk2(ckt[2] * wv.z, ckt[3] * wv.w); *(LAS u32x2*)(lds + L_KTW + e * S64 + s * 2) = o;
              o.x = pk2(cv[0], cv[1]); o.y = pk2(cv[2], cv[3]); *(LAS u32x2*)(lds + L_VT + e * S64 + s * 2) = o; }
        }
        __syncthreads();
        { bf16* qg = (bf16*)(ws + WS_QG) + (size_t)(u * 4 + h) * 8192; bf16* kg = (bf16*)(ws + WS_KG) + (size_t)(u * 4 + h) * 8192; bf16* vg = (bf16*)(ws + WS_VG) + (size_t)(u * 4 + h) * 8192;
#pragma unroll
          for (int i = 0; i < 2; ++i) { const int p = tid + 512 * i; { const int row = p >> 4, c16 = p & 15;
              *(u32x4*)(qg + row * 128 + c16 * 8) = *(const LAS u32x4*)(lds + L_Q + row * S128 + c16 * 16); *(u32x4*)(kg + row * 128 + c16 * 8) = *(const LAS u32x4*)(lds + L_K + row * S128 + c16 * 16); }
              { const int row = p >> 3, c8 = p & 7; *(u32x4*)(vg + row * 64 + c8 * 8) = *(const LAS u32x4*)(lds + L_VT + row * S64 + c8 * 16); } } }
        { bf16x8 ak[2];
#pragma unroll
          for (int ks = 0; ks < 2; ++ks) ak[ks] = ldf(lds + L_KTW + (16 * w + fr) * S64 + (32 * ks + 8 * fq) * 2);
          bf16* st = (bf16*)(ws + WS_ST) + (size_t)(u * 4 + h) * 144 * 128;
#pragma unroll
          for (int vt = 0; vt < 9; ++vt) { f32x4 c = (f32x4){0.f, 0.f, 0.f, 0.f};
#pragma unroll
              for (int ks = 0; ks < 2; ++ks) c = MFMA16(ak[ks], ldf(lds + L_VT + (16 * vt + fr) * S64 + (32 * ks + 8 * fq) * 2), c);
              u32x2 o; o.x = pk2(c[0], c[1]); o.y = pk2(c[2], c[3]); *(u32x2*)(st + (size_t)(16 * vt + fr) * 128 + 16 * w + 4 * fq) = o; } }
        __syncthreads();
    }
}

DI bf16x8 cat2(u32x2 a, u32x2 b) { u32x4 o; o.x = a.x; o.y = a.y; o.z = b.x; o.w = b.y; return __builtin_bit_cast(bf16x8, o); }
constexpr int L3_XC = 0, S3_XC = 1040;
constexpr int L3_XM = 66560;
constexpr int L3_VT = 85504, L3_VT2 = 106496;
constexpr int L3_SM = 127232;
#ifndef PROBE_P1
#define PROBE_P1 0
#endif
#ifndef PROBE_ST
#define PROBE_ST 0
#endif
#ifndef PROBE_A
#define PROBE_A 0
#endif
#ifndef PROBE_B
#define PROBE_B 0
#endif
#ifndef PROBE_P2
#define PROBE_P2 0
#endif
DI void mlstm_local3(const Frame& F, const Mix& M, int u) {
    LAS unsigned char* lds = F.lds; const int tid = F.tid, lane = F.lane, w = F.wave, fr = lane & 15, fq = lane >> 4;
    const int t0 = u * CH; const bool first = (u % NCH) == 0; const int bb = u / NCH, cc = u % NCH;
    LAS float* IG = (LAS float*)(lds + L3_SM); LAS float* BBs = IG + 256; LAS float* WSC = IG + 512;
    unsigned char* ws = F.ws;
    { const int b = tid >> 8, i = tid & 255, row = 128 + (i >> 4), c = i & 15; const unsigned v = (row == 128) ? 0x3f803f80u : 0u; LAS unsigned* p = (LAS unsigned*)(lds + (b ? L3_VT2 : L3_VT) + row * S64 + c * 8); p[0] = v; p[1] = v; }
    u32x4 xq[3];
#define L3_LOADX(hh) do { _Pragma("unroll") for (int it = 0; it < 3; ++it) { const int p = tid + 512 * it; xq[it] = (u32x4){0u, 0u, 0u, 0u}; if (p < 67 * 16) { const int row = p >> 4, c16 = p & 15; \
        if (!(first && row < 3)) xq[it] = *(const u32x4*)(M.proj + (size_t)(t0 - 3 + row) * DIN + (hh) * 128 + c16 * 8); } } } while (0)
#define L3_STOREX() do { _Pragma("unroll") for (int it = 0; it < 3; ++it) { const int p = tid + 512 * it; if (p < 67 * 16) { const int row = p >> 4, c16 = p & 15; *(LAS u32x4*)(lds + L3_XM + row * S128 + c16 * 16) = xq[it]; } } } while (0)
    f32x4 accg[4];
#pragma unroll 1
    for (int rp1 = 0; rp1 < 1 + PROBE_P1; ++rp1) {
    L3_LOADX(0);
#pragma unroll
    for (int tt = 0; tt < 4; ++tt) accg[tt] = (f32x4){0.f, 0.f, 0.f, 0.f};
#pragma unroll 1
    for (int h = 0; h < 4; ++h) {
        L3_STOREX();
        const int cg = tid & 15, ch = h * 128 + cg * 8;
        float cw[4][8], cb[8];
#pragma unroll
        for (int j = 0; j < 4; ++j) { const f32x4 a = *(const f32x4*)(M.convw + j * 512 + ch), b = *(const f32x4*)(M.convw + j * 512 + ch + 4);
            cw[j][0] = a.x; cw[j][1] = a.y; cw[j][2] = a.z; cw[j][3] = a.w; cw[j][4] = b.x; cw[j][5] = b.y; cw[j][6] = b.z; cw[j][7] = b.w; }
        { const f32x4 a = *(const f32x4*)(M.convb + ch), b = *(const f32x4*)(M.convb + ch + 4); cb[0] = a.x; cb[1] = a.y; cb[2] = a.z; cb[3] = a.w; cb[4] = b.x; cb[5] = b.y; cb[6] = b.z; cb[7] = b.w; }
        __syncthreads();
        if (h < 3) L3_LOADX(h + 1);
        bf16* xcg = (bf16*)(ws + WS_XCG) + ((size_t)u * 4 + h) * 8192;
#pragma unroll 1
        for (int it = 0; it < 2; ++it) { const int t = (tid >> 4) + 32 * it; float y[8];
#pragma unroll
            for (int c = 0; c < 8; ++c) y[c] = cb[c];
#pragma unroll
            for (int j = 0; j < 4; ++j) { const u32x4 x = *(const LAS u32x4*)(lds + L3_XM + (t + j) * S128 + cg * 16);
                y[0] += cw[j][0] * bflo(x.x); y[1] += cw[j][1] * bfhi(x.x); y[2] += cw[j][2] * bflo(x.y); y[3] += cw[j][3] * bfhi(x.y);
                y[4] += cw[j][4] * bflo(x.z); y[5] += cw[j][5] * bfhi(x.z); y[6] += cw[j][6] * bflo(x.w); y[7] += cw[j][7] * bfhi(x.w); }
            u32x4 o; o.x = pk2(siluf(y[0]), siluf(y[1])); o.y = pk2(siluf(y[2]), siluf(y[3])); o.z = pk2(siluf(y[4]), siluf(y[5])); o.w = pk2(siluf(y[6]), siluf(y[7]));
            *(LAS u32x4*)(lds + L3_XC + t * S3_XC + (h * 128 + cg * 8) * 2) = o;
            *(u32x4*)(xcg + (size_t)t * 128 + cg * 8) = o; }
        const int cbase = (w < 4) ? (h * 128 + 32 * w) : (512 + h * 128 + 32 * (w - 4));
        const bf16x8 ag = *(const bf16x8*)(M.wg + (size_t)fr * 1024 + cbase + 8 * fq);
        __syncthreads();
#pragma unroll
        for (int tt = 0; tt < 4; ++tt) { const int t = 16 * tt + fr;
            const bf16x8 b = (w < 4) ? ldf(lds + L3_XC + t * S3_XC + (h * 128 + 32 * w + 8 * fq) * 2) : ldf(lds + L3_XM + (t + 3) * S128 + (32 * (w - 4) + 8 * fq) * 2);
            accg[tt] = MFMA16(ag, b, accg[tt]); }
        __syncthreads();
    }
    }
    if (fq < 2) {
#pragma unroll
        for (int tt = 0; tt < 4; ++tt)
#pragma unroll
            for (int r = 0; r < 4; ++r) *(LAS float*)(lds + L3_VT2 + ((w * 8 + 4 * fq + r) * 64 + 16 * tt + fr) * 4) = accg[tt][r];
    }
    __syncthreads();
    { float pre = M.bif[w];
#pragma unroll
      for (int ww = 0; ww < 8; ++ww) pre += *(const LAS float*)(lds + L3_VT2 + ((ww * 8 + w) * 64 + lane) * 4);
      if (w < 4) IG[w * 64 + lane] = pre;
      else { float lf = fminf(pre, 0.f) - softplus_neg(fabsf(pre));
#pragma unroll
          for (int o = 1; o < 64; o <<= 1) { const float v = __shfl_up(lf, o); if (lane >= o) lf += v; }
          BBs[(w - 4) * 64 + lane] = lf; } }
    __syncthreads();
    if (w < 4) { const float bt = BBs[w * 64 + lane], g = IG[w * 64 + lane] - bt, gmax = wave_max(g), bend = BBs[w * 64 + 63];
        WSC[w * 64 + lane] = fexp(g - gmax);
        float* gb = (float*)(ws + WS_GB) + (size_t)(u * 4 + w) * 128; gb[lane] = bt; gb[64 + lane] = g;
        if (lane == 0) { float* sc = (float*)(ws + WS_SC) + ((size_t)(bb * 4 + w) * NCH + cc) * 2; sc[0] = bend; sc[1] = bend + gmax; } }
    __syncthreads();
    bf16x8 aq[4], bk[4], bv[4], nq[4], nk[4], nv[4];
#define L3_LOADW(hh, Q_, K_, V_) do { _Pragma("unroll") for (int ks = 0; ks < 4; ++ks) { const size_t o_ = ((size_t)(M.l * 4 + (hh)) * 128 + 16 * w + fr) * 128 + 32 * ks + 8 * fq; \
        Q_[ks] = *(const bf16x8*)(M.wq + o_); K_[ks] = *(const bf16x8*)(M.wk + o_); V_[ks] = *(const bf16x8*)(M.wv + o_); } } while (0)
    L3_LOADW(0, aq, bk, bv);
    L3_LOADX(0);
#pragma unroll 1
    for (int h = 0; h < 4; ++h) {
        L3_STOREX(); __syncthreads();
        const size_t uh = (size_t)u * 4 + h;
        LAS unsigned char* VT = lds + ((h & 1) ? L3_VT2 : L3_VT);
        bf16* qg = (bf16*)(ws + WS_QG) + uh * 8192; bf16* kg = (bf16*)(ws + WS_KG) + uh * 8192; bf16* vg = (bf16*)(ws + WS_VG) + uh * 8192; bf16* st = (bf16*)(ws + WS_ST) + uh * 144 * 128;
        u32x2 KP[4], QO[4], KO[4], VO[4];
#pragma unroll 1
        for (int _pa = 0; _pa < 1 + PROBE_A; ++_pa) {
#pragma unroll
        for (int tt = 0; tt < 4; ++tt) {
            bf16x8 xcf[4], xmf[4];
#pragma unroll
            for (int ks = 0; ks < 4; ++ks) { xcf[ks] = ldf(lds + L3_XC + (16 * tt + fr) * S3_XC + (h * 128 + 32 * ks + 8 * fq) * 2); xmf[ks] = ldf(lds + L3_XM + (16 * tt + fr + 3) * S128 + (32 * ks + 8 * fq) * 2); }
            f32x4 cq = (f32x4){0.f, 0.f, 0.f, 0.f}, ck = cq, ckt = cq, cv = cq;
#pragma unroll
            for (int ks = 0; ks < 4; ++ks) { cq = MFMA16(aq[ks], xcf[ks], cq); ck = MFMA16(bk[ks], xcf[ks], ck); ckt = MFMA16(xcf[ks], bk[ks], ckt); cv = MFMA16(xmf[ks], bv[ks], cv); }
            QO[tt].x = pk2(cq[0] * 0.08838834764831845f, cq[1] * 0.08838834764831845f); QO[tt].y = pk2(cq[2] * 0.08838834764831845f, cq[3] * 0.08838834764831845f);
            KO[tt].x = pk2(ck[0], ck[1]); KO[tt].y = pk2(ck[2], ck[3]);
            { const int s = 16 * tt + 4 * fq, e = 16 * w + fr;
              const f32x4 wv = *(const LAS f32x4*)(WSC + h * 64 + s);
              KP[tt].x = pk2(ckt[0] * wv.x, ckt[1] * wv.y); KP[tt].y = pk2(ckt[2] * wv.z, ckt[3] * wv.w);
              VO[tt].x = pk2(cv[0], cv[1]); VO[tt].y = pk2(cv[2], cv[3]); *(LAS u32x2*)(VT + e * S64 + s * 2) = VO[tt]; }
        }
        }
        if (h < 3) { L3_LOADX(h + 1); L3_LOADW(h + 1, nq, nk, nv); }
#pragma unroll
        for (int tt = 0; tt < 4; ++tt) { const size_t off = (size_t)((tt * 8 + w) * 256 + fr * 16 + 4 * fq);
            for (int _r = 0; _r < 1 + PROBE_ST; ++_r) { *(u32x2*)(qg + off) = QO[tt]; *(u32x2*)(kg + off) = KO[tt]; *(u32x2*)(vg + (size_t)((w * 4 + tt) * 256 + fr * 16 + 4 * fq)) = VO[tt]; asm volatile("" ::: "memory"); } }
        __syncthreads();
#pragma unroll 1
        for (int _pb = 0; _pb < 1 + PROBE_B; ++_pb)
        { const bf16x8 ak0 = cat2(KP[0], KP[1]), ak1 = cat2(KP[2], KP[3]);
#pragma unroll
          for (int vt = 0; vt < 9; ++vt) { const LAS unsigned char* vr = VT + (16 * vt + fr) * S64 + 8 * fq;
              const u32x2 v0 = *(const LAS u32x2*)(vr), v1 = *(const LAS u32x2*)(vr + 32), v2 = *(const LAS u32x2*)(vr + 64), v3 = *(const LAS u32x2*)(vr + 96);
              f32x4 c = (f32x4){0.f, 0.f, 0.f, 0.f}; c = MFMA16(ak0, cat2(v0, v1), c); c = MFMA16(ak1, cat2(v2, v3), c);
              u32x2 o; o.x = pk2(c[0], c[1]); o.y = pk2(c[2], c[3]); for (int _r = 0; _r < 1 + PROBE_ST; ++_r) { *(u32x2*)(st + (size_t)((vt * 8 + w) * 256 + fr * 16 + 4 * fq)) = o; asm volatile("" ::: "memory"); } } }
#pragma unroll
        for (int ks = 0; ks < 4; ++ks) { aq[ks] = nq[ks]; bk[ks] = nk[ks]; bv[ks] = nv[ks]; }
    }
    __syncthreads();
#undef L3_LOADW
#undef L3_LOADX
#undef L3_STOREX
}

constexpr int L_VNT = 0;
constexpr int L_MU = 36864;
DI void gmlp_unit(const Frame& F, const Mix& M, int ub) {
    LAS unsigned char* lds = F.lds; const int tid = F.tid, lane = F.lane, w = F.wave, fr = lane & 15, fq = lane >> 4;
    const int t0 = ub * 128;
    LAS float* MU = (LAS float*)(lds + L_MU); LAS float* RS = MU + 128; LAS float* GOL = MU + 256; LAS float* GVL = MU + 768;
    GOL[tid] = M.gmog[tid]; GVL[tid] = M.gmvg[tid];
    if (tid < 128) { const f32x4* p = (const f32x4*)((const float*)(F.ws + WS_VST) + (size_t)(t0 + tid) * 16); const f32x4 a = p[0], b = p[1], c = p[2], d = p[3];
        const float s1 = (a.x + a.z) + (b.x + b.z) + (c.x + c.z) + (d.x + d.z), s2 = (a.y + a.w) + (b.y + b.w) + (c.y + c.w) + (d.y + d.w);
        const float mu = s1 * (1.0f / 512.0f), var = fmaxf(s2 * (1.0f / 512.0f) - mu * mu, 0.f); MU[tid] = mu; RS[tid] = 1.0f / sqrtf(var + EPS); }
    float ss = 0.f;
    const int i_tok = 16 * w + fr;
    bf16* py = (bf16*)(F.ws + WS_Y) + (size_t)(t0 + i_tok) * D + 512 + 8 * fq;
    const int j = tid & 127, cq = tid >> 7;
    u32x4 xv[4]; bf16x8 bwn[4]; u32x4 ugn[4]; float biasn;
#define GM_ISSUE(g) do { const bf16* pv_ = M.proj + (size_t)(t0 + j) * DIN + 1536 + (g) * 128 + 32 * cq; _Pragma("unroll") for (int i = 0; i < 4; ++i) xv[i] = *(const u32x4*)(pv_ + 8 * i); \
        const bf16* pw_ = M.wsp + ((size_t)(M.l * 4 + (g)) * 128 + i_tok) * 128 + 8 * fq; _Pragma("unroll") for (int ks = 0; ks < 4; ++ks) bwn[ks] = *(const bf16x8*)(pw_ + 32 * ks); \
        biasn = M.bsp[(g) * 128 + i_tok]; const bf16* pu_ = M.proj + (size_t)(t0 + i_tok) * DIN + 1024 + (g) * 128 + 8 * fq; _Pragma("unroll") for (int p = 0; p < 4; ++p) ugn[p] = *(const u32x4*)(pu_ + 32 * p); } while (0)
    GM_ISSUE(0);
    LBAR();
#pragma unroll 1
    for (int g = 0; g < 4; ++g) {
        { const float mu = MU[j], rs = RS[j];
#pragma unroll
          for (int i = 0; i < 4; ++i) { const int c0 = 32 * cq + 8 * i; const u32x4 x = xv[i];
              const f32x4 ga = *(const LAS f32x4*)(GVL + g * 128 + c0), gb = *(const LAS f32x4*)(GVL + g * 128 + c0 + 4);
              const float v[8] = {(bflo(x.x) - mu) * rs * ga.x, (bfhi(x.x) - mu) * rs * ga.y, (bflo(x.y) - mu) * rs * ga.z, (bfhi(x.y) - mu) * rs * ga.w,
                                  (bflo(x.z) - mu) * rs * gb.x, (bfhi(x.z) - mu) * rs * gb.y, (bflo(x.w) - mu) * rs * gb.z, (bfhi(x.w) - mu) * rs * gb.w};
#pragma unroll
              for (int c = 0; c < 8; ++c) *(LAS bf16*)(lds + L_VNT + (32 * cq + 16 * (c >> 2) + 4 * i + (c & 3)) * S128 + j * 2) = (bf16)f2bf(v[c]); } }
        bf16x8 bw[4]; u32x4 ugv[4]; const float bias = biasn;
#pragma unroll
        for (int ks = 0; ks < 4; ++ks) bw[ks] = bwn[ks];
#pragma unroll
        for (int p = 0; p < 4; ++p) ugv[p] = ugn[p];
        LBAR();
        if (g < 3) GM_ISSUE(g + 1);
#pragma unroll
        for (int p = 0; p < 4; ++p) { f32x4 ce = (f32x4){0.f, 0.f, 0.f, 0.f}, co = ce;
#pragma unroll
            for (int ks = 0; ks < 4; ++ks) { ce = MFMA16(ldf(lds + L_VNT + (32 * p + fr) * S128 + (32 * ks + 8 * fq) * 2), bw[ks], ce); co = MFMA16(ldf(lds + L_VNT + (32 * p + 16 + fr) * S128 + (32 * ks + 8 * fq) * 2), bw[ks], co); }
            const u32x4 ug = ugv[p];
            u32x4 o; o.x = pk2(bflo(ug.x) * (ce[0] + bias), bfhi(ug.x) * (ce[1] + bias)); o.y = pk2(bflo(ug.y) * (ce[2] + bias), bfhi(ug.y) * (ce[3] + bias));
            o.z = pk2(bflo(ug.z) * (co[0] + bias), bfhi(ug.z) * (co[1] + bias)); o.w = pk2(bflo(ug.w) * (co[2] + bias), bfhi(ug.w) * (co[3] + bias));
#pragma unroll
            for (int q = 0; q < 4; ++q) { const float z0 = bflo(o[q]), z1 = bfhi(o[q]); ss += z0 * z0 + z1 * z1; }
            *(u32x4*)(py + g * 128 + 32 * p) = o; }
        LBAR();
    }
#undef GM_ISSUE
    ss += __shfl_xor(ss, 16); ss += __shfl_xor(ss, 32);
    const float r = 1.0f / sqrtf(ss * (1.0f / 512.0f) + EPS);
    VM_WAIT();
    u32x4 yv[4][4];
#pragma unroll
    for (int g = 0; g < 4; ++g)
#pragma unroll
        for (int p = 0; p < 4; ++p) yv[g][p] = *(const u32x4*)(py + g * 128 + 32 * p);
#pragma unroll
    for (int g = 0; g < 4; ++g)
#pragma unroll
        for (int p = 0; p < 4; ++p) { const f32x4 g0 = *(const LAS f32x4*)(GOL + g * 128 + 32 * p + 8 * fq), g1 = *(const LAS f32x4*)(GOL + g * 128 + 32 * p + 8 * fq + 4); const u32x4 x = yv[g][p];
            u32x4 o; o.x = pk2(bflo(x.x) * r * g0.x, bfhi(x.x) * r * g0.y); o.y = pk2(bflo(x.y) * r * g0.z, bfhi(x.y) * r * g0.w); o.z = pk2(bflo(x.z) * r * g1.x, bfhi(x.z) * r * g1.y); o.w = pk2(bflo(x.w) * r * g1.z, bfhi(x.w) * r * g1.w);
            *(u32x4*)(py + g * 128 + 32 * p) = o; }
}

DI void mlstm_scan(const Frame& F) {
    unsigned char* ws = F.ws;
    const int gt = (F.vcu * 8 + F.wave) * 64 + F.lane, NGT = F.G * 512;
    constexpr int PER_BH = 128 * 64;
    for (int it = gt; it < 16 * PER_BH; it += NGT) {
        const int bh = it / PER_BH, rem = it % PER_BH, b = bh >> 2, h = bh & 3;
        const bool extra = rem < 64;
        const int XOFF = (64 + (rem >> 3)) * 128 + (rem & 7) - rem;
        const float* sc = (const float*)(ws + WS_SC) + (size_t)bh * NCH * 2;
        unsigned* st = (unsigned*)((bf16*)(ws + WS_ST) + ((size_t)(b * NCH) * 4 + h) * 144 * 128) + rem;
        float* mp = (float*)(ws + WS_MP);
        float c0 = 0.f, c1 = 0.f, n0 = 0.f, n1 = 0.f, m = 0.f;
        unsigned x[16], y[16], xn[16], yn[16];
#pragma unroll
        for (int j = 0; j < 16; ++j) { x[j] = st[(size_t)j * 36864]; y[j] = extra ? st[(size_t)j * 36864 + XOFF] : 0u; }
#pragma unroll 1
        for (int cb = 0; cb < NCH; cb += 16) {
            const int nb = (cb + 16 < NCH) ? cb + 16 : cb;
#pragma unroll
            for (int j = 0; j < 16; ++j) { xn[j] = st[(size_t)(nb + j) * 36864]; yn[j] = extra ? st[(size_t)(nb + j) * 36864 + XOFF] : 0u; }
#pragma unroll
            for (int j = 0; j < 16; ++j) { const int c = cb + j; const float bend = sc[2 * c], mloc = sc[2 * c + 1];
                const float mn = fmaxf(bend + m, mloc), a = fexp(bend + m - mn), s = fexp(mloc - mn);
                const unsigned oc = pk2(c0, c1), on = pk2(n0, n1); const float om = m;
                c0 = a * c0 + s * bflo(x[j]); c1 = a * c1 + s * bfhi(x[j]); n0 = a * n0 + s * bflo(y[j]); n1 = a * n1 + s * bfhi(y[j]); m = mn;
                x[j] = oc; y[j] = on; if (rem == 0) mp[(size_t)(b * NCH + c) * 4 + h] = om; }
#pragma unroll
            for (int j = 0; j < 16; ++j) { st[(size_t)(cb + j) * 36864] = x[j]; if (extra) st[(size_t)(cb + j) * 36864 + XOFF] = y[j]; }
#pragma unroll
            for (int j = 0; j < 16; ++j) { x[j] = xn[j]; y[j] = yn[j]; }
        }
    }
}

constexpr int L_CP = 70656;
constexpr int L_VT_D = 109824, L_P = 0, L_SD = 9216, L_HM = L_Q;
constexpr int L_PAR = 12288;
DI void mlstm_out_stage_params(const Frame& F, const Mix& M) { LAS float* P = (LAS float*)(F.lds + L_PAR); P[F.tid] = M.mhg[F.tid]; P[512 + F.tid] = M.skip[F.tid]; }
struct OutLoads { u32x4 q[2], k[2], v[2], c[5], xc[2]; u32x2 og[4]; float bt, g, mprev; };
DI void mlstm_out_issue(const Frame& F, const Mix& M, int u, int h, OutLoads& R) {
    const int tid = F.tid, lane = F.lane, w = F.wave, fr = lane & 15, fq = lane >> 4; unsigned char* ws = F.ws;
    const size_t uh = (size_t)u * 4 + h; const int t0 = u * CH;
    const bf16* qg = (const bf16*)(ws + WS_QG) + uh * 8192; const bf16* kg = (const bf16*)(ws + WS_KG) + uh * 8192; const bf16* vg = (const bf16*)(ws + WS_VG) + uh * 8192;
    const bf16* cp = (const bf16*)(ws + WS_ST) + uh * 144 * 128;
#pragma unroll
    for (int i = 0; i < 2; ++i) { const int p = tid + 512 * i; R.q[i] = *(const u32x4*)(qg + p * 8); R.k[i] = *(const u32x4*)(kg + p * 8); R.v[i] = *(const u32x4*)(vg + p * 8); }
#pragma unroll
    for (int i = 0; i < 5; ++i) { const int p = tid + 512 * i; R.c[i] = (u32x4){0u, 0u, 0u, 0u}; if (p < 72 * 32) R.c[i] = *(const u32x4*)(cp + p * 8); }
    { const int tt = w & 3, vh = w >> 2, t = 16 * tt + fr; const bf16* og = M.proj + (size_t)(t0 + t) * DIN + 512 + h * 128 + 64 * vh + 4 * fq;
#pragma unroll
      for (int j = 0; j < 4; ++j) R.og[j] = *(const u32x2*)(og + 16 * j); }
    { const int t = tid >> 3, v0 = 16 * (tid & 7); const bf16* xcp = (const bf16*)(ws + WS_XCG) + uh * 8192 + (size_t)t * 128 + v0; R.xc[0] = *(const u32x4*)(xcp); R.xc[1] = *(const u32x4*)(xcp + 8); }
    R.bt = 0.f; R.g = 0.f; R.mprev = 0.f;
    if (w == 0) { const float* gb = (const float*)(ws + WS_GB) + uh * 128; R.bt = gb[lane]; R.g = gb[64 + lane]; R.mprev = ((const float*)(ws + WS_MP))[uh]; }
}
DI void mlstm_out_item(const Frame& F, const Mix& M, int u, int h, const OutLoads& R, bool has_next, int un, int hn, OutLoads& RN) {
    LAS unsigned char* lds = F.lds; const int tid = F.tid, lane = F.lane, w = F.wave, fr = lane & 15, fq = lane >> 4;
    const int t0 = u * CH;
    LAS float* AT = (LAS float*)(lds + L_SD); LAS float* DF = AT + 64; LAS float* EG = AT + 128; LAS float* MT = AT + 448;
    const LAS float* PAR = (const LAS float*)(lds + L_PAR);
    bf16* Y = (bf16*)(F.ws + WS_Y);
#pragma unroll
    for (int i = 0; i < 2; ++i) { const int p = tid + 512 * i, tile = p >> 5, rem = p & 31;
        { const int row = 16 * (tile >> 3) + (rem >> 1), col = 16 * (tile & 7) + 8 * (rem & 1);
          *(LAS u32x4*)(lds + L_Q + row * S128 + col * 2) = R.q[i]; *(LAS u32x4*)(lds + L_K + row * S128 + col * 2) = R.k[i]; }
        { const int row = 16 * (tile >> 2) + (rem >> 1), col = 16 * (tile & 3) + 8 * (rem & 1);
          *(LAS u32x4*)(lds + L_VT_D + row * S64 + col * 2) = R.v[i]; } }
#pragma unroll
    for (int i = 0; i < 5; ++i) { const int p = tid + 512 * i; if (p < 72 * 32) { const int tile = p >> 5, rem = p & 31, row = 16 * (tile >> 3) + (rem >> 1), col = 16 * (tile & 7) + 8 * (rem & 1);
        *(LAS u32x4*)(lds + L_CP + row * S128 + col * 2) = R.c[i]; } }
    if (tid < 16 * 8) { const int row = 128 + (tid >> 3), c = tid & 7; const unsigned v = (row == 128) ? 0x3f803f80u : 0u; LAS unsigned* p = (LAS unsigned*)(lds + L_VT_D + row * S64 + c * 16); p[0] = v; p[1] = v; p[2] = v; p[3] = v; }
    if (w == 0) { float cm = R.g;
#pragma unroll
        for (int o = 1; o < 64; o <<= 1) { const float v = __shfl_up(cm, o); if (lane >= o) cm = fmaxf(cm, v); }
        const float Mt = fmaxf(R.mprev, cm);
        MT[lane] = Mt; AT[lane] = fexp(R.mprev - Mt); DF[lane] = fexp(-(R.bt + Mt)); EG[lane] = R.g; }
    u32x2 og[4]; u32x4 xc[2];
#pragma unroll
    for (int j = 0; j < 4; ++j) og[j] = R.og[j];
    xc[0] = R.xc[0]; xc[1] = R.xc[1];
    __syncthreads();
    if (has_next) mlstm_out_issue(F, M, un, hn, RN);
    { const int tt = w & 3, t = 16 * tt + fr; const float Mt = MT[t];
      bf16x8 bq[4];
#pragma unroll
      for (int ks = 0; ks < 4; ++ks) bq[ks] = ldf(lds + L_Q + t * S128 + (32 * ks + 8 * fq) * 2);
#pragma unroll
      for (int j = 0; j < 2; ++j) { const int st = 2 * (w >> 2) + j; f32x4 c = (f32x4){0.f, 0.f, 0.f, 0.f};
          if (st <= tt) {
#pragma unroll
              for (int ks = 0; ks < 4; ++ks) c = MFMA16(ldf(lds + L_K + (16 * st + fr) * S128 + (32 * ks + 8 * fq) * 2), bq[ks], c); }
          const int s0 = 16 * st + 4 * fq; const f32x4 gs = *(const LAS f32x4*)(EG + s0);
          float p[4];
#pragma unroll
          for (int r = 0; r < 4; ++r) p[r] = (s0 + r <= t) ? c[r] * fexp(gs[r] - Mt) : 0.f;
          u32x2 o; o.x = pk2(p[0], p[1]); o.y = pk2(p[2], p[3]); *(LAS u32x2*)(lds + L_P + t * S64 + s0 * 2) = o; } }
    __syncthreads();
    { const int tt = w & 3, vh = w >> 2, t = 16 * tt + fr;
      bf16x8 bp[2], bq[4];
#pragma unroll
      for (int ks = 0; ks < 2; ++ks) bp[ks] = ldf(lds + L_P + t * S64 + (32 * ks + 8 * fq) * 2);
#pragma unroll
      for (int ks = 0; ks < 4; ++ks) bq[ks] = ldf(lds + L_Q + t * S128 + (32 * ks + 8 * fq) * 2);
      f32x4 ci[5], cx[5];
#pragma unroll
      for (int j = 0; j < 5; ++j) { const int vt = (j < 4) ? 4 * vh + j : 8; ci[j] = (f32x4){0.f, 0.f, 0.f, 0.f}; cx[j] = ci[j];
#pragma unroll
          for (int ks = 0; ks < 2; ++ks) ci[j] = MFMA16(ldf(lds + L_VT_D + (16 * vt + fr) * S64 + (32 * ks + 8 * fq) * 2), bp[ks], ci[j]);
#pragma unroll
          for (int ks = 0; ks < 4; ++ks) cx[j] = MFMA16(ldf(lds + L_CP + (16 * vt + fr) * S128 + (32 * ks + 8 * fq) * 2), bq[ks], cx[j]); }
      const float at = AT[t];
      float den = ci[4][0] + at * cx[4][0];
      den = __shfl(den, fr);
      den = fmaxf(fabsf(den), DF[t]);
      const float rden = 1.0f / den;
      __syncthreads();
#pragma unroll
      for (int j = 0; j < 4; ++j) { const float o[4] = {bflo(og[j].x), bfhi(og[j].x), bflo(og[j].y), bfhi(og[j].y)}; f32x4 x;
#pragma unroll
          for (int r = 0; r < 4; ++r) x[r] = o[r] * (ci[j][r] + at * cx[j][r]) * rden;
          *(LAS f32x4*)(lds + L_HM + (t * 132 + 64 * vh + 16 * j + 4 * fq) * 4) = x; } }
    __syncthreads();
    { const int t = tid >> 3, part = tid & 7, v0 = 16 * part;
      float s1 = 0.f, s2 = 0.f;
#pragma unroll
      for (int i = 0; i < 4; ++i) { const f32x4 x = *(const LAS f32x4*)(lds + L_HM + (t * 132 + v0 + 4 * i) * 4); s1 += (x.x + x.y) + (x.z + x.w); s2 += (x.x * x.x + x.y * x.y) + (x.z * x.z + x.w * x.w); }
      s1 += __shfl_xor(s1, 1); s1 += __shfl_xor(s1, 2); s1 += __shfl_xor(s1, 4); s2 += __shfl_xor(s2, 1); s2 += __shfl_xor(s2, 2); s2 += __shfl_xor(s2, 4);
      const float mu = s1 * (1.0f / 128.0f), var = fmaxf(s2 * (1.0f / 128.0f) - mu * mu, 0.f), rstd = __builtin_amdgcn_rsqf(var + EPS);
#pragma unroll
      for (int half = 0; half < 2; ++half) { const int c0 = h * 128 + v0 + 8 * half; const u32x4 xcv = xc[half];
          const f32x4 xa = *(const LAS f32x4*)(lds + L_HM + (t * 132 + v0 + 8 * half) * 4), xb = *(const LAS f32x4*)(lds + L_HM + (t * 132 + v0 + 8 * half + 4) * 4);
          const f32x4 ga = *(const LAS f32x4*)(PAR + c0), gb = *(const LAS f32x4*)(PAR + c0 + 4), sa = *(const LAS f32x4*)(PAR + 512 + c0), sb = *(const LAS f32x4*)(PAR + 512 + c0 + 4);
          u32x4 o; o.x = pk2((xa.x - mu) * rstd * ga.x + sa.x * bflo(xcv.x), (xa.y - mu) * rstd * ga.y + sa.y * bfhi(xcv.x));
          o.y = pk2((xa.z - mu) * rstd * ga.z + sa.z * bflo(xcv.y), (xa.w - mu) * rstd * ga.w + sa.w * bfhi(xcv.y));
          o.z = pk2((xb.x - mu) * rstd * gb.x + sb.x * bflo(xcv.z), (xb.y - mu) * rstd * gb.y + sb.y * bfhi(xcv.z));
          o.w = pk2((xb.z - mu) * rstd * gb.z + sb.z * bflo(xcv.w), (xb.w - mu) * rstd * gb.w + sb.w * bfhi(xcv.w));
          *(u32x4*)(Y + (size_t)(t0 + t) * D + c0) = o; } }
    __syncthreads();
}
DI void mlstm_out_phase(const Frame& F, const Mix& M) {
    mlstm_out_stage_params(F, M);
    int u = F.vcu, h = 0;
    if (u >= NU) return;
    OutLoads R, RN;
    mlstm_out_issue(F, M, u, h, R);
#pragma unroll 1
    for (;;) {
        int un = u, hn = h + 1; if (hn == 4) { hn = 0; un = u + F.G; } const bool hn_ok = un < NU;
        mlstm_out_item(F, M, u, h, R, hn_ok, un, hn, RN);
        if (!hn_ok) break;
        u = un; h = hn; R = RN;
    }
}

DI void route_tokens(const Frame& F, const Args& a) {
    LAS unsigned char* lds = F.lds; const int tid = F.tid, lane = F.lane, w = F.wave, ti = lane & 15, kq = lane >> 4;
    unsigned char* ws = F.ws;
    constexpr int WP = 2048 + 64;
    LAS unsigned char* WH = lds; LAS unsigned char* WL = lds + 8 * WP;
    LAS int* CNTL = (LAS int*)(lds + 16 * WP);
    const bf16* xb = (const bf16*)(ws + WS_XB);
    for (int i = tid; i < 8 * 1024; i += 512) { const int e = i >> 10, c = i & 1023; const float wv = a.in[I_ROUTER][c * 8 + e] * a.in[I_FFNG][D + c];
        const unsigned hi = f2bf(wv), lo = f2bf(wv - __builtin_bit_cast(float, hi << 16));
        *(LAS bf16*)(WH + e * WP + c * 2) = (bf16)hi; *(LAS bf16*)(WL + e * WP + c * 2) = (bf16)lo; }
    if (tid < 16) CNTL[tid] = 0;
    __syncthreads();
    const int TPW = (T + F.G - 1) / F.G, tb = F.vcu * TPW, te = (tb + TPW < T) ? tb + TPW : T;
#pragma unroll 1
    for (int t0 = tb + 16 * w; t0 < te; t0 += 128) {
        const int t = t0 + ti; const bool ok = t < te;
        u32x4 x[16][2];
#pragma unroll
        for (int u = 0; u < 16; ++u)
#pragma unroll
            for (int h = 0; h < 2; ++h) { x[u][h] = (u32x4){0u, 0u, 0u, 0u}; if (ok) x[u][h] = *(const u32x4*)(xb + (size_t)t * D + 64 * u + 16 * kq + 8 * h); }
        f32x4 acc = (f32x4){0.f, 0.f, 0.f, 0.f}; float ss = 0.f;
        const LAS unsigned char* wh = WH + (ti & 7) * WP + 32 * kq; const LAS unsigned char* wl = WL + (ti & 7) * WP + 32 * kq;
#pragma unroll
        for (int u = 0; u < 16; ++u)
#pragma unroll
            for (int h = 0; h < 2; ++h) { const bf16x8 xa = __builtin_bit_cast(bf16x8, x[u][h]);
                acc = MFMA16(ldf(wh + 128 * u + 16 * h), xa, acc); acc = MFMA16(ldf(wl + 128 * u + 16 * h), xa, acc);
#pragma unroll
                for (int c = 0; c < 4; ++c) { const float p = bflo(x[u][h][c]), q = bfhi(x[u][h][c]); ss += p * p + q * q; }
                __builtin_amdgcn_sched_barrier(0); }
        ss += __shfl_xor(ss, 16); ss += __shfl_xor(ss, 32);
        const float r = 1.0f / sqrtf(ss * (1.0f / D) + EPS);
        float lg[8];
#pragma unroll
        for (int i = 0; i < 4; ++i) { const float o = __shfl_xor(acc[i], 16); lg[i] = ((kq & 1) ? o : acc[i]) * r; lg[4 + i] = ((kq & 1) ? acc[i] : o) * r; }
        int i0 = 0; float l0 = lg[0];
#pragma unroll
        for (int e = 1; e < 8; ++e) if (lg[e] > l0) { l0 = lg[e]; i0 = e; }
        int i1 = -1; float l1 = -3.0e38f;
#pragma unroll
        for (int e = 0; e < 8; ++e) if (e != i0 && lg[e] > l1) { l1 = lg[e]; i1 = e; }
        if (i1 < 0) { i1 = i0 == 0 ? 1 : 0; l1 = lg[i0 == 0 ? 1 : 0]; }
        const float g0 = 1.0f / (1.0f + expf(l1 - l0));
        if (ok && kq == 0) { ((int*)(ws + WS_TOPI))[t * 2] = i0; ((int*)(ws + WS_TOPI))[t * 2 + 1] = i1; ((float*)(ws + WS_TOPG))[t * 2] = g0; ((float*)(ws + WS_TOPG))[t * 2 + 1] = 1.0f - g0;
            atomicAdd((int*)&CNTL[i0], 1); atomicAdd((int*)&CNTL[8 + i1], 1); }
        if (ok) {
            unsigned char* o8 = ws + WS_XR8 + (size_t)t * D + 16 * kq;
#pragma unroll
            for (int u = 0; u < 16; ++u) { u32x4 o;
#pragma unroll
                for (int h = 0; h < 2; ++h) { u32x4 xv = x[u][h]; asm volatile("" : "+v"(xv.x), "+v"(xv.y), "+v"(xv.z), "+v"(xv.w));
                    int w0 = __builtin_amdgcn_cvt_pk_fp8_f32(bflo(xv.x) * r, bfhi(xv.x) * r, 0, false); w0 = __builtin_amdgcn_cvt_pk_fp8_f32(bflo(xv.y) * r, bfhi(xv.y) * r, w0, true);
                    int w1 = __builtin_amdgcn_cvt_pk_fp8_f32(bflo(xv.z) * r, bfhi(xv.z) * r, 0, false); w1 = __builtin_amdgcn_cvt_pk_fp8_f32(bflo(xv.w) * r, bfhi(xv.w) * r, w1, true);
                    o[2 * h] = (unsigned)w0; o[2 * h + 1] = (unsigned)w1; }
                *(u32x4*)(o8 + 64 * u) = o; } }
    }
    __syncthreads();
    if (tid < 16) ((int*)(ws + WS_CNT))[F.vcu * 16 + tid] = CNTL[tid];
}
DI void route_scatter(const Frame& F) {
    LAS unsigned char* lds = F.lds; const int tid = F.tid;
    unsigned char* ws = F.ws;
    LAS int* TOT = (LAS int*)lds; LAS int* BASE = TOT + 16; LAS int* SEG = TOT + 32; LAS int* NTK = TOT + 48; LAS int* EL = TOT + 64;
    const int* cnt = (const int*)(ws + WS_CNT);
    { LAS int* PT = TOT + 64 + 1024; LAS int* PB = PT + 512;
      const int k = tid & 15, q = tid >> 4, per = (F.G + 31) / 32; int tot = 0, base = 0;
      for (int i = 0; i < per; ++i) { const int g = q * per + i; if (g < F.G) { const int c = cnt[g * 16 + k]; tot += c; if (g < F.vcu) base += c; } }
      PT[q * 16 + k] = tot; PB[q * 16 + k] = base; }
    __syncthreads();
    if (tid < 16) { LAS int* PT = TOT + 64 + 1024; LAS int* PB = PT + 512; int tot = 0, base = 0;
#pragma unroll
        for (int q = 0; q < 32; ++q) { tot += PT[q * 16 + tid]; base += PB[q * 16 + tid]; }
        TOT[tid] = tot; BASE[tid] = base; }
    __syncthreads();
    if (tid < 2) { int off = 0; for (int e = 0; e < 8; ++e) { SEG[tid * 8 + e] = off; off += (TOT[tid * 8 + e] + 255) & ~255; } NTK[tid] = off >> 8; }
    __syncthreads();
    int* rowtok = (int*)(ws + WS_ROWTOK); float* rowgate = (float*)(ws + WS_ROWGATE); int* tile = (int*)(ws + WS_TILE);
    if (F.vcu == 0) {
        for (int k = 0; k < 2; ++k) {
            if (tid == 0) tile[k * 256] = NTK[k];
            if (tid < NTK[k]) { int e = 0; for (int j = 1; j < 8; ++j) if (tid * 256 >= SEG[k * 8 + j]) e = j; tile[k * 256 + 1 + tid] = e; }
            for (int e = 0; e < 8; ++e) { const int tot = TOT[k * 8 + e], r = tot + tid; if (tid < 256 && r < ((tot + 255) & ~255)) { rowtok[k * MAXRT * 256 + SEG[k * 8 + e] + r] = -1; rowgate[k * MAXRT * 256 + SEG[k * 8 + e] + r] = 0.f; } }
        }
    }
    const int TPW = (T + F.G - 1) / F.G, tb = F.vcu * TPW, t = tb + tid; const bool act = tid < TPW && t < T;
    const int* topi = (const int*)(ws + WS_TOPI); const float* topg = (const float*)(ws + WS_TOPG);
    int e0 = -1, e1 = -1; if (act) { e0 = topi[t * 2]; e1 = topi[t * 2 + 1]; }
    EL[tid] = e0; EL[512 + tid] = e1;
    __syncthreads();
    if (act) { int r0 = 0, r1 = 0; for (int j = 0; j < tid; ++j) { r0 += (EL[j] == e0); r1 += (EL[512 + j] == e1); }
        const int p0 = SEG[e0] + BASE[e0] + r0, p1 = SEG[8 + e1] + BASE[8 + e1] + r1;
        rowtok[p0] = t; rowgate[p0] = topg[t * 2]; rowtok[MAXRT * 256 + p1] = t; rowgate[MAXRT * 256 + p1] = topg[t * 2 + 1]; }
}
DI void final_norm(const Frame& F, const Args& a) {
    const int gw = F.vcu * 8 + F.wave, NGW = F.G * 8, lane = F.lane;
    const bf16* xb = (const bf16*)(F.ws + WS_XB);
    f32x4 g[2][2];
#pragma unroll
    for (int jj = 0; jj < 2; ++jj) { g[jj][0] = *((const f32x4*)a.in[I_FING] + 128 * jj + 2 * lane); g[jj][1] = *((const f32x4*)a.in[I_FING] + 128 * jj + 2 * lane + 1); }
    for (int m0 = gw * 4; m0 < T; m0 += NGW * 4) {
        u32x4 v[4][2];
#pragma unroll
        for (int r = 0; r < 4; ++r)
#pragma unroll
            for (int jj = 0; jj < 2; ++jj) v[r][jj] = *((const u32x4*)(xb + (size_t)(m0 + r) * D) + lane + 64 * jj);
#pragma unroll
        for (int r = 0; r < 4; ++r) { float x[2][8]; float s = 0.f;
#pragma unroll
            for (int jj = 0; jj < 2; ++jj)
#pragma unroll
                for (int c = 0; c < 4; ++c) { x[jj][2 * c] = bflo(v[r][jj][c]); x[jj][2 * c + 1] = bfhi(v[r][jj][c]); }
#pragma unroll
            for (int jj = 0; jj < 2; ++jj) s += ((x[jj][0] * x[jj][0] + x[jj][1] * x[jj][1]) + (x[jj][2] * x[jj][2] + x[jj][3] * x[jj][3])) + ((x[jj][4] * x[jj][4] + x[jj][5] * x[jj][5]) + (x[jj][6] * x[jj][6] + x[jj][7] * x[jj][7]));
            s = wave_sum(s); const float rs = 1.0f / sqrtf(s * (1.0f / D) + EPS);
            f32x4* o = (f32x4*)(a.out + (size_t)(m0 + r) * D) + 2 * lane;
#pragma unroll
            for (int jj = 0; jj < 2; ++jj) { o[128 * jj] = (f32x4){x[jj][0], x[jj][1], x[jj][2], x[jj][3]} * rs * g[jj][0]; o[128 * jj + 1] = (f32x4){x[jj][4], x[jj][5], x[jj][6], x[jj][7]} * rs * g[jj][1]; } }
    }
}

#ifndef MK_PER_PHASE
#define MK_PER_PHASE 0
#endif
constexpr int N_PHASES = 21;
#ifndef PH_MASK
#define PH_MASK 0xFFFFFFFFu
#endif
#define PH_ON(k) && ((PH_MASK >> (k)) & 1u)
#ifndef REP_MASK
#define REP_MASK 0u
#endif
#ifndef REP_N
#define REP_N 2
#endif
#define REPS(k) for (int _rep = 0; _rep < 1 + (((REP_MASK >> (k)) & 1u) ? REP_N : 0); ++_rep)
DI int bxo() { int b = (int)blockIdx.x; asm volatile("" : "+s"(b)); return b; }
__global__ void __launch_bounds__(512, 2) trunk_fwd(Args args) {
    extern __shared__ __attribute__((aligned(16))) unsigned char lds_raw[];
    Frame F;
    F.lds = (LAS unsigned char*)lds_raw;
    const int wv0 = __builtin_amdgcn_readfirstlane((int)threadIdx.x >> 6);
    F.lane = lane_asm(); F.wave = wv0; F.tid = wv0 * 64 + F.lane;
    F.G = gridDim.x; { const int bx = blockIdx.x; F.vcu = (F.G % 8 == 0) ? (bx % 8) * (F.G / 8) + bx / 8 : bx; }
    F.ws = args.ws;
    volatile LAS unsigned* MISC = (volatile LAS unsigned*)(F.lds + MISC_OFF);
    for (int u = F.tid; u < (LDS_BYTES - MISC_OFF) / 4; u += 512) MISC[u] = 0u;
    __syncthreads();
    XcdBarrier bar; bar.bar = (unsigned*)(F.ws + WS_CTL) + CW_BAR; bar.x = 0; bar.st = nullptr; bar.wv = wv0;
    if (!MK_PER_PHASE) bar = xcd_barrier_post((unsigned*)(F.ws + WS_CTL) + CW_BAR, MISC + 8, wv0);
    const int lo = args.ph_lo, hi = args.ph_hi;
#define IN(k) (lo <= (k) && (k) < hi)
#define REFRESH() do { const int _l = lane_asm(); int _w = wv0; asm volatile("" : "+s"(_w)); F.lane = _l; F.wave = _w; F.tid = _w * 64 + _l; } while (0)
#define SEAM(k) do { if (IN(k) && IN((k) + 1)) xcd_barrier(bar); } while (0)
    unsigned char* ws = F.ws;
    bf16* xb = (bf16*)(ws + WS_XB); float* ssq = (float*)(ws + WS_SSQ);

    if (IN(0) PH_ON(0)) REPS(0) { REFRESH(); p0_prologue(F, args); __syncthreads(); }
    SEAM(0);
    for (int l = 0; l < 2; ++l) {
        const int pb = 1 + 8 * l;
        Mix M; M.l = l; M.proj = (const bf16*)(ws + WS_PROJ);
        M.convw = args.in[I_CONVW] + l * 4 * 512; M.convb = args.in[I_CONVB] + l * 512; M.bif = args.in[I_BIF] + l * 8; M.skip = args.in[I_SKIP] + l * 512; M.mhg = args.in[I_MHG] + l * 512;
        M.gmvg = args.in[I_GMVG] + l * 512; M.bsp = args.in[I_BSP] + l * 512; M.gmog = args.in[I_GMOG] + l * 512;
        M.wg = (const bf16*)(ws + WS_WG) + (size_t)l * 16 * 1024; M.wq = (const bf16*)(ws + WS_WQ); M.wk = M.wq + 8 * 128 * 128; M.wv = M.wq + 16 * 128 * 128; M.wsp = (const bf16*)(ws + WS_WSP);
        if (IN(pb) PH_ON(1)) REPS(1) { pg8::Gemm g{xb, (const bf16*)(ws + WS_WIN) + (size_t)l * DIN * D, D, 0, nullptr}; pg8::StaticOrder S; S.init(T, DIN, F.G, bxo());
            EpiIn E{(bf16*)(ws + WS_PROJ), ssq, F.lds, (float*)(ws + WS_VST), l == 0}; pg8::gemm_phase<EpiIn, pg8::StaticOrder, false>(F.lds, g, S, E, F.wave); }
        SEAM(pb);
        if (IN(pb + 1) PH_ON(2)) REPS(2) { REFRESH(); __syncthreads(); if (l == 0) { dense_quant(F, args); __syncthreads(); } REPS(21) for (int u = F.vcu; u < NU; u += F.G) mlstm_local3(F, M, u);
            REFRESH();
            REPS(20) for (int ub = F.vcu; ub < T / 128; ub += F.G) { __syncthreads(); gmlp_unit(F, M, ub); } }
        SEAM(pb + 1);
        if (IN(pb + 2) PH_ON(3)) { REFRESH(); mlstm_scan(F); }
        SEAM(pb + 2);
        if (IN(pb + 3) PH_ON(4)) REPS(4) { REFRESH(); __syncthreads(); mlstm_out_phase(F, M); }
        SEAM(pb + 3);
        if (IN(pb + 4) PH_ON(5)) { const bool cw = l == 1, cfirst = (F.vcu & 1) == 0;
            if (cw && cfirst) { REFRESH(); __syncthreads(); moe_weights(F, args); __syncthreads(); }
            { pg8::Gemm g{(const bf16*)(ws + WS_Y), (const bf16*)(ws + WS_WOUT) + (size_t)l * D * D, D, 0, nullptr}; pg8::StaticOrder S; S.init(T, D, F.G, bxo());
              if (l == 0) { EpiResT<false> E{args.in[I_X], xb, ssq, F.lds}; pg8::gemm_phase<EpiResT<false>, pg8::StaticOrder, false>(F.lds, g, S, E, F.wave); }
              else { EpiResT<true> E{nullptr, xb, ssq, F.lds}; pg8::gemm_phase<EpiResT<true>, pg8::StaticOrder, false>(F.lds, g, S, E, F.wave); } }
            if (cw && !cfirst) { REFRESH(); __syncthreads(); moe_weights(F, args); __syncthreads(); } }
        SEAM(pb + 4);
        if (l == 0) {
            if (IN(6) PH_ON(6)) { REFRESH(); rows_to_int8(F); }
            SEAM(6);
            if (IN(7) PH_ON(6)) REPS(6) { pg8::Gemm g{(const bf16*)(ws + WS_XB8D), (const bf16*)(ws + WS_W13), D / 2, 0, nullptr}; pg8::StaticOrder S; S.init(T, 2 * DFFP, F.G, bxo());
                EpiGluI8T<true> E{(bf16*)(ws + WS_HID), DFFP, (const float*)(ws + WS_SA), (const float*)(ws + WS_SWD), nullptr, 0u}; pg8::gemm_phase<EpiGluI8T<true>, pg8::StaticOrder, false, 1>(F.lds, g, S, E, F.wave); }
            SEAM(7);
            if (IN(8) PH_ON(7)) { pg8::Gemm g{(const bf16*)(ws + WS_HID), (const bf16*)(ws + WS_W2), DFFP / 2, 0, nullptr}; pg8::StaticOrder S; S.init(T, D, F.G, bxo());
                EpiResT<true> E{nullptr, xb, ssq, F.lds}; pg8::gemm_phase<EpiResT<true>, pg8::StaticOrder, false, 2>(F.lds, g, S, E, F.wave); }
            SEAM(8);
        }
    }
    if (IN(14) PH_ON(13)) REPS(13) { REFRESH(); __syncthreads(); route_tokens(F, args); }
    SEAM(14);
    if (IN(15) PH_ON(14)) { REFRESH(); route_scatter(F); }
    SEAM(15);
    {
        const int* tile0 = (const int*)(ws + WS_TILE); const int* tile1 = tile0 + 256;
        const int S0 = __builtin_amdgcn_readfirstlane(tile0[0]), S1 = __builtin_amdgcn_readfirstlane(tile1[0]);
        unsigned* hidcnt = (unsigned*)(ws + WS_CTL) + CW_HID;
        for (int ph = 0; ph < 4; ++ph) {
            if (IN(16 + ph) PH_ON(15)) {
                int prev_units = 0;
                if (ph >= 1) {
                    const int p = ph - 1, k = p == 0 ? 0 : 1, first = p == 2 ? S1 - 64 : 0, nM = p == 0 ? S0 : (p == 1 ? S1 - 64 : 64), hid0 = p == 2 ? 72 : 0;
                    const int* rowtok = (const int*)(ws + WS_ROWTOK) + k * MAXRT * 256; const float* rowgate = (const float*)(ws + WS_ROWGATE) + k * MAXRT * 256;
                    pg8::Gemm g{(const bf16*)(ws + WS_MHID), (const bf16*)(ws + WS_MW2), DFE / 2, (size_t)D * DFE / 2, nullptr}; pg8::MoeOrder S; S.init(k ? tile1 : tile0, first, nM, hid0, D, F.G, bxo(), 0, 0);
                    EpiMoe2 E{xb, rowtok, rowgate, hidcnt}; pg8::gemm_phase<EpiMoe2, pg8::MoeOrder, false, 2>(F.lds, g, S, E, F.wave);
                    prev_units = nM * (D / 256);
                }
                if (ph <= 2) {
                    const int p = ph, k = p == 0 ? 0 : 1, first = p == 2 ? S1 - 64 : 0, nM = p == 0 ? S0 : (p == 1 ? S1 - 64 : 64), hid0 = p == 2 ? 72 : 0;
                    const int* rowtok = (const int*)(ws + WS_ROWTOK) + k * MAXRT * 256;
                    pg8::Gemm g{(const bf16*)(ws + WS_XR8), (const bf16*)(ws + WS_MW13), D / 2, (size_t)2 * DFE * (D / 2), rowtok}; pg8::MoeOrder S; S.init(k ? tile1 : tile0, first, nM, hid0, 2 * DFE, F.G, bxo(), prev_units, 3);
                    EpiGluF8 E{ws + WS_MHID, DFE, hidcnt, p == 1 ? 4u : 0u}; pg8::gemm_phase<EpiGluF8, pg8::MoeOrder, true, 2>(F.lds, g, S, E, F.wave);
                }
            }
            SEAM(16 + ph);
        }
    }
    if (IN(20) PH_ON(19)) { REFRESH(); final_norm(F, args); }
#undef IN
#undef SEAM
}

extern "C" void kernel_launch(void* const* d_in, const int* in_sizes, int n_in, void* d_out, int out_size, void* d_ws, size_t ws_size, hipStream_t stream) {
    static int grid = 0;
    if (grid == 0) {
        if (n_in != 26 || in_sizes[0] != T * D || out_size != T * D || ws_size < WS_END) { fprintf(stderr, "kernel_launch: unexpected shapes / workspace (n_in %d, ws %zu < %zu)\n", n_in, ws_size, (size_t)WS_END); grid = -1; return; }
        int dev = 0, cus = 0, per_cu = 0;
        if (hipGetDevice(&dev) != hipSuccess || hipDeviceGetAttribute(&cus, hipDeviceAttributeMultiprocessorCount, dev) != hipSuccess) { grid = -1; return; }
        if (hipFuncSetAttribute((const void*)trunk_fwd, hipFuncAttributeMaxDynamicSharedMemorySize, LDS_BYTES) != hipSuccess) { fprintf(stderr, "kernel_launch: hipFuncSetAttribute failed\n"); grid = -1; return; }
        if (hipOccupancyMaxActiveBlocksPerMultiprocessor(&per_cu, (const void*)trunk_fwd, 512, LDS_BYTES) != hipSuccess || per_cu < 1) { fprintf(stderr, "kernel_launch: occupancy query says %d\n", per_cu); }
        (void)hipGetLastError();
        grid = cus;
    }
    if (grid < 0) return;
    (void)hipMemsetAsync((char*)d_ws + WS_CTL, 0, CTL_ZERO_BYTES, stream);
    Args a{};
    for (int i = 0; i < 26; ++i) a.in[i] = (const float*)d_in[i];
    a.out = (float*)d_out; a.ws = (unsigned char*)d_ws;
#if MK_PER_PHASE
    for (int p = 0; p < N_PHASES; ++p) { a.ph_lo = p; a.ph_hi = p + 1; hipLaunchKernelGGL(trunk_fwd, dim3(grid), dim3(512), LDS_BYTES, stream, a); }
#else
    a.ph_lo = 0; a.ph_hi = N_PHASES;
    hipLaunchKernelGGL(trunk_fwd, dim3(grid), dim3(512), LDS_BYTES, stream, a);
#endif
}
```

```cpp
#include <hip/hip_runtime.h>
#include <cstdio>
#include <cstdint>

#define LAS __attribute__((address_space(3)))
#define GAS __attribute__((address_space(1)))
typedef unsigned short bf16;
typedef short bf16x8 __attribute__((ext_vector_type(8)));
typedef short s16x4 __attribute__((ext_vector_type(4)));
typedef float f32x4 __attribute__((ext_vector_type(4)));
typedef float f32x2 __attribute__((ext_vector_type(2)));
typedef unsigned u32x4 __attribute__((ext_vector_type(4)));
typedef unsigned u32x2 __attribute__((ext_vector_type(2)));
typedef int i32x4 __attribute__((ext_vector_type(4)));
#define DI __device__ __forceinline__

constexpr int NB = 4, SEQ = 8192, T = NB * SEQ, D = 1024, DIN = 2048;
constexpr int CH = 64, NCH = SEQ / CH;
constexpr int NU = T / CH;
constexpr int DFF = 2752, DFFP = 2816;
constexpr int NE = 8, DFE = 3584;
constexpr int MAXRT = 136;
constexpr float EPS = 1e-6f;

constexpr size_t MiB = 1u << 20;
constexpr size_t WS_CTL = 0, CTL_ZERO_BYTES = 1 * MiB;
constexpr size_t WS_SSQ = 1 * MiB;
constexpr size_t WS_VST = 1 * MiB + 512 * 1024;
constexpr size_t WS_WG = 3 * MiB + 512 * 1024;
constexpr size_t WS_WQ = WS_WG + 64 * 1024;
constexpr size_t WS_WSP = WS_WQ + 3 * 256 * 1024;
constexpr size_t WS_GB = 5 * MiB;
constexpr size_t WS_SC = 6 * MiB;
constexpr size_t WS_MP = WS_SC + 64 * 1024;
constexpr size_t WS_TOPI = 6 * MiB + 256 * 1024;
constexpr size_t WS_TOPG = WS_TOPI + 256 * 1024;
constexpr size_t WS_CNT = WS_TOPG + 256 * 1024;
constexpr size_t WS_ROWTOK = 7 * MiB;
constexpr size_t WS_ROWGATE = WS_ROWTOK + 512 * 1024;
constexpr size_t WS_TILE = WS_ROWGATE + 512 * 1024 - 4096;
constexpr size_t WS_WIN = 8 * MiB;
constexpr size_t WS_WOUT = 16 * MiB;
constexpr size_t WS_W13 = 20 * MiB;
constexpr size_t WS_W2 = 31 * MiB;
constexpr size_t WS_XB = 40 * MiB;
constexpr size_t WS_BIG = 104 * MiB;
constexpr size_t WS_PROJ = WS_BIG;
constexpr size_t WS_QG = WS_BIG + 128 * MiB;
constexpr size_t WS_KG = WS_BIG + 160 * MiB;
constexpr size_t WS_VG = WS_BIG + 192 * MiB;
constexpr size_t WS_ST = WS_BIG + 224 * MiB;
constexpr size_t WS_Y = WS_BIG + 296 * MiB;
constexpr size_t WS_XCG = WS_BIG + 360 * MiB;
constexpr size_t WS_HID = WS_BIG;
constexpr size_t WS_MW13 = WS_BIG;
constexpr size_t WS_XR8 = WS_BIG + 64 * MiB;
constexpr size_t WS_MW2 = WS_BIG + 112 * MiB;
constexpr size_t WS_MHID = WS_BIG + 168 * MiB;
constexpr size_t WS_END = WS_BIG + 408 * MiB;
static_assert(WS_MHID + (size_t)MAXRT * 256 * DFE * 2 <= WS_END && WS_Y + (size_t)T * D * 2 <= WS_END, "ws map");
constexpr int CW_BAR = 4096;
constexpr size_t WS_SWD = WS_CTL + 496 * 1024;
constexpr size_t WS_XB8D = WS_BIG + 200 * MiB;
constexpr size_t WS_SW13 = WS_CTL + 256 * 1024;
constexpr size_t WS_ROWSA = WS_GB;
constexpr size_t WS_SA = WS_GB + 512 * 1024;
constexpr int CW_HID = 16384;

constexpr int RING_BYTES = 131072;
constexpr int MISC_OFF = RING_BYTES + 12288;
constexpr int LDS_BYTES = 147456;

typedef __bf16 bf16x2_t __attribute__((ext_vector_type(2)));
DI unsigned pk2(float lo, float hi) { const f32x2 v = {lo, hi}; return __builtin_bit_cast(unsigned, __builtin_convertvector(v, bf16x2_t)); }
DI unsigned f2bf(float f) { return pk2(f, f) & 0xffffu; }
DI float bf2f(unsigned b) { return __builtin_bit_cast(float, b << 16); }
DI float bflo(unsigned w) { return __builtin_bit_cast(float, w << 16); }
DI float bfhi(unsigned w) { return __builtin_bit_cast(float, w & 0xffff0000u); }
DI float fexp(float x) { return __builtin_amdgcn_exp2f(x * 1.44269504089f); }
DI float softplus_neg(float a) { return __builtin_amdgcn_logf(1.0f + __builtin_amdgcn_exp2f(-1.44269504089f * a)) * 0.69314718056f; }
DI float sigmoidf(float x) { return __builtin_amdgcn_rcpf(1.0f + fexp(-x)); }
DI float siluf(float x) { return x * sigmoidf(x); }
DI float geluf(float x) { return x * sigmoidf(1.59576912161f * (x + 0.044715f * x * x * x)); }
DI float dpp_f(float v, const int ctrl_sel) {
    const int x = __builtin_bit_cast(int, v); int r;
    if (ctrl_sel == 0) r = __builtin_amdgcn_update_dpp(x, x, 0xB1, 0xF, 0xF, false);
    else if (ctrl_sel == 1) r = __builtin_amdgcn_update_dpp(x, x, 0x4E, 0xF, 0xF, false);
    else if (ctrl_sel == 2) r = __builtin_amdgcn_update_dpp(x, x, 0x141, 0xF, 0xF, false);
    else r = __builtin_amdgcn_update_dpp(x, x, 0x140, 0xF, 0xF, false);
    return __builtin_bit_cast(float, r);
}
DI float rl_f(float v, int l) { return __builtin_bit_cast(float, __builtin_amdgcn_readlane(__builtin_bit_cast(int, v), l)); }
DI float wave_sum(float v) {
    v += dpp_f(v, 0); v += dpp_f(v, 1); v += dpp_f(v, 2); v += dpp_f(v, 3);
    return (rl_f(v, 0) + rl_f(v, 16)) + (rl_f(v, 32) + rl_f(v, 48));
}
DI float wave_max(float v) {
    v = fmaxf(v, dpp_f(v, 0)); v = fmaxf(v, dpp_f(v, 1)); v = fmaxf(v, dpp_f(v, 2)); v = fmaxf(v, dpp_f(v, 3));
    return fmaxf(fmaxf(rl_f(v, 0), rl_f(v, 16)), fmaxf(rl_f(v, 32), rl_f(v, 48)));
}
#define MFMA16(a, b, c) __builtin_amdgcn_mfma_f32_16x16x32_bf16((a), (b), (c), 0, 0, 0)
#define LDS_WAIT() asm volatile("s_waitcnt lgkmcnt(0)" ::: "memory")
#define VM_WAIT() asm volatile("s_waitcnt vmcnt(0)" ::: "memory")

DI int lane_asm() { int l; asm volatile("v_mbcnt_lo_u32_b32 %0, -1, 0\n\tv_mbcnt_hi_u32_b32 %0, -1, %0" : "=v"(l)); return l; }
namespace pg8 {
constexpr int BM = 256, BK = 64, HALF = 128, HTB = HALF * BK * 2, STAGE_BYTES = 8 * HTB, NXCD = 8, WGM = 8;
__host__ __device__ __forceinline__ int lds_byte(int r, int c) { const int st = (r >> 4) * 2 + (c >> 5), rr = r & 15, cc = c & 31, ob = rr * 64 + cc * 2; return st * 1024 + (ob ^ (((ob >> 9) & 1) << 5)); }
__host__ __device__ __forceinline__ void stage_rc(int b, int& R, int& C) { const int st = b / 1024, sb = b % 1024, swz = sb ^ (((sb >> 9) & 1) << 5); R = (st >> 1) * 16 + swz / 64; C = (st & 1) * 32 + (swz % 64) / 2; }
__host__ __device__ __forceinline__ int perm32(int rho) { const int n = rho >> 4, i = rho & 15; return 8 * (i >> 2) + 4 * n + (i & 3); }

struct Unit { int pm, pn, e, ph; };
struct Gemm { const bf16* A; const bf16* Bt; int K; size_t estride; const int* rowtok; };

DI void tile_of(int wgid, int nM, int nN, int& pm, int& pn) {
    const int nwg = nM * nN;
    { const int q = nwg / NXCD, r = nwg % NXCD, xcd = wgid % NXCD, off = wgid / NXCD; wgid = (xcd < r ? xcd * (q + 1) : r * (q + 1) + (xcd - r) * q) + off; }
    const int nig = WGM * nN, gid = wgid / nig, fm = gid * WGM, gsz = (nM - fm) < WGM ? (nM - fm) : WGM;
    pm = fm + ((wgid % nig) % gsz); pn = (wgid % nig) / gsz;
}
struct StaticOrder {
    int nM, nN, nwg, G, c;
    DI void init(int M, int N, int G_, int c_) { nM = M / BM; nN = N / BM; nwg = nM * nN; G = G_; c = c_; }
    DI bool next(int i, Unit& u) const {
        const long L = (long)i * G + c; if (L >= nwg) return false;
        tile_of((int)L, nM, nN, u.pm, u.pn); u.e = 0; u.ph = u.pm; return true;
    }
};
struct MoeOrder {
    const int* tile; int first, hid0, nM, nN, W, j, cnt, base, ex, SK;
    DI void init(const int* tile_, int first_, int nM_, int hid0_, int N, int G, int c, int prev_units, int SK_) {
        tile = tile_; first = first_; hid0 = hid0_; nM = nM_; nN = N / BM; SK = SK_;
        const int nwg = nM * nN; int x, nx;
        if (G % NXCD == 0) { x = c % NXCD; j = c / NXCD; W = G / NXCD; nx = NXCD; } else { x = 0; j = c; W = G; nx = 1; }
        const int q = nwg / nx, r = nwg % nx; cnt = q + (x < r ? 1 : 0); base = (x < r) ? x * (q + 1) : r * (q + 1) + (x - r) * q;
        const int q2 = prev_units / nx, r2 = prev_units % nx, cnt2 = q2 + (x < r2 ? 1 : 0); ex = cnt2 % W;
    }
    DI bool next(int i, Unit& u) const {
        const int R = i + (j < ex ? SK : 0);
        const int off = (R < SK) ? R * (W - ex) + (j - ex) : SK * (W - ex) + (R - SK) * W + j;
        if (off >= cnt) return false;
        const int wgid = base + off, nig = WGM * nN, gid = wgid / nig, fm = gid * WGM, gsz = (nM - fm) < WGM ? (nM - fm) : WGM;
        const int pl = fm + ((wgid % nig) % gsz); u.pn = (wgid % nig) / gsz; u.pm = first + pl; u.ph = hid0 + pl;
        u.e = __builtin_amdgcn_readfirstlane(tile[1 + u.pm]); return true;
    }
};

DI unsigned cvt_pk_bf16(float lo, float hi) { unsigned r; asm volatile("v_cvt_pk_bf16_f32 %0, %1, %2" : "=v"(r) : "v"(lo), "v"(hi)); return r; }

template <bool I8> struct AccT { typedef f32x4 type; };
template <> struct AccT<true> { typedef i32x4 type; };
template <class Epi, class Sched, bool GATHER, int Q = 0>
DI void gemm_phase(LAS unsigned char* lds, const Gemm g, const Sched& S, const Epi& E, const int wv) {
    constexpr bool I8 = Q == 1;
    typedef typename AccT<I8>::type acc_t;
    int wid = wv; asm volatile("" : "+s"(wid));
    const int tid = wid * 64 + lane_asm();
    const int lane = tid & 63, wr = wid >> 2, wc = wid & 3, fr = lane & 15, fq = lane >> 4;
    const int K = g.K, nt = K / BK;
    unsigned voffA[2], voffB[2];
#pragma unroll
    for (int i = 0; i < 2; ++i) { int R, C; stage_rc(tid * 16 + i * 8192, R, C); const int Rb = Epi::PERM ? ((R & ~31) + perm32(R & 31)) : R;
        voffA[i] = (unsigned)(R * K + C) * 2u; voffB[i] = (unsigned)(Rb * K + C) * 2u; }
    const unsigned kstep = (unsigned)(BK * 2);
    const size_t hstep = (size_t)HALF * K * 2;
    const size_t tstep = 2 * hstep;
    const unsigned ldsw = (unsigned)wid * 1024u;
    const int aoff = lds_byte(wr * 64 + fr, fq * 8), boff = lds_byte(wc * 32 + fr, fq * 8);
#define PG8_SA(b, h) (((b) * 2 + (h)) * HTB)
#define PG8_SB(b, h) ((4 + (b) * 2 + (h)) * HTB)
#define PG8_STAGE(bufoff, gbase, voff) do { _Pragma("unroll") for (int _i = 0; _i < 2; ++_i) { unsigned _vo = (voff)[_i]; asm volatile("" : "+v"(_vo)); \
        __builtin_amdgcn_global_load_lds((const unsigned*)((const char*)(gbase) + _vo), (LAS unsigned*)(lds + (bufoff) + ldsw + _i * 8192), 16, 0, 0); } } while (0)
#define PG8_STAGEA(bufoff, PA, OA, h, kb) do { if constexpr (GATHER) { _Pragma("unroll") for (int _i = 0; _i < 2; ++_i) { unsigned _vo = (OA)[h][_i]; asm volatile("" : "+v"(_vo)); \
        __builtin_amdgcn_global_load_lds((const unsigned*)((const char*)g.A + (size_t)_vo + (kb)), (LAS unsigned*)(lds + (bufoff) + ldsw + _i * 8192), 16, 0, 0); } } \
        else { PG8_STAGE(bufoff, (PA) + (h) * hstep + (kb), voffA); } } while (0)
#define PG8_LDA(dst, b, h) do { _Pragma("unroll") for (int m = 0; m < 4; ++m) _Pragma("unroll") for (int k = 0; k < 2; ++k) dst[m][k] = *(const LAS bf16x8*)(lds + PG8_SA(b, h) + aoff + m * 2048 + k * 1024); } while (0)
#define PG8_LDB(dst, b, h) do { _Pragma("unroll") for (int n = 0; n < 2; ++n) _Pragma("unroll") for (int k = 0; k < 2; ++k) dst[n][k] = *(const LAS bf16x8*)(lds + PG8_SB(b, h) + boff + n * 2048 + k * 1024); } while (0)
#define PG8_CAT(X) __builtin_shufflevector(__builtin_bit_cast(i32x4, X[0]), __builtin_bit_cast(i32x4, X[1]), 0, 1, 2, 3, 4, 5, 6, 7)
#define PG8_MMA(ai, bj, At, Bt) do { __builtin_amdgcn_s_setprio(1); _Pragma("unroll") for (int m = 0; m < 4; ++m) _Pragma("unroll") for (int n = 0; n < 2; ++n) _Pragma("unroll") for (int k = 0; k < 2; ++k) { \
        if constexpr (Q == 2) { if (k == 0) acc[ai][bj][m][n] = __builtin_amdgcn_mfma_scale_f32_16x16x128_f8f6f4(PG8_CAT(Bt[n]), PG8_CAT(At[m]), acc[ai][bj][m][n], 0, 0, 0, 0x7c7c7c7c, 0, 0x7c7c7c7c); } \
        else if constexpr (I8) acc[ai][bj][m][n] = __builtin_amdgcn_mfma_i32_16x16x64_i8(__builtin_bit_cast(i32x4, Bt[n][k]), __builtin_bit_cast(i32x4, At[m][k]), acc[ai][bj][m][n], 0, 0, 0); \
        else acc[ai][bj][m][n] = __builtin_amdgcn_mfma_f32_16x16x32_bf16(Bt[n][k], At[m][k], acc[ai][bj][m][n], 0, 0, 0); } __builtin_amdgcn_s_setprio(0); } while (0)
#define PG8_WAIT_V(n) asm volatile("s_waitcnt vmcnt(" #n ")" ::: "memory")
#define PG8_WAIT_L(n) asm volatile("s_waitcnt lgkmcnt(" #n ")" ::: "memory")
#define PG8_BAR __builtin_amdgcn_s_barrier()
#define PG8_SCHED __builtin_amdgcn_sched_barrier(0)
#define PG8_ARAW(dst, u) do { if constexpr (GATHER) { _Pragma("unroll") for (int _h = 0; _h < 2; ++_h) _Pragma("unroll") for (int _i = 0; _i < 2; ++_i) { \
        int _R, _C; stage_rc(tid * 16 + _i * 8192, _R, _C); dst[_h][_i] = g.rowtok[(u).pm * BM + _h * HALF + _R]; } } } while (0)
#define PG8_AOFFS(dst, raw) do { if constexpr (GATHER) { _Pragma("unroll") for (int _h = 0; _h < 2; ++_h) _Pragma("unroll") for (int _i = 0; _i < 2; ++_i) { \
        int _R, _C; stage_rc(tid * 16 + _i * 8192, _R, _C); int _t = raw[_h][_i]; _t = _t < 0 ? 0 : _t; \
        dst[_h][_i] = (unsigned)_t * (unsigned)(K * 2) + (unsigned)(_C * 2); } } } while (0)
    Unit cur, nxt, nn; int ui = 0;
    if (!S.next(0, cur)) return;
    bool has_next = S.next(1, nxt); if (!has_next) nxt = cur;
    acc_t acc[2][2][4][2];
#pragma unroll
    for (int a = 0; a < 2; ++a)
#pragma unroll
        for (int b = 0; b < 2; ++b)
#pragma unroll
            for (int m = 0; m < 4; ++m)
#pragma unroll
                for (int n = 0; n < 2; ++n) acc[a][b][m][n] = acc_t{};
    bf16x8 At[4][2], B0[2][2], B1[2][2];
    unsigned oa[2][2], na[2][2]; int rt2[2][2];
    PG8_ARAW(rt2, cur); PG8_AOFFS(oa, rt2); PG8_ARAW(rt2, nxt); PG8_AOFFS(na, rt2);
    const char* cA = (const char*)g.A + (GATHER ? (size_t)0 : (size_t)cur.ph * tstep);
    const char* cB = (const char*)g.Bt + ((size_t)cur.e * g.estride) * 2 + (size_t)cur.pn * tstep;
    PG8_STAGE(PG8_SB(0, 0), cB, voffB); PG8_STAGE(PG8_SB(0, 1), cB + hstep, voffB); PG8_STAGEA(PG8_SA(0, 0), cA, oa, 0, 0); PG8_STAGEA(PG8_SA(0, 1), cA, oa, 1, 0);
    if (wr == 1) PG8_BAR;
    PG8_WAIT_V(2); PG8_BAR;
    PG8_STAGE(PG8_SB(1, 0), cB + kstep, voffB); PG8_STAGEA(PG8_SA(1, 0), cA, oa, 0, kstep); PG8_STAGE(PG8_SB(1, 1), cB + hstep + kstep, voffB);
    PG8_WAIT_V(6); PG8_BAR;
    for (;;) {
        const char* nA = (const char*)g.A + (GATHER ? (size_t)0 : (size_t)nxt.ph * tstep);
        const char* nB = (const char*)g.Bt + ((size_t)nxt.e * g.estride) * 2 + (size_t)nxt.pn * tstep;
        for (int t = 0; t < nt; t += 2) {
            const bool last = (t == nt - 2);
            const unsigned k1 = (unsigned)(t + 1) * kstep, k2 = last ? 0u : (unsigned)(t + 2) * kstep, k3 = k2 + kstep;
            const char* a2 = last ? nA : cA;
            const char* b2 = last ? nB : cB + (size_t)(t + 2) * kstep; const char* b3 = b2 + kstep;
            PG8_LDB(B0, 0, 0); PG8_LDB(B1, 0, 1); PG8_SCHED; PG8_LDA(At, 0, 0); PG8_STAGEA(PG8_SA(1, 1), cA, oa, 1, k1);
            if constexpr (GATHER) { if (last) {
#pragma unroll
                for (int h = 0; h < 2; ++h)
#pragma unroll
                    for (int i = 0; i < 2; ++i) oa[h][i] = na[h][i]; } }
            PG8_WAIT_V(8); PG8_WAIT_L(0); PG8_BAR; PG8_MMA(0, 0, At, B0); PG8_MMA(0, 1, At, B1); PG8_BAR; PG8_SCHED;
            PG8_LDA(At, 0, 1); PG8_STAGE(PG8_SB(0, 0), b2, voffB); PG8_STAGE(PG8_SB(0, 1), b2 + hstep, voffB); PG8_STAGEA(PG8_SA(0, 0), a2, oa, 0, k2);
            PG8_WAIT_V(8); PG8_WAIT_L(0); PG8_BAR; PG8_MMA(1, 0, At, B0); PG8_MMA(1, 1, At, B1); PG8_BAR; PG8_SCHED;
            PG8_LDB(B0, 1, 0); PG8_LDB(B1, 1, 1); PG8_SCHED; PG8_LDA(At, 1, 0); PG8_STAGEA(PG8_SA(0, 1), a2, oa, 1, k2);
            PG8_WAIT_V(8); PG8_WAIT_L(0); PG8_BAR; PG8_MMA(0, 0, At, B0); PG8_MMA(0, 1, At, B1); PG8_BAR; PG8_SCHED;
            PG8_LDA(At, 1, 1); PG8_STAGE(PG8_SB(1, 0), b3, voffB); PG8_STAGE(PG8_SB(1, 1), b3 + hstep, voffB); PG8_STAGEA(PG8_SA(1, 0), a2, oa, 0, k3);
            PG8_WAIT_V(8); PG8_WAIT_L(0); PG8_BAR; PG8_MMA(1, 0, At, B0); PG8_MMA(1, 1, At, B1); PG8_BAR; PG8_SCHED;
        }
        if (wr == 0) PG8_BAR;
        bool has_nn = has_next && S.next(ui + 2, nn); if (!has_nn) nn = nxt;
        PG8_ARAW(rt2, nn);
        E.done(cur, wid * 64 + lane_asm());
        { const int l2 = lane_asm(); int wr_ = wr, wc_ = wc; asm volatile("" : "+s"(wr_), "+s"(wc_));
          E(acc, cur, wr_, wc_, l2 & 15, l2 >> 4); }
        if (!has_next) break;
        PG8_AOFFS(na, rt2);
#pragma unroll
        for (int a = 0; a < 2; ++a)
#pragma unroll
            for (int b = 0; b < 2; ++b)
#pragma unroll
                for (int m = 0; m < 4; ++m)
#pragma unroll
                    for (int n = 0; n < 2; ++n) acc[a][b][m][n] = acc_t{};
        cur = nxt; cA = nA; cB = nB; nxt = nn; has_next = has_nn; ++ui;
        if (wr == 1) PG8_BAR;
    }
    PG8_WAIT_V(0);
    PG8_BAR;
#undef PG8_SA
#undef PG8_SB
#undef PG8_STAGE
#undef PG8_STAGEA
#undef PG8_LDA
#undef PG8_LDB
#undef PG8_MMA
#undef PG8_CAT
#undef PG8_WAIT_V
#undef PG8_WAIT_L
#undef PG8_BAR
#undef PG8_SCHED
#undef PG8_ARAW
#undef PG8_AOFFS
}
}

#define XB_TMO      128
#define XB_XCNT(j)  (256  + 64 * (j))
#define XB_XSUB(j)  (1280 + 64 * (j))
#define XB_XGEN(j)  (2304 + 64 * (j))
#define XB_TOP      3328
#define XB_TOPGEN   3392
#define XCD_BAR_WORDS 3456
#define XB_SPIN_CAP (1u << 18)
__device__ __forceinline__ unsigned xb_ld(unsigned* p)              { return __hip_atomic_load(p, __ATOMIC_RELAXED, __HIP_MEMORY_SCOPE_AGENT); }
__device__ __forceinline__ unsigned xb_add(unsigned* p, unsigned v) { return __hip_atomic_fetch_add(p, v, __ATOMIC_RELAXED, __HIP_MEMORY_SCOPE_AGENT); }
__device__ __forceinline__ unsigned xb_xcc_id() { return (unsigned)__builtin_amdgcn_s_getreg((3 << 11) | 20) & 0xFu; }
#define XB_SPIN(cond, bar) do { unsigned _sp = 0; while (cond) { __builtin_amdgcn_s_sleep(1); \
    if ((++_sp & 255u) == 0u) { if (xb_ld(&(bar)[XB_TMO])) break; if (_sp > XB_SPIN_CAP) { atomicAdd(&(bar)[XB_TMO], 1u); break; } } } } while (0)
struct XcdBarrier { unsigned* bar; unsigned x; volatile LAS unsigned* st; int wv; };
__device__ __forceinline__ XcdBarrier xcd_barrier_post(unsigned* bar, volatile LAS unsigned* st, int wv) {
    XcdBarrier b; b.bar = bar; b.x = xb_xcc_id(); b.st = st; b.wv = wv;
    if (wv == 0 && lane_asm() == 0) (void)xb_add(&bar[XB_XCNT(b.x)], 1u);
    return b;
}
__device__ __forceinline__ void xcd_barrier_complete(unsigned* bar, unsigned x, unsigned& nloc, unsigned& nx) {
    const unsigned G = gridDim.x * gridDim.y * gridDim.z;
    unsigned sum, cnt, mine, sp = 0u;
    for (;;) {
        sum = 0u; cnt = 0u; mine = 0u;
#pragma unroll
        for (unsigned j = 0; j < 16; ++j) { const unsigned c = xb_ld(&bar[XB_XCNT(j)]); sum += c; cnt += (c > 0u) ? 1u : 0u; mine = (j == x) ? c : mine; }
        if (sum == G) break;
        __builtin_amdgcn_s_sleep(1);
        if ((++sp & 255u) == 0u) { if (xb_ld(&bar[XB_TMO])) break; if (sp > XB_SPIN_CAP) { atomicAdd(&bar[XB_TMO], 1u); break; } }
    }
    nloc = mine > 0u ? mine : 1u; nx = cnt > 0u ? cnt : 1u;
}
__device__ __forceinline__ void xcd_barrier(const XcdBarrier& b) {
    asm volatile("s_waitcnt vmcnt(0)" ::: "memory");
    __syncthreads();
    if (b.wv == 0 && lane_asm() == 0) {
        unsigned* bar = b.bar;
        __builtin_amdgcn_s_waitcnt(0);
        unsigned nloc = b.st[0], nx = b.st[1];
        if (nloc == 0u) { xcd_barrier_complete(bar, b.x, nloc, nx); b.st[0] = nloc; b.st[1] = nx; }
        const unsigned old = xb_add(&bar[XB_XSUB(b.x)], 1u);
        const unsigned gen = old / nloc;
        if (old + 1u == (gen + 1u) * nloc) {
            __builtin_amdgcn_fence(__ATOMIC_RELEASE, "agent");
            asm volatile("s_waitcnt vmcnt(0)" ::: "memory");
            const unsigned og = xb_add(&bar[XB_TOP], 1u);
            const unsigned tg = og / nx;
            if (og + 1u == (tg + 1u) * nx) xb_add(&bar[XB_TOPGEN], 1u);
            else XB_SPIN(xb_ld(&bar[XB_TOPGEN]) == tg, bar);
            __builtin_amdgcn_fence(__ATOMIC_ACQUIRE, "agent");
            xb_add(&bar[XB_XGEN(b.x)], 1u);
            asm volatile("s_waitcnt vmcnt(0)" ::: "memory");
        } else {
            XB_SPIN(xb_ld(&bar[XB_XGEN(b.x)]) == gen, bar);
            __builtin_amdgcn_fence(__ATOMIC_ACQUIRE, "agent");
            asm volatile("s_waitcnt vmcnt(0)" ::: "memory");
        }
    }
    __syncthreads();
}

struct Frame {
    LAS unsigned char* lds;
    int tid, lane, wave, vcu, G;
    unsigned char* ws;
};
struct Args { const float* in[26]; float* out; unsigned char* ws; int ph_lo, ph_hi; };
enum { I_X = 0, I_MIXG, I_WIN, I_CONVW, I_CONVB, I_WQ, I_WK, I_WV, I_WIF, I_BIF, I_SKIP, I_MHG, I_GMVG, I_WSP, I_BSP, I_GMOG, I_WOUT, I_FFNG,
       I_DW1, I_DW3, I_DW2, I_ROUTER, I_MW1, I_MW3, I_MW2, I_FING };

DI float rs_from(const f32x4 p) { return __builtin_amdgcn_rsqf(((p.x + p.y) + (p.z + p.w)) * (1.0f / D) + EPS); }
constexpr int L_SSL = RING_BYTES;

struct EpiIn {
    static constexpr bool PERM = true;
    bf16* O; const float* ssq; LAS unsigned char* lds; float* vst; bool scaled;
    DI void done(const pg8::Unit&, int) const {}
    DI void operator()(const f32x4 (&acc)[2][2][4][2], const pg8::Unit& u, int wr, int wc, int fr, int fq) const {
        const int row0 = u.pm * 256 + wr * 64 + fr, col0 = u.pn * 256 + wc * 32 + 8 * fq, act = u.pn >> 1;
        f32x4 pp[2][4];
#pragma unroll
        for (int ai = 0; ai < 2; ++ai)
#pragma unroll
            for (int m = 0; m < 4; ++m) { pp[ai][m] = (f32x4){0.f, 0.f, 0.f, 0.f}; if (!scaled) pp[ai][m] = *(const f32x4*)(ssq + (size_t)(row0 + ai * 128 + m * 16) * 4); }
#pragma unroll
        for (int ai = 0; ai < 2; ++ai)
#pragma unroll
            for (int m = 0; m < 4; ++m) { const int row = row0 + ai * 128 + m * 16; const float r = scaled ? 1.0f : rs_from(pp[ai][m]); bf16* rowp = O + (size_t)row * DIN + col0; float s1 = 0.f, s2 = 0.f;
#pragma unroll
                for (int bj = 0; bj < 2; ++bj) { float v[8];
#pragma unroll
                    for (int j = 0; j < 4; ++j) { v[j] = acc[ai][bj][m][0][j] * r; v[4 + j] = acc[ai][bj][m][1][j] * r; }
                    if (act == 1) {
#pragma unroll
                        for (int j = 0; j < 8; ++j) v[j] = sigmoidf(v[j]); }
                    else if (act >= 2) {
#pragma unroll
                        for (int j = 0; j < 8; ++j) v[j] = geluf(v[j]); }
                    u32x4 w; w.x = pg8::cvt_pk_bf16(v[0], v[1]); w.y = pg8::cvt_pk_bf16(v[2], v[3]); w.z = pg8::cvt_pk_bf16(v[4], v[5]); w.w = pg8::cvt_pk_bf16(v[6], v[7]);
                    *(u32x4*)(rowp + bj * 128) = w;
                    if (act == 3) { s1 += ((v[0] + v[1]) + (v[2] + v[3])) + ((v[4] + v[5]) + (v[6] + v[7])); s2 += ((v[0] * v[0] + v[1] * v[1]) + (v[2] * v[2] + v[3] * v[3])) + ((v[4] * v[4] + v[5] * v[5]) + (v[6] * v[6] + v[7] * v[7])); } }
                if (act == 3) { s1 += __shfl_xor(s1, 16); s1 += __shfl_xor(s1, 32); s2 += __shfl_xor(s2, 16); s2 += __shfl_xor(s2, 32);
                    if (fq == 0) *(f32x2*)(vst + ((size_t)row * 8 + (u.pn - 6) * 4 + wc) * 2) = (f32x2){s1, s2}; } }
    }
};
template <bool BF> struct EpiResT {
    static constexpr bool PERM = true;
    const float* base; bf16* xb; float* ssq; LAS unsigned char* lds;
    DI void done(const pg8::Unit&, int) const {}
    DI void operator()(const f32x4 (&acc)[2][2][4][2], const pg8::Unit& u, int wr, int wc, int fr, int fq) const {
        const int row0 = u.pm * 256 + wr * 64 + fr, col0 = u.pn * 256 + wc * 32 + 8 * fq;
        LAS float* SSL = (LAS float*)(lds + L_SSL);
#pragma unroll
        for (int ai = 0; ai < 2; ++ai) {
            f32x4 bs[4][2][2]; u32x4 bb[4][2];
#pragma unroll
            for (int m = 0; m < 4; ++m)
#pragma unroll
                for (int bj = 0; bj < 2; ++bj) { const size_t o_ = (size_t)(row0 + ai * 128 + m * 16) * D + col0 + bj * 128;
                    if constexpr (BF) bb[m][bj] = *(const u32x4*)(xb + o_); else { bs[m][bj][0] = *(const f32x4*)(base + o_); bs[m][bj][1] = *(const f32x4*)(base + o_ + 4); } }
#pragma unroll
            for (int m = 0; m < 4; ++m) { const int row = row0 + ai * 128 + m * 16; const size_t off = (size_t)row * D + col0; float ss = 0.f;
#pragma unroll
                for (int bj = 0; bj < 2; ++bj) { f32x4 b0, b1;
                    if constexpr (BF) { b0 = (f32x4){bflo(bb[m][bj].x), bfhi(bb[m][bj].x), bflo(bb[m][bj].y), bfhi(bb[m][bj].y)}; b1 = (f32x4){bflo(bb[m][bj].z), bfhi(bb[m][bj].z), bflo(bb[m][bj].w), bfhi(bb[m][bj].w)}; }
                    else { b0 = bs[m][bj][0]; b1 = bs[m][bj][1]; }
                    const f32x4 o0 = b0 + acc[ai][bj][m][0], o1 = b1 + acc[ai][bj][m][1];
                    ss += ((o0.x * o0.x + o0.y * o0.y) + (o0.z * o0.z + o0.w * o0.w)) + ((o1.x * o1.x + o1.y * o1.y) + (o1.z * o1.z + o1.w * o1.w));
                    u32x4 w; w.x = pg8::cvt_pk_bf16(o0.x, o0.y); w.y = pg8::cvt_pk_bf16(o0.z, o0.w); w.z = pg8::cvt_pk_bf16(o1.x, o1.y); w.w = pg8::cvt_pk_bf16(o1.z, o1.w);
                    *(u32x4*)(xb + off + bj * 128) = w; }
                ss += __shfl_xor(ss, 16); ss += __shfl_xor(ss, 32);
                if (fq == 0) SSL[(ai * 128 + wr * 64 + m * 16 + fr) * 4 + wc] = ss; }
            asm volatile("" ::: "memory"); }
        LDS_WAIT(); __builtin_amdgcn_s_barrier(); asm volatile("" ::: "memory");
        const int tix = (wr * 4 + wc) * 64 + fq * 16 + fr;
        if (tix < 256) { const f32x4 p = *(const LAS f32x4*)(SSL + tix * 4); ssq[(size_t)(u.pm * 256 + tix) * 4 + u.pn] = (p.x + p.y) + (p.z + p.w); }
    }
};
template <bool MOE> struct EpiGlu {
    static constexpr bool PERM = true;
    bf16* O; int ld; const float* ssq; const int* rowtok; unsigned* hidcnt; unsigned need;
    DI void done(const pg8::Unit&, int) const {}
    DI void operator()(const f32x4 (&acc)[2][2][4][2], const pg8::Unit& u, int wr, int wc, int fr, int fq) const {
        const int row0 = u.pm * 256 + wr * 64 + fr, orow0 = u.ph * 256 + wr * 64 + fr, col0 = u.pn * 128 + wc * 32 + 8 * fq;
        f32x4 pp[2][4];
#pragma unroll
        for (int ai = 0; ai < 2; ++ai)
#pragma unroll
            for (int m = 0; m < 4; ++m) { pp[ai][m] = (f32x4){0.f, 0.f, 0.f, 0.f}; if (!MOE) pp[ai][m] = *(const f32x4*)(ssq + (size_t)(row0 + ai * 128 + m * 16) * 4); }
        if (MOE) { if (need) { unsigned sp = 0; while ((unsigned)__builtin_amdgcn_readfirstlane(__hip_atomic_load(hidcnt + 64 * u.ph, __ATOMIC_RELAXED, __HIP_MEMORY_SCOPE_AGENT)) < need) { __builtin_amdgcn_s_sleep(2); if (++sp > (1u << 22)) break; } } }
#pragma unroll
        for (int ai = 0; ai < 2; ++ai)
#pragma unroll
            for (int m = 0; m < 4; ++m) { const float r = MOE ? 1.0f : rs_from(pp[ai][m]); float v[8];
#pragma unroll
                for (int j = 0; j < 4; ++j) { v[j] = siluf(acc[ai][0][m][0][j] * r) * (acc[ai][1][m][0][j] * r); v[4 + j] = siluf(acc[ai][0][m][1][j] * r) * (acc[ai][1][m][1][j] * r); }
                u32x4 w; w.x = pg8::cvt_pk_bf16(v[0], v[1]); w.y = pg8::cvt_pk_bf16(v[2], v[3]); w.z = pg8::cvt_pk_bf16(v[4], v[5]); w.w = pg8::cvt_pk_bf16(v[6], v[7]);
                *(u32x4*)(O + (size_t)(orow0 + ai * 128 + m * 16) * ld + col0) = w; }
    }
};
template <bool F8> struct EpiGluI8T {
    static constexpr bool PERM = true;
    bf16* O; int ld; const float* rowsa; const float* sw13; unsigned* hidcnt; unsigned need;
    DI void done(const pg8::Unit&, int) const {}
    DI void operator()(const i32x4 (&acc)[2][2][4][2], const pg8::Unit& u, int wr, int wc, int fr, int fq) const {
        const int row0 = u.pm * 256 + wr * 64 + fr, orow0 = u.ph * 256 + wr * 64 + fr, col0 = u.pn * 128 + wc * 32 + 8 * fq;
        float sa[2][4];
#pragma unroll
        for (int ai = 0; ai < 2; ++ai)
#pragma unroll
            for (int m = 0; m < 4; ++m) sa[ai][m] = rowsa[row0 + ai * 128 + m * 16];
        const float* swp = sw13 + (size_t)u.e * (2 * DFE) + u.pn * 256 + wc * 32 + 8 * fq;
        const f32x4 sg0 = *(const f32x4*)(swp), sg1 = *(const f32x4*)(swp + 4), su0 = *(const f32x4*)(swp + 128), su1 = *(const f32x4*)(swp + 132);
        if (need) { unsigned sp = 0; while ((unsigned)__builtin_amdgcn_readfirstlane(__hip_atomic_load(hidcnt + 64 * u.ph, __ATOMIC_RELAXED, __HIP_MEMORY_SCOPE_AGENT)) < need) { __builtin_amdgcn_s_sleep(2); if (++sp > (1u << 22)) break; } }
        const float sg[8] = {sg0.x, sg0.y, sg0.z, sg0.w, sg1.x, sg1.y, sg1.z, sg1.w}, su[8] = {su0.x, su0.y, su0.z, su0.w, su1.x, su1.y, su1.z, su1.w};
#pragma unroll
        for (int ai = 0; ai < 2; ++ai)
#pragma unroll
            for (int m = 0; m < 4; ++m) { const float r = sa[ai][m] * (1.0f / 127.0f); float v[8];
#pragma unroll
                for (int j = 0; j < 4; ++j) { v[j] = siluf((float)acc[ai][0][m][0][j] * (r * sg[j])) * ((float)acc[ai][1][m][0][j] * (r * su[j]));
                    v[4 + j] = siluf((float)acc[ai][0][m][1][j] * (r * sg[4 + j])) * ((float)acc[ai][1][m][1][j] * (r * su[4 + j])); }
                if constexpr (F8) { int w0 = __builtin_amdgcn_cvt_pk_fp8_f32(v[0], v[1], 0, false); w0 = __builtin_amdgcn_cvt_pk_fp8_f32(v[2], v[3], w0, true);
                    int w1 = __builtin_amdgcn_cvt_pk_fp8_f32(v[4], v[5], 0, false); w1 = __builtin_amdgcn_cvt_pk_fp8_f32(v[6], v[7], w1, true);
                    *(u32x2*)((unsigned char*)O + (size_t)(orow0 + ai * 128 + m * 16) * ld + col0) = (u32x2){(unsigned)w0, (unsigned)w1}; }
                else { u32x4 w; w.x = pg8::cvt_pk_bf16(v[0], v[1]); w.y = pg8::cvt_pk_bf16(v[2], v[3]); w.z = pg8::cvt_pk_bf16(v[4], v[5]); w.w = pg8::cvt_pk_bf16(v[6], v[7]);
                    *(u32x4*)(O + (size_t)(orow0 + ai * 128 + m * 16) * ld + col0) = w; } }
    }
};
typedef EpiGluI8T<false> EpiGluI8;
struct EpiGluF8 {
    static constexpr bool PERM = true;
    unsigned char* O; int ld; unsigned* hidcnt; unsigned need;
    DI void done(const pg8::Unit&, int) const {}
    DI void operator()(const f32x4 (&acc)[2][2][4][2], const pg8::Unit& u, int wr, int wc, int fr, int fq) const {
        const int orow0 = u.ph * 256 + wr * 64 + fr, col0 = u.pn * 128 + wc * 32 + 8 * fq;
        if (need) { unsigned sp = 0; while ((unsigned)__builtin_amdgcn_readfirstlane(__hip_atomic_load(hidcnt + 64 * u.ph, __ATOMIC_RELAXED, __HIP_MEMORY_SCOPE_AGENT)) < need) { __builtin_amdgcn_s_sleep(2); if (++sp > (1u << 22)) break; } }
#pragma unroll
        for (int ai = 0; ai < 2; ++ai)
#pragma unroll
            for (int m = 0; m < 4; ++m) { float v[8];
#pragma unroll
                for (int n = 0; n < 2; ++n)
#pragma unroll
                    for (int j = 0; j < 4; ++j) { const float t = acc[ai][0][m][n][j]; v[4 * n + j] = (t * acc[ai][1][m][n][j]) * __builtin_amdgcn_rcpf(1.0f + __builtin_amdgcn_exp2f(t)); }
                int w0 = __builtin_amdgcn_cvt_pk_fp8_f32(v[0], v[1], 0, false); w0 = __builtin_amdgcn_cvt_pk_fp8_f32(v[2], v[3], w0, true);
                int w1 = __builtin_amdgcn_cvt_pk_fp8_f32(v[4], v[5], 0, false); w1 = __builtin_amdgcn_cvt_pk_fp8_f32(v[6], v[7], w1, true);
                *(u32x2*)(O + (size_t)(orow0 + ai * 128 + m * 16) * ld + col0) = (u32x2){(unsigned)w0, (unsigned)w1}; }
    }
};
struct EpiMoe2 {
    static constexpr bool PERM = true;
    bf16* xb; const int* rowtok; const float* rowgate; unsigned* hidcnt;
    DI void done(const pg8::Unit& u, int tid) const { if (tid == 0) __hip_atomic_fetch_add(hidcnt + 64 * u.ph, 1u, __ATOMIC_RELAXED, __HIP_MEMORY_SCOPE_AGENT); }
    DI void operator()(const f32x4 (&acc)[2][2][4][2], const pg8::Unit& u, int wr, int wc, int fr, int fq) const {
        const int row0 = u.pm * 256 + wr * 64 + fr, col0 = u.pn * 256 + wc * 32 + 8 * fq;
        int tok[2][4]; float gt[2][4];
#pragma unroll
        for (int ai = 0; ai < 2; ++ai)
#pragma unroll
            for (int m = 0; m < 4; ++m) { const int row = row0 + ai * 128 + m * 16; tok[ai][m] = rowtok[row]; gt[ai][m] = rowgate[row]; }
        u32x4 bb[2][4][2];
#pragma unroll
        for (int ai = 0; ai < 2; ++ai)
#pragma unroll
            for (int m = 0; m < 4; ++m) { const size_t off = (size_t)(tok[ai][m] < 0 ? 0 : tok[ai][m]) * D + col0;
#pragma unroll
                for (int bj = 0; bj < 2; ++bj) bb[ai][m][bj] = *(const u32x4*)(xb + off + bj * 128); }
#pragma unroll
        for (int ai = 0; ai < 2; ++ai)
#pragma unroll
            for (int m = 0; m < 4; ++m) { if (tok[ai][m] >= 0) { const size_t off = (size_t)tok[ai][m] * D + col0;
#pragma unroll
                for (int bj = 0; bj < 2; ++bj) { const u32x4 b = bb[ai][m][bj];
                    const f32x4 o0 = (f32x4){bflo(b.x), bfhi(b.x), bflo(b.y), bfhi(b.y)} + gt[ai][m] * acc[ai][bj][m][0], o1 = (f32x4){bflo(b.z), bfhi(b.z), bflo(b.w), bfhi(b.w)} + gt[ai][m] * acc[ai][bj][m][1];
                    u32x4 w; w.x = pg8::cvt_pk_bf16(o0.x, o0.y); w.y = pg8::cvt_pk_bf16(o0.z, o0.w); w.z = pg8::cvt_pk_bf16(o1.x, o1.y); w.w = pg8::cvt_pk_bf16(o1.z, o1.w);
                    *(u32x4*)(xb + off + bj * 128) = w; } } }
    }
};

DI void tr_item(const float* W, int N, const float* kscale, bf16* WT, int ldk, int mode, int add, int item, LAS float* scr, int lane) {
    const int nblk = N / 64, kb = item / nblk, nb = item % nblk, k0 = 64 * kb, n0 = 64 * nb;
    const int drow0 = mode ? (((n0 >> 7) << 8) + (n0 & 127) + add) : n0;
    const int kr = lane >> 4, nc = (lane & 15) * 4;
    f32x4 v[16];
#pragma unroll
    for (int i = 0; i < 16; ++i) v[i] = *(const f32x4*)(W + (size_t)(k0 + 4 * i + kr) * N + n0 + nc);
#pragma unroll
    for (int i = 0; i < 16; ++i) { const int kk = 4 * i + kr; f32x4 x = v[i]; if (kscale) x = x * kscale[k0 + kk];
        LAS float* d = scr + kk * 65 + nc; d[0] = x.x; d[1] = x.y; d[2] = x.z; d[3] = x.w; }
    LDS_WAIT(); asm volatile("" ::: "memory");
    const int c = lane & 7;
#pragma unroll
    for (int j = 0; j < 8; ++j) { const int n = (lane >> 3) + 8 * j; const LAS float* sp = scr + (8 * c) * 65 + n;
        u32x4 o; o.x = pk2(sp[0 * 65], sp[1 * 65]); o.y = pk2(sp[2 * 65], sp[3 * 65]); o.z = pk2(sp[4 * 65], sp[5 * 65]); o.w = pk2(sp[6 * 65], sp[7 * 65]);
        *(u32x4*)(WT + (size_t)(drow0 + n) * ldk + k0 + 8 * c) = o; }
    LDS_WAIT(); asm volatile("" ::: "memory");
}
DI void absmax_item(const float* W, int N, const float* ks, unsigned* sw, int add, int item, int lane);
DI void f8_item(const float* W, int N, const float* ks, float mul, unsigned char* dst, int ldk, bool il, int add, int item, LAS float* scr, int lane);
DI void p0_prologue(const Frame& F, const Args& a) {
    LAS float* scr = (LAS float*)(F.lds + F.wave * 16896);
    const int gw = F.vcu * 8 + F.wave, NGW = F.G * 8, lane = F.lane;
    unsigned char* ws = F.ws;
    constexpr int I_IN = 16 * 32, I_OUT = 16 * 16, I_W1 = 16 * 43, I_W2 = 43 * 16, I_QKV = 2 * 2;
    constexpr int NITEMS = 2 * I_IN + 2 * I_OUT + 2 * I_W1 + 24 * I_QKV;
    for (int it = gw; it < NITEMS; it += NGW) {
        int r = it;
        if (r < 2 * I_IN) { const int l = r / I_IN; tr_item(a.in[I_WIN] + (size_t)l * D * DIN, DIN, a.in[I_MIXG] + l * D, (bf16*)(ws + WS_WIN) + (size_t)l * DIN * D, D, 0, 0, r % I_IN, scr, lane); continue; } r -= 2 * I_IN;
        if (r < 2 * I_OUT) { const int l = r / I_OUT; tr_item(a.in[I_WOUT] + (size_t)l * D * D, D, nullptr, (bf16*)(ws + WS_WOUT) + (size_t)l * D * D, D, 0, 0, r % I_OUT, scr, lane); continue; } r -= 2 * I_OUT;
        if (r < I_W1) { absmax_item(a.in[I_DW1], DFF, a.in[I_FFNG], (unsigned*)(ws + WS_SWD), 0, r, lane); continue; } r -= I_W1;
        if (r < I_W1) { absmax_item(a.in[I_DW3], DFF, a.in[I_FFNG], (unsigned*)(ws + WS_SWD), 128, r, lane); continue; } r -= I_W1;
        { const int mtx = r / I_QKV, m = mtx / 8, lh = mtx % 8;
          tr_item(a.in[I_WQ + m] + (size_t)lh * 128 * 128, 128, nullptr, (bf16*)(ws + WS_WQ) + (size_t)mtx * 128 * 128, 128, 0, 0, r % I_QKV, scr, lane); }
    }
    { const int gt = gw * 64 + lane, NGT = NGW * 64; const u32x4 z = (u32x4){0u, 0u, 0u, 0u};
      for (int i = gt; i < 128 * (D / 16); i += NGT) { const int rr = i / (D / 16), c16 = i % (D / 16); const int row = 21 * 256 + (rr < 64 ? 64 + rr : 192 + (rr - 64)); *(u32x4*)((signed char*)(ws + WS_W13) + (size_t)row * D + c16 * 16) = z; }
      for (int i = gt; i < D * 4; i += NGT) { const int row = i / 4, c4 = i % 4; *(u32x4*)(ws + WS_W2 + (size_t)row * DFFP + DFF + c4 * 16) = z; } }
    for (int m0 = gw * 4; m0 < T; m0 += NGW * 4) {
        f32x4 v[4][4];
#pragma unroll
        for (int r = 0; r < 4; ++r) { const f32x4* xr = (const f32x4*)(a.in[I_X] + (size_t)(m0 + r) * D) + lane;
#pragma unroll
            for (int j = 0; j < 4; ++j) v[r][j] = xr[64 * j]; }
#pragma unroll
        for (int r = 0; r < 4; ++r) { float s_ = 0.f;
#pragma unroll
            for (int j = 0; j < 4; ++j) s_ += (v[r][j].x * v[r][j].x + v[r][j].y * v[r][j].y) + (v[r][j].z * v[r][j].z + v[r][j].w * v[r][j].w);
            s_ = wave_sum(s_);
            u32x2* o8 = (u32x2*)((bf16*)(ws + WS_XB) + (size_t)(m0 + r) * D) + lane;
#pragma unroll
            for (int j = 0; j < 4; ++j) { u32x2 w; w.x = pk2(v[r][j].x, v[r][j].y); w.y = pk2(v[r][j].z, v[r][j].w); o8[64 * j] = w; }
            if (lane < 4) ((float*)(ws + WS_SSQ))[(size_t)(m0 + r) * 4 + lane] = lane == 0 ? s_ : 0.f; }
    }
    for (int it = gw; it < 2 * 16; it += NGW) {
        const int l = it / 16, c = (it % 16) * 64 + lane, part = c >> 9, cc = c & 511, h = cc >> 7, d = cc & 127;
        const float* wif = a.in[I_WIF] + (size_t)l * 1536 * 8;
        float accj[8];
#pragma unroll
        for (int j = 0; j < 8; ++j) accj[j] = 0.f;
        if (part == 0) {
            const float* wq = a.in[I_WQ] + ((size_t)(l * 4 + h) * 128 + d) * 128; const float* wk = a.in[I_WK] + ((size_t)(l * 4 + h) * 128 + d) * 128;
            for (int e = 0; e < 128; ++e) { const float q = wq[e], k = wk[e]; const float* fq_ = wif + (size_t)(128 * h + e) * 8; const float* fk_ = wif + (size_t)(512 + 128 * h + e) * 8;
#pragma unroll
                for (int j = 0; j < 8; ++j) accj[j] += q * fq_[j] + k * fk_[j]; }
        } else {
            const float* wv = a.in[I_WV] + ((size_t)(l * 4 + h) * 128 + d) * 128;
            for (int e = 0; e < 128; ++e) { const float v = wv[e]; const float* fv_ = wif + (size_t)(1024 + 128 * h + e) * 8;
#pragma unroll
                for (int j = 0; j < 8; ++j) accj[j] += v * fv_[j]; }
        }
        bf16* wg = (bf16*)(ws + WS_WG) + (size_t)l * 16 * 1024;
#pragma unroll
        for (int j = 0; j < 8; ++j) { wg[j * 1024 + c] = (bf16)f2bf(accj[j]); wg[(8 + j) * 1024 + c] = 0; }
    }
    { const int gt = gw * 64 + lane, NGT = NGW * 64;
      for (int i = gt; i < 2 * 4 * 128 * 128; i += NGT) { const int ii = (i >> 7) & 127, jj = i & 127; const float v = ((ii >> 6) >= (jj >> 6)) ? a.in[I_WSP][i] : 0.f; ((bf16*)(ws + WS_WSP))[i] = (bf16)f2bf(v); } }
}
DI void absmax_item(const float* W, int N, const float* ks, unsigned* sw, int add, int item, int lane) {
    const int nblk = N / 64, kb = item / nblk, nb = item % nblk, k0 = 64 * kb, n0 = 64 * nb, kr = lane >> 4, nc = (lane & 15) * 4;
    f32x4 v[16];
#pragma unroll
    for (int i = 0; i < 16; ++i) v[i] = *(const f32x4*)(W + (size_t)(k0 + 4 * i + kr) * N + n0 + nc);
    f32x4 mx = (f32x4){0.f, 0.f, 0.f, 0.f};
#pragma unroll
    for (int i = 0; i < 16; ++i) { const f32x4 x = v[i] * ks[k0 + 4 * i + kr]; mx.x = fmaxf(mx.x, fabsf(x.x)); mx.y = fmaxf(mx.y, fabsf(x.y)); mx.z = fmaxf(mx.z, fabsf(x.z)); mx.w = fmaxf(mx.w, fabsf(x.w)); }
#pragma unroll
    for (int c = 0; c < 4; ++c) { mx[c] = fmaxf(mx[c], __shfl_xor(mx[c], 16)); mx[c] = fmaxf(mx[c], __shfl_xor(mx[c], 32)); }
    if (kr == 0) { unsigned* p = sw + ((n0 >> 7) << 8) + (n0 & 127) + add + nc;
#pragma unroll
        for (int c = 0; c < 4; ++c) atomicMax(p + c, __builtin_bit_cast(unsigned, mx[c])); }
}
DI void quant_item(const float* W, int N, const float* ks, const float* sw, signed char* dst, int add, int item, LAS float* scr, int lane) {
    const int nblk = N / 64, kb = item / nblk, nb = item % nblk, k0 = 64 * kb, n0 = 64 * nb, kr = lane >> 4, nc = (lane & 15) * 4;
    const int drow0 = ((n0 >> 7) << 8) + (n0 & 127) + add;
    f32x4 v[16];
#pragma unroll
    for (int i = 0; i < 16; ++i) v[i] = *(const f32x4*)(W + (size_t)(k0 + 4 * i + kr) * N + n0 + nc);
    const int kq = lane & 3, nl = lane >> 2;
    float inv[4];
#pragma unroll
    for (int j = 0; j < 4; ++j) { const float amax = sw[drow0 + nl + 16 * j]; inv[j] = amax > 0.f ? 127.0f / amax : 0.f; }
#pragma unroll
    for (int i = 0; i < 16; ++i) { const int kk = 4 * i + kr; const f32x4 x = v[i] * ks[k0 + kk]; LAS float* p = scr + kk * 65 + nc; p[0] = x.x; p[1] = x.y; p[2] = x.z; p[3] = x.w; }
    LDS_WAIT(); asm volatile("" ::: "memory");
#pragma unroll
    for (int j = 0; j < 4; ++j) { const int n = nl + 16 * j; u32x4 o;
#pragma unroll
        for (int d = 0; d < 4; ++d) { unsigned wd = 0;
#pragma unroll
            for (int b = 0; b < 4; ++b) { const float q = rintf(scr[(16 * kq + 4 * d + b) * 65 + n] * inv[j]); const int qi = (int)fminf(fmaxf(q, -127.f), 127.f); wd |= ((unsigned)qi & 0xffu) << (8 * b); }
            o[d] = wd; }
        *(u32x4*)(dst + (size_t)(drow0 + n) * D + k0 + 16 * kq) = o; }
    LDS_WAIT(); asm volatile("" ::: "memory");
}
DI void f8_item(const float* W, int N, const float* ks, float mul, unsigned char* dst, int ldk, bool il, int add, int item, LAS float* scr, int lane) {
    const int nblk = N / 64, kb = item / nblk, nb = item % nblk, k0 = 64 * kb, n0 = 64 * nb, kr = lane >> 4, nc = (lane & 15) * 4;
    const int drow0 = il ? ((n0 >> 7) << 8) + (n0 & 127) + add : n0;
    f32x4 v[16];
#pragma unroll
    for (int i = 0; i < 16; ++i) v[i] = *(const f32x4*)(W + (size_t)(k0 + 4 * i + kr) * N + n0 + nc);
    const int kq = lane & 3, nl = lane >> 2;
#pragma unroll
    for (int i = 0; i < 16; ++i) { const int kk = 4 * i + kr; const f32x4 x = v[i] * (ks ? ks[k0 + kk] * mul : mul); LAS float* p = scr + kk * 65 + nc; p[0] = x.x; p[1] = x.y; p[2] = x.z; p[3] = x.w; }
    LDS_WAIT(); asm volatile("" ::: "memory");
#pragma unroll
    for (int j = 0; j < 4; ++j) { const int n = nl + 16 * j; u32x4 o;
#pragma unroll
        for (int d = 0; d < 4; ++d) { const LAS float* q = scr + (16 * kq + 4 * d) * 65 + n;
            int wd = __builtin_amdgcn_cvt_pk_fp8_f32(q[0], q[65], 0, false); wd = __builtin_amdgcn_cvt_pk_fp8_f32(q[130], q[195], wd, true); o[d] = (unsigned)wd; }
        *(u32x4*)(dst + (size_t)(drow0 + n) * ldk + k0 + 16 * kq) = o; }
    LDS_WAIT(); asm volatile("" ::: "memory");
}
DI void moe_weights(const Frame& F, const Args& a) {
    LAS float* scr = (LAS float*)(F.lds + F.wave * 16896);
    const int gw = F.vcu * 8 + F.wave, NGW = F.G * 8, lane = F.lane;
    constexpr int I_1 = 16 * 56, I_2 = 56 * 16;
    constexpr int NITEMS = 16 * I_1 + 8 * I_2;
    for (int it = gw; it < NITEMS; it += NGW) {
        int r = it;
        if (r < 16 * I_1) { const int m = r / I_1, e = m >> 1, w3 = m & 1;
            f8_item(a.in[w3 ? I_MW3 : I_MW1] + (size_t)e * D * DFE, DFE, a.in[I_FFNG] + D, w3 ? -64.0f * 0.69314718056f : -64.0f * 1.44269504089f, F.ws + WS_MW13 + (size_t)e * (2 * DFE) * D, D, true, w3 ? 128 : 0, r % I_1, scr, lane); continue; }
        r -= 16 * I_1;
        { const int e = r / I_2; f8_item(a.in[I_MW2] + (size_t)e * DFE * D, D, nullptr, 64.0f, F.ws + WS_MW2 + (size_t)e * D * DFE, DFE, false, 0, r % I_2, scr, lane); }
    }
}
DI void dense_quant(const Frame& F, const Args& a) {
    LAS float* scr = (LAS float*)(F.lds + F.wave * 16896);
    const int gw = F.vcu * 8 + F.wave, NGW = F.G * 8, lane = F.lane;
    constexpr int I_1 = 16 * 43, I_W2 = 43 * 16;
    for (int it = gw; it < 2 * I_1 + I_W2; it += NGW) { const int w3 = it / I_1;
        if (it >= 2 * I_1) { f8_item(a.in[I_DW2], D, nullptr, 64.0f, F.ws + WS_W2, DFFP, false, 0, it - 2 * I_1, scr, lane); continue; }
        quant_item(a.in[w3 ? I_DW3 : I_DW1], DFF, a.in[I_FFNG], (const float*)(F.ws + WS_SWD), (signed char*)(F.ws + WS_W13), w3 ? 128 : 0, it % I_1, scr, lane); }
}
DI void rows_to_int8(const Frame& F) {
    unsigned char* ws = F.ws; const int gw = F.vcu * 8 + F.wave, NGW = F.G * 8, lane = F.lane;
    const bf16* xb = (const bf16*)(ws + WS_XB); const float* ssq = (const float*)(ws + WS_SSQ);
    u32x4 va[4], vb[4], na[4], nb[4];
#define RQ_LOAD(A_, B_, mbase) do { _Pragma("unroll") for (int r = 0; r < 4; ++r) { const u32x4* p_ = (const u32x4*)(xb + (size_t)((mbase) + r) * D) + lane; A_[r] = p_[0]; B_[r] = p_[64]; } } while (0)
    int m0 = gw * 4; if (m0 >= T) return;
    RQ_LOAD(va, vb, m0);
#pragma unroll 1
    for (;;) { const int mn = m0 + NGW * 4; const bool more = mn < T;
        if (more) RQ_LOAD(na, nb, mn);
#pragma unroll
        for (int r = 0; r < 4; ++r) { const int m = m0 + r; const float rs = rs_from(*(const f32x4*)(ssq + (size_t)m * 4));
            const unsigned wv[8] = {va[r].x, va[r].y, va[r].z, va[r].w, vb[r].x, vb[r].y, vb[r].z, vb[r].w};
            float am = 0.f;
#pragma unroll
            for (int i = 0; i < 8; ++i) am = fmaxf(am, fmaxf(fabsf(bflo(wv[i])), fabsf(bfhi(wv[i]))));
            am = wave_max(am) * rs; const float inv = am > 0.f ? 127.0f / am : 0.f, qs = rs * inv;
            unsigned o[4];
#pragma unroll
            for (int i = 0; i < 4; ++i) { const int q0 = (int)rintf(bflo(wv[2 * i]) * qs), q1 = (int)rintf(bfhi(wv[2 * i]) * qs), q2 = (int)rintf(bflo(wv[2 * i + 1]) * qs), q3 = (int)rintf(bfhi(wv[2 * i + 1]) * qs);
                o[i] = ((unsigned)q0 & 0xffu) | (((unsigned)q1 & 0xffu) << 8) | (((unsigned)q2 & 0xffu) << 16) | (((unsigned)q3 & 0xffu) << 24); }
            u32x2* d8 = (u32x2*)((signed char*)(ws + WS_XB8D) + (size_t)m * D) + lane;
            d8[0] = (u32x2){o[0], o[1]}; d8[64] = (u32x2){o[2], o[3]};
            if (lane == 0) ((float*)(ws + WS_SA))[m] = am * (1.0f / 127.0f); }
        if (!more) break;
        m0 = mn;
#pragma unroll
        for (int r = 0; r < 4; ++r) { va[r] = na[r]; vb[r] = nb[r]; } }
#undef RQ_LOAD
}

struct Mix { int l; const bf16* proj; const float *convw, *convb, *bif, *skip, *mhg, *gmvg, *bsp, *gmog; const bf16 *wg, *wq, *wk, *wv, *wsp; };
constexpr int L_XM = 0, L_XC = 18432, L_Q = 35840, L_K = 53248, L_KTW = 70656, L_VT = 89088, L_SM = 110592;
constexpr int L_RED = L_Q;
constexpr int S128 = 272, S64 = 144;
DI bf16x8 ldf(const LAS unsigned char* p) { return *(const LAS bf16x8*)p; }

DI void load_xm_conv(const Frame& F, const Mix& M, int t0, bool first, int h) {
    LAS unsigned char* lds = F.lds; const int tid = F.tid;
#pragma unroll
    for (int it = 0; it < 3; ++it) { const int p = tid + 512 * it; if (p < 67 * 16) { const int row = p >> 4, c16 = p & 15; u32x4 v = (u32x4){0u, 0u, 0u, 0u};
        if (!(first && row < 3)) v = *(const u32x4*)(M.proj + (size_t)(t0 - 3 + row) * DIN + h * 128 + c16 * 8);
        *(LAS u32x4*)(lds + L_XM + row * S128 + c16 * 16) = v; } }
    const int cg = tid & 15, ch = h * 128 + cg * 8;
    float cw[4][8], cb[8];
#pragma unroll
    for (int j = 0; j < 4; ++j) { const f32x4 a = *(const f32x4*)(M.convw + j * 512 + ch), b = *(const f32x4*)(M.convw + j * 512 + ch + 4);
        cw[j][0] = a.x; cw[j][1] = a.y; cw[j][2] = a.z; cw[j][3] = a.w; cw[j][4] = b.x; cw[j][5] = b.y; cw[j][6] = b.z; cw[j][7] = b.w; }
    { const f32x4 a = *(const f32x4*)(M.convb + ch), b = *(const f32x4*)(M.convb + ch + 4); cb[0] = a.x; cb[1] = a.y; cb[2] = a.z; cb[3] = a.w; cb[4] = b.x; cb[5] = b.y; cb[6] = b.z; cb[7] = b.w; }
    __syncthreads();
#pragma unroll
    for (int it = 0; it < 2; ++it) { const int t = (tid >> 4) + 32 * it; float y[8];
#pragma unroll
        for (int c = 0; c < 8; ++c) y[c] = cb[c];
#pragma unroll
        for (int j = 0; j < 4; ++j) { const u32x4 x = *(const LAS u32x4*)(lds + L_XM + (t + j) * S128 + cg * 16);
            y[0] += cw[j][0] * bflo(x.x); y[1] += cw[j][1] * bfhi(x.x); y[2] += cw[j][2] * bflo(x.y); y[3] += cw[j][3] * bfhi(x.y);
            y[4] += cw[j][4] * bflo(x.z); y[5] += cw[j][5] * bfhi(x.z); y[6] += cw[j][6] * bflo(x.w); y[7] += cw[j][7] * bfhi(x.w); }
        u32x4 o; o.x = pk2(siluf(y[0]), siluf(y[1])); o.y = pk2(siluf(y[2]), siluf(y[3])); o.z = pk2(siluf(y[4]), siluf(y[5])); o.w = pk2(siluf(y[6]), siluf(y[7]));
        *(LAS u32x4*)(lds + L_XC + t * S128 + cg * 16) = o; }
    __syncthreads();
}

DI void mlstm_local_unit(const Frame& F, const Mix& M, int u) {
    LAS unsigned char* lds = F.lds; const int tid = F.tid, lane = F.lane, w = F.wave, fr = lane & 15, fq = lane >> 4;
    const int t0 = u * CH; const bool first = (u % NCH) == 0; const int bb = u / NCH, cc = u % NCH;
    LAS float* IG = (LAS float*)(lds + L_SM); LAS float* BBs = IG + 256; LAS float* WSC = IG + 512;
    unsigned char* ws = F.ws;
    if (tid < 16 * 8) { const int row = 128 + (tid >> 3), c = tid & 7; const unsigned v = (row == 128) ? 0x3f803f80u : 0u; *(LAS u32x4*)(lds + L_VT + row * S64 + c * 16) = (u32x4){v, v, v, v}; }
    f32x4 accg[4];
#pragma unroll
    for (int tt = 0; tt < 4; ++tt) accg[tt] = (f32x4){0.f, 0.f, 0.f, 0.f};
    for (int h = 0; h < 4; ++h) {
        load_xm_conv(F, M, t0, first, h);
        const int cbase = (w < 4) ? (h * 128 + 32 * w) : (512 + h * 128 + 32 * (w - 4));
        const bf16x8 a = *(const bf16x8*)(M.wg + (size_t)fr * 1024 + cbase + 8 * fq);
#pragma unroll
        for (int tt = 0; tt < 4; ++tt) { const int t = 16 * tt + fr;
            const bf16x8 b = (w < 4) ? ldf(lds + L_XC + t * S128 + (32 * w + 8 * fq) * 2) : ldf(lds + L_XM + (t + 3) * S128 + (32 * (w - 4) + 8 * fq) * 2);
            accg[tt] = MFMA16(a, b, accg[tt]); }
        __syncthreads();
    }
    if (fq < 2) {
#pragma unroll
        for (int tt = 0; tt < 4; ++tt)
#pragma unroll
            for (int r = 0; r < 4; ++r) *(LAS float*)(lds + L_RED + ((w * 8 + 4 * fq + r) * 64 + 16 * tt + fr) * 4) = accg[tt][r];
    }
    __syncthreads();
    { float pre = M.bif[w];
#pragma unroll
      for (int ww = 0; ww < 8; ++ww) pre += *(const LAS float*)(lds + L_RED + ((ww * 8 + w) * 64 + lane) * 4);
      if (w < 4) IG[w * 64 + lane] = pre;
      else { float lf = fminf(pre, 0.f) - softplus_neg(fabsf(pre));
#pragma unroll
          for (int o = 1; o < 64; o <<= 1) { const float v = __shfl_up(lf, o); if (lane >= o) lf += v; }
          BBs[(w - 4) * 64 + lane] = lf; } }
    __syncthreads();
    if (w < 4) { const float bt = BBs[w * 64 + lane], g = IG[w * 64 + lane] - bt, gmax = wave_max(g), bend = BBs[w * 64 + 63];
        WSC[w * 64 + lane] = fexp(g - gmax);
        float* gb = (float*)(ws + WS_GB) + (size_t)(u * 4 + w) * 128; gb[lane] = bt; gb[64 + lane] = g;
        if (lane == 0) { float* sc = (float*)(ws + WS_SC) + ((size_t)(bb * 4 + w) * NCH + cc) * 2; sc[0] = bend; sc[1] = bend + gmax; } }
    __syncthreads();
    for (int h = 0; h < 4; ++h) {
        load_xm_conv(F, M, t0, first, h);
        const int lh = M.l * 4 + h;
        bf16x8 aq[4], bk[4], bv[4];
#pragma unroll
        for (int ks = 0; ks < 4; ++ks) { const size_t o = ((size_t)lh * 128 + 16 * w + fr) * 128 + 32 * ks + 8 * fq;
            aq[ks] = *(const bf16x8*)(M.wq + o); bk[ks] = *(const bf16x8*)(M.wk + o); bv[ks] = *(const bf16x8*)(M.wv + o); }
#pragma unroll
        for (int tt = 0; tt < 4; ++tt) {
            bf16x8 xcf[4], xmf[4];
#pragma unroll
            for (int ks = 0; ks < 4; ++ks) { xcf[ks] = ldf(lds + L_XC + (16 * tt + fr) * S128 + (32 * ks + 8 * fq) * 2); xmf[ks] = ldf(lds + L_XM + (16 * tt + fr + 3) * S128 + (32 * ks + 8 * fq) * 2); }
            f32x4 cq = (f32x4){0.f, 0.f, 0.f, 0.f}, ck = cq, ckt = cq, cv = cq;
#pragma unroll
            for (int ks = 0; ks < 4; ++ks) { cq = MFMA16(aq[ks], xcf[ks], cq); ck = MFMA16(bk[ks], xcf[ks], ck); ckt = MFMA16(xcf[ks], bk[ks], ckt); cv = MFMA16(xmf[ks], bv[ks], cv); }
            { const int t = 16 * tt + fr, e = 16 * w + 4 * fq;
              u32x2 o; o.x = pk2(cq[0] * 0.08838834764831845f, cq[1] * 0.08838834764831845f); o.y = pk2(cq[2] * 0.08838834764831845f, cq[3] * 0.08838834764831845f);
              *(LAS u32x2*)(lds + L_Q + t * S128 + e * 2) = o;
              o.x = pk2(ck[0], ck[1]); o.y = pk2(ck[2], ck[3]); *(LAS u32x2*)(lds + L_K + t * S128 + e * 2) = o; }
            { const int s = 16 * tt + 4 * fq, e = 16 * w + fr;
              const f32x4 wv = *(const LAS f32x4*)(WSC + h * 64 + s);
              u32x2 o; o.x = pk2(ckt[0] * wv.x, ckt[1] * wv.y); o.y = pk2(ckt[2] * wv.z, ckt[3] * wv.w); *(LAS u32x2*)(lds + L_KTW + e * S64 + s * 2) = o;
              o.x = pk2(cv[0], cv[1]); o.y = pk2(cv[2], cv[3]); *(LAS u32x2*)(lds + L_VT + e * S64 + s * 2) = o; }
        }
        __syncthreads();
        { bf16* qg = (bf16*)(ws + WS_QG) + (size_t)(u * 4 + h) * 8192; bf16* kg = (bf16*)(ws + WS_KG) + (size_t)(u * 4 + h) * 8192; bf16* vg = (bf16*)(ws + WS_VG) + (size_t)(u * 4 + h) * 8192;
#pragma unroll
          for (int i = 0; i < 2; ++i) { const int p = tid + 512 * i; { const int row = p >> 4, c16 = p & 15;
              *(u32x4*)(qg + row * 128 + c16 * 8) = *(const LAS u32x4*)(lds + L_Q + row * S128 + c16 * 16); *(u32x4*)(kg + row * 128 + c16 * 8) = *(const LAS u32x4*)(lds + L_K + row * S128 + c16 * 16); }
              { const int row = p >> 3, c8 = p & 7; *(u32x4*)(vg + row * 64 + c8 * 8) = *(const LAS u32x4*)(lds + L_VT + row * S64 + c8 * 16); } } }
        { bf16x8 ak[2];
#pragma unroll
          for (int ks = 0; ks < 2; ++ks) ak[ks] = ldf(lds + L_KTW + (16 * w + fr) * S64 + (32 * ks + 8 * fq) * 2);
          bf16* st = (bf16*)(ws + WS_ST) + (size_t)(u * 4 + h) * 144 * 128;
#pragma unroll
          for (int vt = 0; vt < 9; ++vt) { f32x4 c = (f32x4){0.f, 0.f, 0.f, 0.f};
#pragma unroll
              for (int ks = 0; ks < 2; ++ks) c = MFMA16(ak[ks], ldf(lds + L_VT + (16 * vt + fr) * S64 + (32 * ks + 8 * fq) * 2), c);
              u32x2 o; o.x = pk2(c[0], c[1]); o.y = pk2(c[2], c[3]); *(u32x2*)(st + (size_t)(16 * vt + fr) * 128 + 16 * w + 4 * fq) = o; } }
        __syncthreads();
    }
}

DI bf16x8 cat2(u32x2 a, u32x2 b) { u32x4 o; o.x = a.x; o.y = a.y; o.z = b.x; o.w = b.y; return __builtin_bit_cast(bf16x8, o); }
constexpr int L3_XC = 0, S3_XC = 1040;
constexpr int L3_XM = 66560;
constexpr int L3_VT = 85504, L3_VT2 = 106496;
constexpr int L3_SM = 127232;
#ifndef PROBE_P1
#define PROBE_P1 0
#endif
#ifndef PROBE_ST
#define PROBE_ST 0
#endif
#ifndef PROBE_A
#define PROBE_A 0
#endif
#ifndef PROBE_B
#define PROBE_B 0
#endif
#ifndef PROBE_P2
#define PROBE_P2 0
#endif
DI void mlstm_local3(const Frame& F, const Mix& M, int u) {
    LAS unsigned char* lds = F.lds; const int tid = F.tid, lane = F.lane, w = F.wave, fr = lane & 15, fq = lane >> 4;
    const int t0 = u * CH; const bool first = (u % NCH) == 0; const int bb = u / NCH, cc = u % NCH;
    LAS float* IG = (LAS float*)(lds + L3_SM); LAS float* BBs = IG + 256; LAS float* WSC = IG + 512;
    unsigned char* ws = F.ws;
    { const int b = tid >> 8, i = tid & 255, row = 128 + (i >> 4), c = i & 15; const unsigned v = (row == 128) ? 0x3f803f80u : 0u; LAS unsigned* p = (LAS unsigned*)(lds + (b ? L3_VT2 : L3_VT) + row * S64 + c * 8); p[0] = v; p[1] = v; }
    u32x4 xq[3];
#define L3_LOADX(hh) do { _Pragma("unroll") for (int it = 0; it < 3; ++it) { const int p = tid + 512 * it; xq[it] = (u32x4){0u, 0u, 0u, 0u}; if (p < 67 * 16) { const int row = p >> 4, c16 = p & 15; \
        if (!(first && row < 3)) xq[it] = *(const u32x4*)(M.proj + (size_t)(t0 - 3 + row) * DIN + (hh) * 128 + c16 * 8); } } } while (0)
#define L3_STOREX() do { _Pragma("unroll") for (int it = 0; it < 3; ++it) { const int p = tid + 512 * it; if (p < 67 * 16) { const int row = p >> 4, c16 = p & 15; *(LAS u32x4*)(lds + L3_XM + row * S128 + c16 * 16) = xq[it]; } } } while (0)
    f32x4 accg[4];
#pragma unroll 1
    for (int rp1 = 0; rp1 < 1 + PROBE_P1; ++rp1) {
    L3_LOADX(0);
#pragma unroll
    for (int tt = 0; tt < 4; ++tt) accg[tt] = (f32x4){0.f, 0.f, 0.f, 0.f};
#pragma unroll 1
    for (int h = 0; h < 4; ++h) {
        L3_STOREX();
        const int cg = tid & 15, ch = h * 128 + cg * 8;
        float cw[4][8], cb[8];
#pragma unroll
        for (int j = 0; j < 4; ++j) { const f32x4 a = *(const f32x4*)(M.convw + j * 512 + ch), b = *(const f32x4*)(M.convw + j * 512 + ch + 4);
            cw[j][0] = a.x; cw[j][1] = a.y; cw[j][2] = a.z; cw[j][3] = a.w; cw[j][4] = b.x; cw[j][5] = b.y; cw[j][6] = b.z; cw[j][7] = b.w; }
        { const f32x4 a = *(const f32x4*)(M.convb + ch), b = *(const f32x4*)(M.convb + ch + 4); cb[0] = a.x; cb[1] = a.y; cb[2] = a.z; cb[3] = a.w; cb[4] = b.x; cb[5] = b.y; cb[6] = b.z; cb[7] = b.w; }
        __syncthreads();
        if (h < 3) L3_LOADX(h + 1);
        bf16* xcg = (bf16*)(ws + WS_XCG) + ((size_t)u * 4 + h) * 8192;
#pragma unroll 1
        for (int it = 0; it < 2; ++it) { const int t = (tid >> 4) + 32 * it; float y[8];
#pragma unroll
            for (int c = 0; c < 8; ++c) y[c] = cb[c];
#pragma unroll
            for (int j = 0; j < 4; ++j) { const u32x4 x = *(const LAS u32x4*)(lds + L3_XM + (t + j) * S128 + cg * 16);
                y[0] += cw[j][0] * bflo(x.x); y[1] += cw[j][1] * bfhi(x.x); y[2] += cw[j][2] * bflo(x.y); y[3] += cw[j][3] * bfhi(x.y);
                y[4] += cw[j][4] * bflo(x.z); y[5] += cw[j][5] * bfhi(x.z); y[6] += cw[j][6] * bflo(x.w); y[7] += cw[j][7] * bfhi(x.w); }
            u32x4 o; o.x = pk2(siluf(y[0]), siluf(y[1])); o.y = pk2(siluf(y[2]), siluf(y[3])); o.z = pk2(siluf(y[4]), siluf(y[5])); o.w = pk2(siluf(y[6]), siluf(y[7]));
            *(LAS u32x4*)(lds + L3_XC + t * S3_XC + (h * 128 + cg * 8) * 2) = o;
            *(u32x4*)(xcg + (size_t)t * 128 + cg * 8) = o; }
        const int cbase = (w < 4) ? (h * 128 + 32 * w) : (512 + h * 128 + 32 * (w - 4));
        const bf16x8 ag = *(const bf16x8*)(M.wg + (size_t)fr * 1024 + cbase + 8 * fq);
        __syncthreads();
#pragma unroll
        for (int tt = 0; tt < 4; ++tt) { const int t = 16 * tt + fr;
            const bf16x8 b = (w < 4) ? ldf(lds + L3_XC + t * S3_XC + (h * 128 + 32 * w + 8 * fq) * 2) : ldf(lds + L3_XM + (t + 3) * S128 + (32 * (w - 4) + 8 * fq) * 2);
            accg[tt] = MFMA16(ag, b, accg[tt]); }
        __syncthreads();
    }
    }
    if (fq < 2) {
#pragma unroll
        for (int tt = 0; tt < 4; ++tt)
#pragma unroll
            for (int r = 0; r < 4; ++r) *(LAS float*)(lds + L3_VT2 + ((w * 8 + 4 * fq + r) * 64 + 16 * tt + fr) * 4) = accg[tt][r];
    }
    __syncthreads();
    { float pre = M.bif[w];
#pragma unroll
      for (int ww = 0; ww < 8; ++ww) pre += *(const LAS float*)(lds + L3_VT2 + ((ww * 8 + w) * 64 + lane) * 4);
      if (w < 4) IG[w * 64 + lane] = pre;
      else { float lf = fminf(pre, 0.f) - softplus_neg(fabsf(pre));
#pragma unroll
          for (int o = 1; o < 64; o <<= 1) { const float v = __shfl_up(lf, o); if (lane >= o) lf += v; }
          BBs[(w - 4) * 64 + lane] = lf; } }
    __syncthreads();
    if (w < 4) { const float bt = BBs[w * 64 + lane], g = IG[w * 64 + lane] - bt, gmax = wave_max(g), bend = BBs[w * 64 + 63];
        WSC[w * 64 + lane] = fexp(g - gmax);
        float* gb = (float*)(ws + WS_GB) + (size_t)(u * 4 + w) * 128; gb[lane] = bt; gb[64 + lane] = g;
        if (lane == 0) { float* sc = (float*)(ws + WS_SC) + ((size_t)(bb * 4 + w) * NCH + cc) * 2; sc[0] = bend; sc[1] = bend + gmax; } }
    __syncthreads();
    bf16x8 aq[4], bk[4], bv[4], nq[4], nk[4], nv[4];
#define L3_LOADW(hh, Q_, K_, V_) do { _Pragma("unroll") for (int ks = 0; ks < 4; ++ks) { const size_t o_ = ((size_t)(M.l * 4 + (hh)) * 128 + 16 * w + fr) * 128 + 32 * ks + 8 * fq; \
        Q_[ks] = *(const bf16x8*)(M.wq + o_); K_[ks] = *(const bf16x8*)(M.wk + o_); V_[ks] = *(const bf16x8*)(M.wv + o_); } } while (0)
    L3_LOADW(0, aq, bk, bv);
    L3_LOADX(0);
#pragma unroll 1
    for (int h = 0; h < 4; ++h) {
        L3_STOREX(); __syncthreads();
        const size_t uh = (size_t)u * 4 + h;
        LAS unsigned char* VT = lds + ((h & 1) ? L3_VT2 : L3_VT);
        bf16* qg = (bf16*)(ws + WS_QG) + uh * 8192; bf16* kg = (bf16*)(ws + WS_KG) + uh * 8192; bf16* vg = (bf16*)(ws + WS_VG) + uh * 8192; bf16* st = (bf16*)(ws + WS_ST) + uh * 144 * 128;
        u32x2 KP[4], QO[4], KO[4], VO[4];
#pragma unroll 1
        for (int _pa = 0; _pa < 1 + PROBE_A; ++_pa) {
#pragma unroll
        for (int tt = 0; tt < 4; ++tt) {
            bf16x8 xcf[4], xmf[4];
#pragma unroll
            for (int ks = 0; ks < 4; ++ks) { xcf[ks] = ldf(lds + L3_XC + (16 * tt + fr) * S3_XC + (h * 128 + 32 * ks + 8 * fq) * 2); xmf[ks] = ldf(lds + L3_XM + (16 * tt + fr + 3) * S128 + (32 * ks + 8 * fq) * 2); }
            f32x4 cq = (f32x4){0.f, 0.f, 0.f, 0.f}, ck = cq, ckt = cq, cv = cq;
#pragma unroll
            for (int ks = 0; ks < 4; ++ks) { cq = MFMA16(aq[ks], xcf[ks], cq); ck = MFMA16(bk[ks], xcf[ks], ck); ckt = MFMA16(xcf[ks], bk[ks], ckt); cv = MFMA16(xmf[ks], bv[ks], cv); }
            QO[tt].x = pk2(cq[0] * 0.08838834764831845f, cq[1] * 0.08838834764831845f); QO[tt].y = pk2(cq[2] * 0.08838834764831845f, cq[3] * 0.08838834764831845f);
            KO[tt].x = pk2(ck[0], ck[1]); KO[tt].y = pk2(ck[2], ck[3]);
            { const int s = 16 * tt + 4 * fq, e = 16 * w + fr;
              const f32x4 wv = *(const LAS f32x4*)(WSC + h * 64 + s);
              KP[tt].x = pk2(ckt[0] * wv.x, ckt[1] * wv.y); KP[tt].y = pk2(ckt[2] * wv.z, ckt[3] * wv.w);
              VO[tt].x = pk2(cv[0], cv[1]); VO[tt].y = pk2(cv[2], cv[3]); *(LAS u32x2*)(VT + e * S64 + s * 2) = VO[tt]; }
        }
        }
        if (h < 3) { L3_LOADX(h + 1); L3_LOADW(h + 1, nq, nk, nv); }
#pragma unroll
        for (int tt = 0; tt < 4; ++tt) { const size_t off = (size_t)((tt * 8 + w) * 256 + fr * 16 + 4 * fq);
            for (int _r = 0; _r < 1 + PROBE_ST; ++_r) { *(u32x2*)(qg + off) = QO[tt]; *(u32x2*)(kg + off) = KO[tt]; *(u32x2*)(vg + (size_t)((w * 4 + tt) * 256 + fr * 16 + 4 * fq)) = VO[tt]; asm volatile("" ::: "memory"); } }
        __syncthreads();
#pragma unroll 1
        for (int _pb = 0; _pb < 1 + PROBE_B; ++_pb)
        { const bf16x8 ak0 = cat2(KP[0], KP[1]), ak1 = cat2(KP[2], KP[3]);
#pragma unroll
          for (int vt = 0; vt < 9; ++vt) { const LAS unsigned char* vr = VT + (16 * vt + fr) * S64 + 8 * fq;
              const u32x2 v0 = *(const LAS u32x2*)(vr), v1 = *(const LAS u32x2*)(vr + 32), v2 = *(const LAS u32x2*)(vr + 64), v3 = *(const LAS u32x2*)(vr + 96);
              f32x4 c = (f32x4){0.f, 0.f, 0.f, 0.f}; c = MFMA16(ak0, cat2(v0, v1), c); c = MFMA16(ak1, cat2(v2, v3), c);
              u32x2 o; o.x = pk2(c[0], c[1]); o.y = pk2(c[2], c[3]); for (int _r = 0; _r < 1 + PROBE_ST; ++_r) { *(u32x2*)(st + (size_t)((vt * 8 + w) * 256 + fr * 16 + 4 * fq)) = o; asm volatile("" ::: "memory"); } } }
#pragma unroll
        for (int ks = 0; ks < 4; ++ks) { aq[ks] = nq[ks]; bk[ks] = nk[ks]; bv[ks] = nv[ks]; }
    }
    __syncthreads();
#undef L3_LOADW
#undef L3_LOADX
#undef L3_STOREX
}

constexpr int L_VNT = 0;
constexpr int L_MU = 36864;
DI void gmlp_unit(const Frame& F, const Mix& M, int ub) {
    LAS unsigned char* lds = F.lds; const int tid = F.tid, lane = F.lane, w = F.wave, fr = lane & 15, fq = lane >> 4;
    const int t0 = ub * 128;
    LAS float* MU = (LAS float*)(lds + L_MU); LAS float* RS = MU + 128; LAS float* GOL = MU + 256; LAS float* GVL = MU + 768;
    GOL[tid] = M.gmog[tid]; GVL[tid] = M.gmvg[tid];
    if (tid < 128) { const f32x4* p = (const f32x4*)((const float*)(F.ws + WS_VST) + (size_t)(t0 + tid) * 16); const f32x4 a = p[0], b = p[1], c = p[2], d = p[3];
        const float s1 = (a.x + a.z) + (b.x + b.z) + (c.x + c.z) + (d.x + d.z), s2 = (a.y + a.w) + (b.y + b.w) + (c.y + c.w) + (d.y + d.w);
        const float mu = s1 * (1.0f / 512.0f), var = fmaxf(s2 * (1.0f / 512.0f) - mu * mu, 0.f); MU[tid] = mu; RS[tid] = 1.0f / sqrtf(var + EPS); }
    float ss = 0.f;
    const int i_tok = 16 * w + fr;
    bf16* py = (bf16*)(F.ws + WS_Y) + (size_t)(t0 + i_tok) * D + 512 + 8 * fq;
    const int j = tid & 127, cq = tid >> 7;
    u32x4 xv[4]; bf16x8 bwn[4]; u32x4 ugn[4]; float biasn;
#define GM_ISSUE(g) do { const bf16* pv_ = M.proj + (size_t)(t0 + j) * DIN + 1536 + (g) * 128 + 32 * cq; _Pragma("unroll") for (int i = 0; i < 4; ++i) xv[i] = *(const u32x4*)(pv_ + 8 * i); \
        const bf16* pw_ = M.wsp + ((size_t)(M.l * 4 + (g)) * 128 + i_tok) * 128 + 8 * fq; _Pragma("unroll") for (int ks = 0; ks < 4; ++ks) bwn[ks] = *(const bf16x8*)(pw_ + 32 * ks); \
        biasn = M.bsp[(g) * 128 + i_tok]; const bf16* pu_ = M.proj + (size_t)(t0 + i_tok) * DIN + 1024 + (g) * 128 + 8 * fq; _Pragma("unroll") for (int p = 0; p < 4; ++p) ugn[p] = *(const u32x4*)(pu_ + 32 * p); } while (0)
    GM_ISSUE(0);
    __syncthreads();
#pragma unroll 1
    for (int g = 0; g < 4; ++g) {
        { const float mu = MU[j], rs = RS[j];
#pragma unroll
          for (int i = 0; i < 4; ++i) { const int c0 = 32 * cq + 8 * i; const u32x4 x = xv[i];
              const f32x4 ga = *(const LAS f32x4*)(GVL + g * 128 + c0), gb = *(const LAS f32x4*)(GVL + g * 128 + c0 + 4);
              const float v[8] = {(bflo(x.x) - mu) * rs * ga.x, (bfhi(x.x) - mu) * rs * ga.y, (bflo(x.y) - mu) * rs * ga.z, (bfhi(x.y) - mu) * rs * ga.w,
                                  (bflo(x.z) - mu) * rs * gb.x, (bfhi(x.z) - mu) * rs * gb.y, (bflo(x.w) - mu) * rs * gb.z, (bfhi(x.w) - mu) * rs * gb.w};
#pragma unroll
              for (int c = 0; c < 8; ++c) *(LAS bf16*)(lds + L_VNT + (32 * cq + 16 * (c >> 2) + 4 * i + (c & 3)) * S128 + j * 2) = (bf16)f2bf(v[c]); } }
        bf16x8 bw[4]; u32x4 ugv[4]; const float bias = biasn;
#pragma unroll
        for (int ks = 0; ks < 4; ++ks) bw[ks] = bwn[ks];
#pragma unroll
        for (int p = 0; p < 4; ++p) ugv[p] = ugn[p];
        __syncthreads();
        if (g < 3) GM_ISSUE(g + 1);
#pragma unroll
        for (int p = 0; p < 4; ++p) { f32x4 ce = (f32x4){0.f, 0.f, 0.f, 0.f}, co = ce;
#pragma unroll
            for (int ks = 0; ks < 4; ++ks) { ce = MFMA16(ldf(lds + L_VNT + (32 * p + fr) * S128 + (32 * ks + 8 * fq) * 2), bw[ks], ce); co = MFMA16(ldf(lds + L_VNT + (32 * p + 16 + fr) * S128 + (32 * ks + 8 * fq) * 2), bw[ks], co); }
            const u32x4 ug = ugv[p];
            u32x4 o; o.x = pk2(bflo(ug.x) * (ce[0] + bias), bfhi(ug.x) * (ce[1] + bias)); o.y = pk2(bflo(ug.y) * (ce[2] + bias), bfhi(ug.y) * (ce[3] + bias));
            o.z = pk2(bflo(ug.z) * (co[0] + bias), bfhi(ug.z) * (co[1] + bias)); o.w = pk2(bflo(ug.w) * (co[2] + bias), bfhi(ug.w) * (co[3] + bias));
#pragma unroll
            for (int q = 0; q < 4; ++q) { const float z0 = bflo(o[q]), z1 = bfhi(o[q]); ss += z0 * z0 + z1 * z1; }
            *(u32x4*)(py + g * 128 + 32 * p) = o; }
        __syncthreads();
    }
#undef GM_ISSUE
    ss += __shfl_xor(ss, 16); ss += __shfl_xor(ss, 32);
    const float r = 1.0f / sqrtf(ss * (1.0f / 512.0f) + EPS);
    VM_WAIT();
    u32x4 yv[4][4];
#pragma unroll
    for (int g = 0; g < 4; ++g)
#pragma unroll
        for (int p = 0; p < 4; ++p) yv[g][p] = *(const u32x4*)(py + g * 128 + 32 * p);
#pragma unroll
    for (int g = 0; g < 4; ++g)
#pragma unroll
        for (int p = 0; p < 4; ++p) { const f32x4 g0 = *(const LAS f32x4*)(GOL + g * 128 + 32 * p + 8 * fq), g1 = *(const LAS f32x4*)(GOL + g * 128 + 32 * p + 8 * fq + 4); const u32x4 x = yv[g][p];
            u32x4 o; o.x = pk2(bflo(x.x) * r * g0.x, bfhi(x.x) * r * g0.y); o.y = pk2(bflo(x.y) * r * g0.z, bfhi(x.y) * r * g0.w); o.z = pk2(bflo(x.z) * r * g1.x, bfhi(x.z) * r * g1.y); o.w = pk2(bflo(x.w) * r * g1.z, bfhi(x.w) * r * g1.w);
            *(u32x4*)(py + g * 128 + 32 * p) = o; }
}

DI void mlstm_scan(const Frame& F) {
    unsigned char* ws = F.ws;
    const int gt = (F.vcu * 8 + F.wave) * 64 + F.lane, NGT = F.G * 512;
    constexpr int PER_BH = 128 * 64;
    for (int it = gt; it < 16 * PER_BH; it += NGT) {
        const int bh = it / PER_BH, rem = it % PER_BH, b = bh >> 2, h = bh & 3;
        const bool extra = rem < 64;
        const int XOFF = (64 + (rem >> 3)) * 128 + (rem & 7) - rem;
        const float* sc = (const float*)(ws + WS_SC) + (size_t)bh * NCH * 2;
        unsigned* st = (unsigned*)((bf16*)(ws + WS_ST) + ((size_t)(b * NCH) * 4 + h) * 144 * 128) + rem;
        float* mp = (float*)(ws + WS_MP);
        float c0 = 0.f, c1 = 0.f, n0 = 0.f, n1 = 0.f, m = 0.f;
        unsigned x[16], y[16], xn[16], yn[16];
#pragma unroll
        for (int j = 0; j < 16; ++j) { x[j] = st[(size_t)j * 36864]; y[j] = extra ? st[(size_t)j * 36864 + XOFF] : 0u; }
#pragma unroll 1
        for (int cb = 0; cb < NCH; cb += 16) {
            const int nb = (cb + 16 < NCH) ? cb + 16 : cb;
#pragma unroll
            for (int j = 0; j < 16; ++j) { xn[j] = st[(size_t)(nb + j) * 36864]; yn[j] = extra ? st[(size_t)(nb + j) * 36864 + XOFF] : 0u; }
#pragma unroll
            for (int j = 0; j < 16; ++j) { const int c = cb + j; const float bend = sc[2 * c], mloc = sc[2 * c + 1];
                const float mn = fmaxf(bend + m, mloc), a = fexp(bend + m - mn), s = fexp(mloc - mn);
                const unsigned oc = pk2(c0, c1), on = pk2(n0, n1); const float om = m;
                c0 = a * c0 + s * bflo(x[j]); c1 = a * c1 + s * bfhi(x[j]); n0 = a * n0 + s * bflo(y[j]); n1 = a * n1 + s * bfhi(y[j]); m = mn;
                x[j] = oc; y[j] = on; if (rem == 0) mp[(size_t)(b * NCH + c) * 4 + h] = om; }
#pragma unroll
            for (int j = 0; j < 16; ++j) { st[(size_t)(cb + j) * 36864] = x[j]; if (extra) st[(size_t)(cb + j) * 36864 + XOFF] = y[j]; }
#pragma unroll
            for (int j = 0; j < 16; ++j) { x[j] = xn[j]; y[j] = yn[j]; }
        }
    }
}

constexpr int L_CP = 70656;
constexpr int L_VT_D = 109824, L_P = 0, L_SD = 9216, L_HM = L_Q;
constexpr int L_PAR = 12288;
DI void mlstm_out_stage_params(const Frame& F, const Mix& M) { LAS float* P = (LAS float*)(F.lds + L_PAR); P[F.tid] = M.mhg[F.tid]; P[512 + F.tid] = M.skip[F.tid]; }
struct OutLoads { u32x4 q[2], k[2], v[2], c[5], xc[2]; u32x2 og[4]; float bt, g, mprev; };
DI void mlstm_out_issue(const Frame& F, const Mix& M, int u, int h, OutLoads& R) {
    const int tid = F.tid, lane = F.lane, w = F.wave, fr = lane & 15, fq = lane >> 4; unsigned char* ws = F.ws;
    const size_t uh = (size_t)u * 4 + h; const int t0 = u * CH;
    const bf16* qg = (const bf16*)(ws + WS_QG) + uh * 8192; const bf16* kg = (const bf16*)(ws + WS_KG) + uh * 8192; const bf16* vg = (const bf16*)(ws + WS_VG) + uh * 8192;
    const bf16* cp = (const bf16*)(ws + WS_ST) + uh * 144 * 128;
#pragma unroll
    for (int i = 0; i < 2; ++i) { const int p = tid + 512 * i; R.q[i] = *(const u32x4*)(qg + p * 8); R.k[i] = *(const u32x4*)(kg + p * 8); R.v[i] = *(const u32x4*)(vg + p * 8); }
#pragma unroll
    for (int i = 0; i < 5; ++i) { const int p = tid + 512 * i; R.c[i] = (u32x4){0u, 0u, 0u, 0u}; if (p < 72 * 32) R.c[i] = *(const u32x4*)(cp + p * 8); }
    { const int tt = w & 3, vh = w >> 2, t = 16 * tt + fr; const bf16* og = M.proj + (size_t)(t0 + t) * DIN + 512 + h * 128 + 64 * vh + 4 * fq;
#pragma unroll
      for (int j = 0; j < 4; ++j) R.og[j] = *(const u32x2*)(og + 16 * j); }
    { const int t = tid >> 3, v0 = 16 * (tid & 7); const bf16* xcp = (const bf16*)(ws + WS_XCG) + uh * 8192 + (size_t)t * 128 + v0; R.xc[0] = *(const u32x4*)(xcp); R.xc[1] = *(const u32x4*)(xcp + 8); }
    R.bt = 0.f; R.g = 0.f; R.mprev = 0.f;
    if (w == 0) { const float* gb = (const float*)(ws + WS_GB) + uh * 128; R.bt = gb[lane]; R.g = gb[64 + lane]; R.mprev = ((const float*)(ws + WS_MP))[uh]; }
}
DI void mlstm_out_item(const Frame& F, const Mix& M, int u, int h, const OutLoads& R, bool has_next, int un, int hn, OutLoads& RN) {
    LAS unsigned char* lds = F.lds; const int tid = F.tid, lane = F.lane, w = F.wave, fr = lane & 15, fq = lane >> 4;
    const int t0 = u * CH;
    LAS float* AT = (LAS float*)(lds + L_SD); LAS float* DF = AT + 64; LAS float* EG = AT + 128; LAS float* MT = AT + 448;
    const LAS float* PAR = (const LAS float*)(lds + L_PAR);
    bf16* Y = (bf16*)(F.ws + WS_Y);
#pragma unroll
    for (int i = 0; i < 2; ++i) { const int p = tid + 512 * i, tile = p >> 5, rem = p & 31;
        { const int row = 16 * (tile >> 3) + (rem >> 1), col = 16 * (tile & 7) + 8 * (rem & 1);
          *(LAS u32x4*)(lds + L_Q + row * S128 + col * 2) = R.q[i]; *(LAS u32x4*)(lds + L_K + row * S128 + col * 2) = R.k[i]; }
        { const int row = 16 * (tile >> 2) + (rem >> 1), col = 16 * (tile & 3) + 8 * (rem & 1);
          *(LAS u32x4*)(lds + L_VT_D + row * S64 + col * 2) = R.v[i]; } }
#pragma unroll
    for (int i = 0; i < 5; ++i) { const int p = tid + 512 * i; if (p < 72 * 32) { const int tile = p >> 5, rem = p & 31, row = 16 * (tile >> 3) + (rem >> 1), col = 16 * (tile & 7) + 8 * (rem & 1);
        *(LAS u32x4*)(lds + L_CP + row * S128 + col * 2) = R.c[i]; } }
    if (tid < 16 * 8) { const int row = 128 + (tid >> 3), c = tid & 7; const unsigned v = (row == 128) ? 0x3f803f80u : 0u; LAS unsigned* p = (LAS unsigned*)(lds + L_VT_D + row * S64 + c * 16); p[0] = v; p[1] = v; p[2] = v; p[3] = v; }
    if (w == 0) { float cm = R.g;
#pragma unroll
        for (int o = 1; o < 64; o <<= 1) { const float v = __shfl_up(cm, o); if (lane >= o) cm = fmaxf(cm, v); }
        const float Mt = fmaxf(R.mprev, cm);
        MT[lane] = Mt; AT[lane] = fexp(R.mprev - Mt); DF[lane] = fexp(-(R.bt + Mt)); EG[lane] = R.g; }
    u32x2 og[4]; u32x4 xc[2];
#pragma unroll
    for (int j = 0; j < 4; ++j) og[j] = R.og[j];
    xc[0] = R.xc[0]; xc[1] = R.xc[1];
    __syncthreads();
    if (has_next) mlstm_out_issue(F, M, un, hn, RN);
    { const int tt = w & 3, t = 16 * tt + fr; const float Mt = MT[t];
      bf16x8 bq[4];
#pragma unroll
      for (int ks = 0; ks < 4; ++ks) bq[ks] = ldf(lds + L_Q + t * S128 + (32 * ks + 8 * fq) * 2);
#pragma unroll
      for (int j = 0; j < 2; ++j) { const int st = 2 * (w >> 2) + j; f32x4 c = (f32x4){0.f, 0.f, 0.f, 0.f};
          if (st <= tt) {
#pragma unroll
              for (int ks = 0; ks < 4; ++ks) c = MFMA16(ldf(lds + L_K + (16 * st + fr) * S128 + (32 * ks + 8 * fq) * 2), bq[ks], c); }
          const int s0 = 16 * st + 4 * fq; const f32x4 gs = *(const LAS f32x4*)(EG + s0);
          float p[4];
#pragma unroll
          for (int r = 0; r < 4; ++r) p[r] = (s0 + r <= t) ? c[r] * fexp(gs[r] - Mt) : 0.f;
          u32x2 o; o.x = pk2(p[0], p[1]); o.y = pk2(p[2], p[3]); *(LAS u32x2*)(lds + L_P + t * S64 + s0 * 2) = o; } }
    __syncthreads();
    { const int tt = w & 3, vh = w >> 2, t = 16 * tt + fr;
      bf16x8 bp[2], bq[4];
#pragma unroll
      for (int ks = 0; ks < 2; ++ks) bp[ks] = ldf(lds + L_P + t * S64 + (32 * ks + 8 * fq) * 2);
#pragma unroll
      for (int ks = 0; ks < 4; ++ks) bq[ks] = ldf(lds + L_Q + t * S128 + (32 * ks + 8 * fq) * 2);
      f32x4 ci[5], cx[5];
#pragma unroll
      for (int j = 0; j < 5; ++j) { const int vt = (j < 4) ? 4 * vh + j : 8; ci[j] = (f32x4){0.f, 0.f, 0.f, 0.f}; cx[j] = ci[j];
#pragma unroll
          for (int ks = 0; ks < 2; ++ks) ci[j] = MFMA16(ldf(lds + L_VT_D + (16 * vt + fr) * S64 + (32 * ks + 8 * fq) * 2), bp[ks], ci[j]);
#pragma unroll
          for (int ks = 0; ks < 4; ++ks) cx[j] = MFMA16(ldf(lds + L_CP + (16 * vt + fr) * S128 + (32 * ks + 8 * fq) * 2), bq[ks], cx[j]); }
      const float at = AT[t];
      float den = ci[4][0] + at * cx[4][0];
      den = __shfl(den, fr);
      den = fmaxf(fabsf(den), DF[t]);
      const float rden = 1.0f / den;
      __syncthreads();
#pragma unroll
      for (int j = 0; j < 4; ++j) { const float o[4] = {bflo(og[j].x), bfhi(og[j].x), bflo(og[j].y), bfhi(og[j].y)}; f32x4 x;
#pragma unroll
          for (int r = 0; r < 4; ++r) x[r] = o[r] * (ci[j][r] + at * cx[j][r]) * rden;
          *(LAS f32x4*)(lds + L_HM + (t * 132 + 64 * vh + 16 * j + 4 * fq) * 4) = x; } }
    __syncthreads();
    { const int t = tid >> 3, part = tid & 7, v0 = 16 * part;
      float s1 = 0.f, s2 = 0.f;
#pragma unroll
      for (int i = 0; i < 4; ++i) { const f32x4 x = *(const LAS f32x4*)(lds + L_HM + (t * 132 + v0 + 4 * i) * 4); s1 += (x.x + x.y) + (x.z + x.w); s2 += (x.x * x.x + x.y * x.y) + (x.z * x.z + x.w * x.w); }
      s1 += __shfl_xor(s1, 1); s1 += __shfl_xor(s1, 2); s1 += __shfl_xor(s1, 4); s2 += __shfl_xor(s2, 1); s2 += __shfl_xor(s2, 2); s2 += __shfl_xor(s2, 4);
      const float mu = s1 * (1.0f / 128.0f), var = fmaxf(s2 * (1.0f / 128.0f) - mu * mu, 0.f), rstd = __builtin_amdgcn_rsqf(var + EPS);
#pragma unroll
      for (int half = 0; half < 2; ++half) { const int c0 = h * 128 + v0 + 8 * half; const u32x4 xcv = xc[half];
          const f32x4 xa = *(const LAS f32x4*)(lds + L_HM + (t * 132 + v0 + 8 * half) * 4), xb = *(const LAS f32x4*)(lds + L_HM + (t * 132 + v0 + 8 * half + 4) * 4);
          const f32x4 ga = *(const LAS f32x4*)(PAR + c0), gb = *(const LAS f32x4*)(PAR + c0 + 4), sa = *(const LAS f32x4*)(PAR + 512 + c0), sb = *(const LAS f32x4*)(PAR + 512 + c0 + 4);
          u32x4 o; o.x = pk2((xa.x - mu) * rstd * ga.x + sa.x * bflo(xcv.x), (xa.y - mu) * rstd * ga.y + sa.y * bfhi(xcv.x));
          o.y = pk2((xa.z - mu) * rstd * ga.z + sa.z * bflo(xcv.y), (xa.w - mu) * rstd * ga.w + sa.w * bfhi(xcv.y));
          o.z = pk2((xb.x - mu) * rstd * gb.x + sb.x * bflo(xcv.z), (xb.y - mu) * rstd * gb.y + sb.y * bfhi(xcv.z));
          o.w = pk2((xb.z - mu) * rstd * gb.z + sb.z * bflo(xcv.w), (xb.w - mu) * rstd * gb.w + sb.w * bfhi(xcv.w));
          *(u32x4*)(Y + (size_t)(t0 + t) * D + c0) = o; } }
    __syncthreads();
}
DI void mlstm_out_phase(const Frame& F, const Mix& M) {
    mlstm_out_stage_params(F, M);
    int u = F.vcu, h = 0;
    if (u >= NU) return;
    OutLoads R, RN;
    mlstm_out_issue(F, M, u, h, R);
#pragma unroll 1
    for (;;) {
        int un = u, hn = h + 1; if (hn == 4) { hn = 0; un = u + F.G; } const bool hn_ok = un < NU;
        mlstm_out_item(F, M, u, h, R, hn_ok, un, hn, RN);
        if (!hn_ok) break;
        u = un; h = hn; R = RN;
    }
}

DI void route_tokens(const Frame& F, const Args& a) {
    LAS unsigned char* lds = F.lds; const int tid = F.tid, lane = F.lane, w = F.wave, ti = lane & 15, kq = lane >> 4;
    unsigned char* ws = F.ws;
    constexpr int WP = 2048 + 64;
    LAS unsigned char* WH = lds; LAS unsigned char* WL = lds + 8 * WP;
    LAS int* CNTL = (LAS int*)(lds + 16 * WP);
    const bf16* xb = (const bf16*)(ws + WS_XB);
    for (int i = tid; i < 8 * 1024; i += 512) { const int e = i >> 10, c = i & 1023; const float wv = a.in[I_ROUTER][c * 8 + e] * a.in[I_FFNG][D + c];
        const unsigned hi = f2bf(wv), lo = f2bf(wv - __builtin_bit_cast(float, hi << 16));
        *(LAS bf16*)(WH + e * WP + c * 2) = (bf16)hi; *(LAS bf16*)(WL + e * WP + c * 2) = (bf16)lo; }
    if (tid < 16) CNTL[tid] = 0;
    __syncthreads();
    const int TPW = (T + F.G - 1) / F.G, tb = F.vcu * TPW, te = (tb + TPW < T) ? tb + TPW : T;
#pragma unroll 1
    for (int t0 = tb + 16 * w; t0 < te; t0 += 128) {
        const int t = t0 + ti; const bool ok = t < te;
        u32x4 x[16][2];
#pragma unroll
        for (int u = 0; u < 16; ++u)
#pragma unroll
            for (int h = 0; h < 2; ++h) { x[u][h] = (u32x4){0u, 0u, 0u, 0u}; if (ok) x[u][h] = *(const u32x4*)(xb + (size_t)t * D + 64 * u + 16 * kq + 8 * h); }
        f32x4 acc = (f32x4){0.f, 0.f, 0.f, 0.f}; float ss = 0.f;
        const LAS unsigned char* wh = WH + (ti & 7) * WP + 32 * kq; const LAS unsigned char* wl = WL + (ti & 7) * WP + 32 * kq;
#pragma unroll
        for (int u = 0; u < 16; ++u)
#pragma unroll
            for (int h = 0; h < 2; ++h) { const bf16x8 xa = __builtin_bit_cast(bf16x8, x[u][h]);
                acc = MFMA16(ldf(wh + 128 * u + 16 * h), xa, acc); acc = MFMA16(ldf(wl + 128 * u + 16 * h), xa, acc);
#pragma unroll
                for (int c = 0; c < 4; ++c) { const float p = bflo(x[u][h][c]), q = bfhi(x[u][h][c]); ss += p * p + q * q; }
                __builtin_amdgcn_sched_barrier(0); }
        ss += __shfl_xor(ss, 16); ss += __shfl_xor(ss, 32);
        const float r = 1.0f / sqrtf(ss * (1.0f / D) + EPS);
        float lg[8];
#pragma unroll
        for (int i = 0; i < 4; ++i) { const float o = __shfl_xor(acc[i], 16); lg[i] = ((kq & 1) ? o : acc[i]) * r; lg[4 + i] = ((kq & 1) ? acc[i] : o) * r; }
        int i0 = 0; float l0 = lg[0];
#pragma unroll
        for (int e = 1; e < 8; ++e) if (lg[e] > l0) { l0 = lg[e]; i0 = e; }
        int i1 = -1; float l1 = -3.0e38f;
#pragma unroll
        for (int e = 0; e < 8; ++e) if (e != i0 && lg[e] > l1) { l1 = lg[e]; i1 = e; }
        if (i1 < 0) { i1 = i0 == 0 ? 1 : 0; l1 = lg[i0 == 0 ? 1 : 0]; }
        const float g0 = 1.0f / (1.0f + expf(l1 - l0));
        if (ok && kq == 0) { ((int*)(ws + WS_TOPI))[t * 2] = i0; ((int*)(ws + WS_TOPI))[t * 2 + 1] = i1; ((float*)(ws + WS_TOPG))[t * 2] = g0; ((float*)(ws + WS_TOPG))[t * 2 + 1] = 1.0f - g0;
            atomicAdd((int*)&CNTL[i0], 1); atomicAdd((int*)&CNTL[8 + i1], 1); }
        if (ok) {
            unsigned char* o8 = ws + WS_XR8 + (size_t)t * D + 16 * kq;
#pragma unroll
            for (int u = 0; u < 16; ++u) { u32x4 o;
#pragma unroll
                for (int h = 0; h < 2; ++h) { u32x4 xv = x[u][h]; asm volatile("" : "+v"(xv.x), "+v"(xv.y), "+v"(xv.z), "+v"(xv.w));
                    int w0 = __builtin_amdgcn_cvt_pk_fp8_f32(bflo(xv.x) * r, bfhi(xv.x) * r, 0, false); w0 = __builtin_amdgcn_cvt_pk_fp8_f32(bflo(xv.y) * r, bfhi(xv.y) * r, w0, true);
                    int w1 = __builtin_amdgcn_cvt_pk_fp8_f32(bflo(xv.z) * r, bfhi(xv.z) * r, 0, false); w1 = __builtin_amdgcn_cvt_pk_fp8_f32(bflo(xv.w) * r, bfhi(xv.w) * r, w1, true);
                    o[2 * h] = (unsigned)w0; o[2 * h + 1] = (unsigned)w1; }
                *(u32x4*)(o8 + 64 * u) = o; } }
    }
    __syncthreads();
    if (tid < 16) ((int*)(ws + WS_CNT))[F.vcu * 16 + tid] = CNTL[tid];
}
DI void route_scatter(const Frame& F) {
    LAS unsigned char* lds = F.lds; const int tid = F.tid;
    unsigned char* ws = F.ws;
    LAS int* TOT = (LAS int*)lds; LAS int* BASE = TOT + 16; LAS int* SEG = TOT + 32; LAS int* NTK = TOT + 48; LAS int* EL = TOT + 64;
    const int* cnt = (const int*)(ws + WS_CNT);
    { LAS int* PT = TOT + 64 + 1024; LAS int* PB = PT + 512;
      const int k = tid & 15, q = tid >> 4, per = (F.G + 31) / 32; int tot = 0, base = 0;
      for (int i = 0; i < per; ++i) { const int g = q * per + i; if (g < F.G) { const int c = cnt[g * 16 + k]; tot += c; if (g < F.vcu) base += c; } }
      PT[q * 16 + k] = tot; PB[q * 16 + k] = base; }
    __syncthreads();
    if (tid < 16) { LAS int* PT = TOT + 64 + 1024; LAS int* PB = PT + 512; int tot = 0, base = 0;
#pragma unroll
        for (int q = 0; q < 32; ++q) { tot += PT[q * 16 + tid]; base += PB[q * 16 + tid]; }
        TOT[tid] = tot; BASE[tid] = base; }
    __syncthreads();
    if (tid < 2) { int off = 0; for (int e = 0; e < 8; ++e) { SEG[tid * 8 + e] = off; off += (TOT[tid * 8 + e] + 255) & ~255; } NTK[tid] = off >> 8; }
    __syncthreads();
    int* rowtok = (int*)(ws + WS_ROWTOK); float* rowgate = (float*)(ws + WS_ROWGATE); int* tile = (int*)(ws + WS_TILE);
    if (F.vcu == 0) {
        for (int k = 0; k < 2; ++k) {
            if (tid == 0) tile[k * 256] = NTK[k];
            if (tid < NTK[k]) { int e = 0; for (int j = 1; j < 8; ++j) if (tid * 256 >= SEG[k * 8 + j]) e = j; tile[k * 256 + 1 + tid] = e; }
            for (int e = 0; e < 8; ++e) { const int tot = TOT[k * 8 + e], r = tot + tid; if (tid < 256 && r < ((tot + 255) & ~255)) { rowtok[k * MAXRT * 256 + SEG[k * 8 + e] + r] = -1; rowgate[k * MAXRT * 256 + SEG[k * 8 + e] + r] = 0.f; } }
        }
    }
    const int TPW = (T + F.G - 1) / F.G, tb = F.vcu * TPW, t = tb + tid; const bool act = tid < TPW && t < T;
    const int* topi = (const int*)(ws + WS_TOPI); const float* topg = (const float*)(ws + WS_TOPG);
    int e0 = -1, e1 = -1; if (act) { e0 = topi[t * 2]; e1 = topi[t * 2 + 1]; }
    EL[tid] = e0; EL[512 + tid] = e1;
    __syncthreads();
    if (act) { int r0 = 0, r1 = 0; for (int j = 0; j < tid; ++j) { r0 += (EL[j] == e0); r1 += (EL[512 + j] == e1); }
        const int p0 = SEG[e0] + BASE[e0] + r0, p1 = SEG[8 + e1] + BASE[8 + e1] + r1;
        rowtok[p0] = t; rowgate[p0] = topg[t * 2]; rowtok[MAXRT * 256 + p1] = t; rowgate[MAXRT * 256 + p1] = topg[t * 2 + 1]; }
}
DI void final_norm(const Frame& F, const Args& a) {
    const int gw = F.vcu * 8 + F.wave, NGW = F.G * 8, lane = F.lane;
    const bf16* xb = (const bf16*)(F.ws + WS_XB);
    f32x4 g[2][2];
#pragma unroll
    for (int jj = 0; jj < 2; ++jj) { g[jj][0] = *((const f32x4*)a.in[I_FING] + 128 * jj + 2 * lane); g[jj][1] = *((const f32x4*)a.in[I_FING] + 128 * jj + 2 * lane + 1); }
    for (int m0 = gw * 4; m0 < T; m0 += NGW * 4) {
        u32x4 v[4][2];
#pragma unroll
        for (int r = 0; r < 4; ++r)
#pragma unroll
            for (int jj = 0; jj < 2; ++jj) v[r][jj] = *((const u32x4*)(xb + (size_t)(m0 + r) * D) + lane + 64 * jj);
#pragma unroll
        for (int r = 0; r < 4; ++r) { float x[2][8]; float s = 0.f;
#pragma unroll
            for (int jj = 0; jj < 2; ++jj)
#pragma unroll
                for (int c = 0; c < 4; ++c) { x[jj][2 * c] = bflo(v[r][jj][c]); x[jj][2 * c + 1] = bfhi(v[r][jj][c]); }
#pragma unroll
            for (int jj = 0; jj < 2; ++jj) s += ((x[jj][0] * x[jj][0] + x[jj][1] * x[jj][1]) + (x[jj][2] * x[jj][2] + x[jj][3] * x[jj][3])) + ((x[jj][4] * x[jj][4] + x[jj][5] * x[jj][5]) + (x[jj][6] * x[jj][6] + x[jj][7] * x[jj][7]));
            s = wave_sum(s); const float rs = 1.0f / sqrtf(s * (1.0f / D) + EPS);
            f32x4* o = (f32x4*)(a.out + (size_t)(m0 + r) * D) + 2 * lane;
#pragma unroll
            for (int jj = 0; jj < 2; ++jj) { o[128 * jj] = (f32x4){x[jj][0], x[jj][1], x[jj][2], x[jj][3]} * rs * g[jj][0]; o[128 * jj + 1] = (f32x4){x[jj][4], x[jj][5], x[jj][6], x[jj][7]} * rs * g[jj][1]; } }
    }
}

#ifndef MK_PER_PHASE
#define MK_PER_PHASE 0
#endif
constexpr int N_PHASES = 21;
#ifndef PH_MASK
#define PH_MASK 0xFFFFFFFFu
#endif
#define PH_ON(k) && ((PH_MASK >> (k)) & 1u)
#ifndef REP_MASK
#define REP_MASK 0u
#endif
#ifndef REP_N
#define REP_N 2
#endif
#define REPS(k) for (int _rep = 0; _rep < 1 + (((REP_MASK >> (k)) & 1u) ? REP_N : 0); ++_rep)
DI int bxo() { int b = (int)blockIdx.x; asm volatile("" : "+s"(b)); return b; }
__global__ void __launch_bounds__(512, 2) trunk_fwd(Args args) {
    extern __shared__ __attribute__((aligned(16))) unsigned char lds_raw[];
    Frame F;
    F.lds = (LAS unsigned char*)lds_raw;
    const int wv0 = __builtin_amdgcn_readfirstlane((int)threadIdx.x >> 6);
    F.lane = lane_asm(); F.wave = wv0; F.tid = wv0 * 64 + F.lane;
    F.G = gridDim.x; { const int bx = blockIdx.x; F.vcu = (F.G % 8 == 0) ? (bx % 8) * (F.G / 8) + bx / 8 : bx; }
    F.ws = args.ws;
    volatile LAS unsigned* MISC = (volatile LAS unsigned*)(F.lds + MISC_OFF);
    for (int u = F.tid; u < (LDS_BYTES - MISC_OFF) / 4; u += 512) MISC[u] = 0u;
    __syncthreads();
    XcdBarrier bar; bar.bar = (unsigned*)(F.ws + WS_CTL) + CW_BAR; bar.x = 0; bar.st = nullptr; bar.wv = wv0;
    if (!MK_PER_PHASE) bar = xcd_barrier_post((unsigned*)(F.ws + WS_CTL) + CW_BAR, MISC + 8, wv0);
    const int lo = args.ph_lo, hi = args.ph_hi;
#define IN(k) (lo <= (k) && (k) < hi)
#define REFRESH() do { const int _l = lane_asm(); int _w = wv0; asm volatile("" : "+s"(_w)); F.lane = _l; F.wave = _w; F.tid = _w * 64 + _l; } while (0)
#define SEAM(k) do { if (IN(k) && IN((k) + 1)) xcd_barrier(bar); } while (0)
    unsigned char* ws = F.ws;
    bf16* xb = (bf16*)(ws + WS_XB); float* ssq = (float*)(ws + WS_SSQ);

    if (IN(0) PH_ON(0)) REPS(0) { REFRESH(); p0_prologue(F, args); __syncthreads(); }
    SEAM(0);
    for (int l = 0; l < 2; ++l) {
        const int pb = 1 + 8 * l;
        Mix M; M.l = l; M.proj = (const bf16*)(ws + WS_PROJ);
        M.convw = args.in[I_CONVW] + l * 4 * 512; M.convb = args.in[I_CONVB] + l * 512; M.bif = args.in[I_BIF] + l * 8; M.skip = args.in[I_SKIP] + l * 512; M.mhg = args.in[I_MHG] + l * 512;
        M.gmvg = args.in[I_GMVG] + l * 512; M.bsp = args.in[I_BSP] + l * 512; M.gmog = args.in[I_GMOG] + l * 512;
        M.wg = (const bf16*)(ws + WS_WG) + (size_t)l * 16 * 1024; M.wq = (const bf16*)(ws + WS_WQ); M.wk = M.wq + 8 * 128 * 128; M.wv = M.wq + 16 * 128 * 128; M.wsp = (const bf16*)(ws + WS_WSP);
        if (IN(pb) PH_ON(1)) REPS(1) { pg8::Gemm g{xb, (const bf16*)(ws + WS_WIN) + (size_t)l * DIN * D, D, 0, nullptr}; pg8::StaticOrder S; S.init(T, DIN, F.G, bxo());
            EpiIn E{(bf16*)(ws + WS_PROJ), ssq, F.lds, (float*)(ws + WS_VST), false}; pg8::gemm_phase<EpiIn, pg8::StaticOrder, false>(F.lds, g, S, E, F.wave); }
        SEAM(pb);
        if (IN(pb + 1) PH_ON(2)) REPS(2) { REFRESH(); __syncthreads(); if (l == 0) { dense_quant(F, args); __syncthreads(); } REPS(21) for (int u = F.vcu; u < NU; u += F.G) mlstm_local3(F, M, u);
            REFRESH();
            REPS(20) for (int ub = F.vcu; ub < T / 128; ub += F.G) { __syncthreads(); gmlp_unit(F, M, ub); } }
        SEAM(pb + 1);
        if (IN(pb + 2) PH_ON(3)) { REFRESH(); mlstm_scan(F); }
        SEAM(pb + 2);
        if (IN(pb + 3) PH_ON(4)) REPS(4) { REFRESH(); __syncthreads(); mlstm_out_phase(F, M); }
        SEAM(pb + 3);
        if (IN(pb + 4) PH_ON(5)) { const bool cw = l == 1, cfirst = (F.vcu & 1) == 0;
            if (cw && cfirst) { REFRESH(); __syncthreads(); moe_weights(F, args); __syncthreads(); }
            { pg8::Gemm g{(const bf16*)(ws + WS_Y), (const bf16*)(ws + WS_WOUT) + (size_t)l * D * D, D, 0, nullptr}; pg8::StaticOrder S; S.init(T, D, F.G, bxo());
              EpiResT<true> E{nullptr, xb, ssq, F.lds}; pg8::gemm_phase<EpiResT<true>, pg8::StaticOrder, false>(F.lds, g, S, E, F.wave); }
            if (cw && !cfirst) { REFRESH(); __syncthreads(); moe_weights(F, args); __syncthreads(); } }
        SEAM(pb + 4);
        if (l == 0) {
            if (IN(6) PH_ON(6)) { REFRESH(); rows_to_int8(F); }
            SEAM(6);
            if (IN(7) PH_ON(6)) REPS(6) { pg8::Gemm g{(const bf16*)(ws + WS_XB8D), (const bf16*)(ws + WS_W13), D / 2, 0, nullptr}; pg8::StaticOrder S; S.init(T, 2 * DFFP, F.G, bxo());
                EpiGluI8T<true> E{(bf16*)(ws + WS_HID), DFFP, (const float*)(ws + WS_SA), (const float*)(ws + WS_SWD), nullptr, 0u}; pg8::gemm_phase<EpiGluI8T<true>, pg8::StaticOrder, false, 1>(F.lds, g, S, E, F.wave); }
            SEAM(7);
            if (IN(8) PH_ON(7)) { pg8::Gemm g{(const bf16*)(ws + WS_HID), (const bf16*)(ws + WS_W2), DFFP / 2, 0, nullptr}; pg8::StaticOrder S; S.init(T, D, F.G, bxo());
                EpiResT<true> E{nullptr, xb, ssq, F.lds}; pg8::gemm_phase<EpiResT<true>, pg8::StaticOrder, false, 2>(F.lds, g, S, E, F.wave); }
            SEAM(8);
        }
    }
    if (IN(14) PH_ON(13)) REPS(13) { REFRESH(); __syncthreads(); route_tokens(F, args); }
    SEAM(14);
    if (IN(15) PH_ON(14)) { REFRESH(); route_scatter(F); }
    SEAM(15);
    {
        const int* tile0 = (const int*)(ws + WS_TILE); const int* tile1 = tile0 + 256;
        const int S0 = __builtin_amdgcn_readfirstlane(tile0[0]), S1 = __builtin_amdgcn_readfirstlane(tile1[0]);
        unsigned* hidcnt = (unsigned*)(ws + WS_CTL) + CW_HID;
        for (int ph = 0; ph < 4; ++ph) {
            if (IN(16 + ph) PH_ON(15)) {
                int prev_units = 0;
                if (ph >= 1) {
                    const int p = ph - 1, k = p == 0 ? 0 : 1, first = p == 2 ? S1 - 64 : 0, nM = p == 0 ? S0 : (p == 1 ? S1 - 64 : 64), hid0 = p == 2 ? 72 : 0;
                    const int* rowtok = (const int*)(ws + WS_ROWTOK) + k * MAXRT * 256; const float* rowgate = (const float*)(ws + WS_ROWGATE) + k * MAXRT * 256;
                    pg8::Gemm g{(const bf16*)(ws + WS_MHID), (const bf16*)(ws + WS_MW2), DFE / 2, (size_t)D * DFE / 2, nullptr}; pg8::MoeOrder S; S.init(k ? tile1 : tile0, first, nM, hid0, D, F.G, bxo(), 0, 0);
                    EpiMoe2 E{xb, rowtok, rowgate, hidcnt}; pg8::gemm_phase<EpiMoe2, pg8::MoeOrder, false, 2>(F.lds, g, S, E, F.wave);
                    prev_units = nM * (D / 256);
                }
                if (ph <= 2) {
                    const int p = ph, k = p == 0 ? 0 : 1, first = p == 2 ? S1 - 64 : 0, nM = p == 0 ? S0 : (p == 1 ? S1 - 64 : 64), hid0 = p == 2 ? 72 : 0;
                    const int* rowtok = (const int*)(ws + WS_ROWTOK) + k * MAXRT * 256;
                    pg8::Gemm g{(const bf16*)(ws + WS_XR8), (const bf16*)(ws + WS_MW13), D / 2, (size_t)2 * DFE * (D / 2), rowtok}; pg8::MoeOrder S; S.init(k ? tile1 : tile0, first, nM, hid0, 2 * DFE, F.G, bxo(), prev_units, 3);
                    EpiGluF8 E{ws + WS_MHID, DFE, hidcnt, p == 1 ? 4u : 0u}; pg8::gemm_phase<EpiGluF8, pg8::MoeOrder, true, 2>(F.lds, g, S, E, F.wave);
                }
            }
            SEAM(16 + ph);
        }
    }
    if (IN(20) PH_ON(19)) { REFRESH(); final_norm(F, args); }
#undef IN
#undef SEAM
}

extern "C" void kernel_launch(void* const* d_in, const int* in_sizes, int n_in, void* d_out, int out_size, void* d_ws, size_t ws_size, hipStream_t stream) {
    static int grid = 0;
    if (grid == 0) {
        if (n_in != 26 || in_sizes[0] != T * D || out_size != T * D || ws_size < WS_END) { fprintf(stderr, "kernel_launch: unexpected shapes / workspace (n_in %d, ws %zu < %zu)\n", n_in, ws_size, (size_t)WS_END); grid = -1; return; }
        int dev = 0, cus = 0, per_cu = 0;
        if (hipGetDevice(&dev) != hipSuccess || hipDeviceGetAttribute(&cus, hipDeviceAttributeMultiprocessorCount, dev) != hipSuccess) { grid = -1; return; }
        if (hipFuncSetAttribute((const void*)trunk_fwd, hipFuncAttributeMaxDynamicSharedMemorySize, LDS_BYTES) != hipSuccess) { fprintf(stderr, "kernel_launch: hipFuncSetAttribute failed\n"); grid = -1; return; }
        if (hipOccupancyMaxActiveBlocksPerMultiprocessor(&per_cu, (const void*)trunk_fwd, 512, LDS_BYTES) != hipSuccess || per_cu < 1) { fprintf(stderr, "kernel_launch: occupancy query says %d\n", per_cu); }
        (void)hipGetLastError();
        grid = cus;
    }
    if (grid < 0) return;
    (void)hipMemsetAsync((char*)d_ws + WS_CTL, 0, CTL_ZERO_BYTES, stream);
    Args a{};
    for (int i = 0; i < 26; ++i) a.in[i] = (const float*)d_in[i];
    a.out = (float*)d_out; a.ws = (unsigned char*)d_ws;
#if MK_PER_PHASE
    for (int p = 0; p < N_PHASES; ++p) { a.ph_lo = p; a.ph_hi = p + 1; hipLaunchKernelGGL(trunk_fwd, dim3(grid), dim3(512), LDS_BYTES, stream, a); }
#else
    a.ph_lo = 0; a.ph_hi = N_PHASES;
    hipLaunchKernelGGL(trunk_fwd, dim3(grid), dim3(512), LDS_BYTES, stream, a);
#endif
}
```

```cpp
#include <hip/hip_runtime.h>
#include <cstdio>
#include <cstdint>

#define LAS __attribute__((address_space(3)))
#define GAS __attribute__((address_space(1)))
typedef unsigned short bf16;
typedef short bf16x8 __attribute__((ext_vector_type(8)));
typedef short s16x4 __attribute__((ext_vector_type(4)));
typedef float f32x4 __attribute__((ext_vector_type(4)));
typedef float f32x2 __attribute__((ext_vector_type(2)));
typedef unsigned u32x4 __attribute__((ext_vector_type(4)));
typedef unsigned u32x2 __attribute__((ext_vector_type(2)));
typedef int i32x4 __attribute__((ext_vector_type(4)));
#define DI __device__ __forceinline__

constexpr int NB = 4, SEQ = 8192, T = NB * SEQ, D = 1024, DIN = 2048;
constexpr int CH = 64, NCH = SEQ / CH;
constexpr int NU = T / CH;
constexpr int DFF = 2752, DFFP = 2816;
constexpr int NE = 8, DFE = 3584;
constexpr int MAXRT = 136;
constexpr float EPS = 1e-6f;

constexpr size_t MiB = 1u << 20;
constexpr size_t WS_CTL = 0, CTL_ZERO_BYTES = 1 * MiB;
constexpr size_t WS_SSQ = 1 * MiB;
constexpr size_t WS_VST = 1 * MiB + 512 * 1024;
constexpr size_t WS_WG = 3 * MiB + 512 * 1024;
constexpr size_t WS_WQ = WS_WG + 64 * 1024;
constexpr size_t WS_WSP = WS_WQ + 3 * 256 * 1024;
constexpr size_t WS_GB = 5 * MiB;
constexpr size_t WS_SC = 6 * MiB;
constexpr size_t WS_MP = WS_SC + 64 * 1024;
constexpr size_t WS_TOPI = 6 * MiB + 256 * 1024;
constexpr size_t WS_TOPG = WS_TOPI + 256 * 1024;
constexpr size_t WS_CNT = WS_TOPG + 256 * 1024;
constexpr size_t WS_ROWTOK = 7 * MiB;
constexpr size_t WS_ROWGATE = WS_ROWTOK + 512 * 1024;
constexpr size_t WS_TILE = WS_ROWGATE + 512 * 1024 - 4096;
constexpr size_t WS_WIN = 8 * MiB;
constexpr size_t WS_WOUT = 16 * MiB;
constexpr size_t WS_W13 = 20 * MiB;
constexpr size_t WS_W2 = 31 * MiB;
constexpr size_t WS_XB = 40 * MiB;
constexpr size_t WS_BIG = 104 * MiB;
constexpr size_t WS_PROJ = WS_BIG;
constexpr size_t WS_QG = WS_BIG + 128 * MiB;
constexpr size_t WS_KG = WS_BIG + 160 * MiB;
constexpr size_t WS_VG = WS_BIG + 192 * MiB;
constexpr size_t WS_ST = WS_BIG + 224 * MiB;
constexpr size_t WS_Y = WS_BIG + 296 * MiB;
constexpr size_t WS_XCG = WS_BIG + 360 * MiB;
constexpr size_t WS_HID = WS_BIG;
constexpr size_t WS_MW13 = WS_BIG;
constexpr size_t WS_XR8 = WS_BIG + 64 * MiB;
constexpr size_t WS_MW2 = WS_BIG + 112 * MiB;
constexpr size_t WS_MHID = WS_BIG + 168 * MiB;
constexpr size_t WS_END = WS_BIG + 408 * MiB;
static_assert(WS_MHID + (size_t)MAXRT * 256 * DFE * 2 <= WS_END && WS_Y + (size_t)T * D * 2 <= WS_END, "ws map");
constexpr int CW_BAR = 4096;
constexpr size_t WS_SWD = WS_CTL + 496 * 1024;
constexpr size_t WS_XB8D = WS_BIG + 200 * MiB;
constexpr size_t WS_SW13 = WS_CTL + 256 * 1024;
constexpr size_t WS_ROWSA = WS_GB;
constexpr size_t WS_SA = WS_GB + 512 * 1024;
constexpr int CW_HID = 16384;

constexpr int RING_BYTES = 131072;
constexpr int MISC_OFF = RING_BYTES + 12288;
constexpr int LDS_BYTES = 147456;

typedef __bf16 bf16x2_t __attribute__((ext_vector_type(2)));
DI unsigned pk2(float lo, float hi) { const f32x2 v = {lo, hi}; return __builtin_bit_cast(unsigned, __builtin_convertvector(v, bf16x2_t)); }
DI unsigned f2bf(float f) { return pk2(f, f) & 0xffffu; }
DI float bf2f(unsigned b) { return __builtin_bit_cast(float, b << 16); }
DI float bflo(unsigned w) { return __builtin_bit_cast(float, w << 16); }
DI float bfhi(unsigned w) { return __builtin_bit_cast(float, w & 0xffff0000u); }
DI float fexp(float x) { return __builtin_amdgcn_exp2f(x * 1.44269504089f); }
DI float softplus_neg(float a) { return __builtin_amdgcn_logf(1.0f + __builtin_amdgcn_exp2f(-1.44269504089f * a)) * 0.69314718056f; }
DI float sigmoidf(float x) { return __builtin_amdgcn_rcpf(1.0f + fexp(-x)); }
DI float siluf(float x) { return x * sigmoidf(x); }
DI float geluf(float x) { return x * sigmoidf(1.59576912161f * (x + 0.044715f * x * x * x)); }
DI float dpp_f(float v, const int ctrl_sel) {
    const int x = __builtin_bit_cast(int, v); int r;
    if (ctrl_sel == 0) r = __builtin_amdgcn_update_dpp(x, x, 0xB1, 0xF, 0xF, false);
    else if (ctrl_sel == 1) r = __builtin_amdgcn_update_dpp(x, x, 0x4E, 0xF, 0xF, false);
    else if (ctrl_sel == 2) r = __builtin_amdgcn_update_dpp(x, x, 0x141, 0xF, 0xF, false);
    else r = __builtin_amdgcn_update_dpp(x, x, 0x140, 0xF, 0xF, false);
    return __builtin_bit_cast(float, r);
}
DI float rl_f(float v, int l) { return __builtin_bit_cast(float, __builtin_amdgcn_readlane(__builtin_bit_cast(int, v), l)); }
DI float wave_sum(float v) {
    v += dpp_f(v, 0); v += dpp_f(v, 1); v += dpp_f(v, 2); v += dpp_f(v, 3);
    return (rl_f(v, 0) + rl_f(v, 16)) + (rl_f(v, 32) + rl_f(v, 48));
}
DI float wave_max(float v) {
    v = fmaxf(v, dpp_f(v, 0)); v = fmaxf(v, dpp_f(v, 1)); v = fmaxf(v, dpp_f(v, 2)); v = fmaxf(v, dpp_f(v, 3));
    return fmaxf(fmaxf(rl_f(v, 0), rl_f(v, 16)), fmaxf(rl_f(v, 32), rl_f(v, 48)));
}
#define MFMA16(a, b, c) __builtin_amdgcn_mfma_f32_16x16x32_bf16((a), (b), (c), 0, 0, 0)
#define LDS_WAIT() asm volatile("s_waitcnt lgkmcnt(0)" ::: "memory")
#define VM_WAIT() asm volatile("s_waitcnt vmcnt(0)" ::: "memory")

DI int lane_asm() { int l; asm volatile("v_mbcnt_lo_u32_b32 %0, -1, 0\n\tv_mbcnt_hi_u32_b32 %0, -1, %0" : "=v"(l)); return l; }
namespace pg8 {
constexpr int BM = 256, BK = 64, HALF = 128, HTB = HALF * BK * 2, STAGE_BYTES = 8 * HTB, NXCD = 8, WGM = 8;
__host__ __device__ __forceinline__ int lds_byte(int r, int c) { const int st = (r >> 4) * 2 + (c >> 5), rr = r & 15, cc = c & 31, ob = rr * 64 + cc * 2; return st * 1024 + (ob ^ (((ob >> 9) & 1) << 5)); }
__host__ __device__ __forceinline__ void stage_rc(int b, int& R, int& C) { const int st = b / 1024, sb = b % 1024, swz = sb ^ (((sb >> 9) & 1) << 5); R = (st >> 1) * 16 + swz / 64; C = (st & 1) * 32 + (swz % 64) / 2; }
__host__ __device__ __forceinline__ int perm32(int rho) { const int n = rho >> 4, i = rho & 15; return 8 * (i >> 2) + 4 * n + (i & 3); }

struct Unit { int pm, pn, e, ph; };
struct Gemm { const bf16* A; const bf16* Bt; int K; size_t estride; const int* rowtok; };

DI void tile_of(int wgid, int nM, int nN, int& pm, int& pn) {
    const int nwg = nM * nN;
    { const int q = nwg / NXCD, r = nwg % NXCD, xcd = wgid % NXCD, off = wgid / NXCD; wgid = (xcd < r ? xcd * (q + 1) : r * (q + 1) + (xcd - r) * q) + off; }
    const int nig = WGM * nN, gid = wgid / nig, fm = gid * WGM, gsz = (nM - fm) < WGM ? (nM - fm) : WGM;
    pm = fm + ((wgid % nig) % gsz); pn = (wgid % nig) / gsz;
}
struct StaticOrder {
    int nM, nN, nwg, G, c;
    DI void init(int M, int N, int G_, int c_) { nM = M / BM; nN = N / BM; nwg = nM * nN; G = G_; c = c_; }
    DI bool next(int i, Unit& u) const {
        const long L = (long)i * G + c; if (L >= nwg) return false;
        tile_of((int)L, nM, nN, u.pm, u.pn); u.e = 0; u.ph = u.pm; return true;
    }
};
struct MoeOrder {
    const int* tile; int first, hid0, nM, nN, W, j, cnt, base, ex, SK;
    DI void init(const int* tile_, int first_, int nM_, int hid0_, int N, int G, int c, int prev_units, int SK_) {
        tile = tile_; first = first_; hid0 = hid0_; nM = nM_; nN = N / BM; SK = SK_;
        const int nwg = nM * nN; int x, nx;
        if (G % NXCD == 0) { x = c % NXCD; j = c / NXCD; W = G / NXCD; nx = NXCD; } else { x = 0; j = c; W = G; nx = 1; }
        const int q = nwg / nx, r = nwg % nx; cnt = q + (x < r ? 1 : 0); base = (x < r) ? x * (q + 1) : r * (q + 1) + (x - r) * q;
        const int q2 = prev_units / nx, r2 = prev_units % nx, cnt2 = q2 + (x < r2 ? 1 : 0); ex = cnt2 % W;
    }
    DI bool next(int i, Unit& u) const {
        const int R = i + (j < ex ? SK : 0);
        const int off = (R < SK) ? R * (W - ex) + (j - ex) : SK * (W - ex) + (R - SK) * W + j;
        if (off >= cnt) return false;
        const int wgid = base + off, nig = WGM * nN, gid = wgid / nig, fm = gid * WGM, gsz = (nM - fm) < WGM ? (nM - fm) : WGM;
        const int pl = fm + ((wgid % nig) % gsz); u.pn = (wgid % nig) / gsz; u.pm = first + pl; u.ph = hid0 + pl;
        u.e = __builtin_amdgcn_readfirstlane(tile[1 + u.pm]); return true;
    }
};

DI unsigned cvt_pk_bf16(float lo, float hi) { unsigned r; asm volatile("v_cvt_pk_bf16_f32 %0, %1, %2" : "=v"(r) : "v"(lo), "v"(hi)); return r; }

template <bool I8> struct AccT { typedef f32x4 type; };
template <> struct AccT<true> { typedef i32x4 type; };
template <class Epi, class Sched, bool GATHER, int Q = 0>
DI void gemm_phase(LAS unsigned char* lds, const Gemm g, const Sched& S, const Epi& E, const int wv) {
    constexpr bool I8 = Q == 1;
    typedef typename AccT<I8>::type acc_t;
    int wid = wv; asm volatile("" : "+s"(wid));
    const int tid = wid * 64 + lane_asm();
    const int lane = tid & 63, wr = wid >> 2, wc = wid & 3, fr = lane & 15, fq = lane >> 4;
    const int K = g.K, nt = K / BK;
    unsigned voffA[2], voffB[2];
#pragma unroll
    for (int i = 0; i < 2; ++i) { int R, C; stage_rc(tid * 16 + i * 8192, R, C); const int Rb = Epi::PERM ? ((R & ~31) + perm32(R & 31)) : R;
        voffA[i] = (unsigned)(R * K + C) * 2u; voffB[i] = (unsigned)(Rb * K + C) * 2u; }
    const unsigned kstep = (unsigned)(BK * 2);
    const size_t hstep = (size_t)HALF * K * 2;
    const size_t tstep = 2 * hstep;
    const unsigned ldsw = (unsigned)wid * 1024u;
    const int aoff = lds_byte(wr * 64 + fr, fq * 8), boff = lds_byte(wc * 32 + fr, fq * 8);
#define PG8_SA(b, h) (((b) * 2 + (h)) * HTB)
#define PG8_SB(b, h) ((4 + (b) * 2 + (h)) * HTB)
#define PG8_STAGE(bufoff, gbase, voff) do { _Pragma("unroll") for (int _i = 0; _i < 2; ++_i) { unsigned _vo = (voff)[_i]; asm volatile("" : "+v"(_vo)); \
        __builtin_amdgcn_global_load_lds((const unsigned*)((const char*)(gbase) + _vo), (LAS unsigned*)(lds + (bufoff) + ldsw + _i * 8192), 16, 0, 0); } } while (0)
#define PG8_STAGEA(bufoff, PA, OA, h, kb) do { if constexpr (GATHER) { _Pragma("unroll") for (int _i = 0; _i < 2; ++_i) { unsigned _vo = (OA)[h][_i]; asm volatile("" : "+v"(_vo)); \
        __builtin_amdgcn_global_load_lds((const unsigned*)((const char*)g.A + (size_t)_vo + (kb)), (LAS unsigned*)(lds + (bufoff) + ldsw + _i * 8192), 16, 0, 0); } } \
        else { PG8_STAGE(bufoff, (PA) + (h) * hstep + (kb), voffA); } } while (0)
#define PG8_LDA(dst, b, h) do { _Pragma("unroll") for (int m = 0; m < 4; ++m) _Pragma("unroll") for (int k = 0; k < 2; ++k) dst[m][k] = *(const LAS bf16x8*)(lds + PG8_SA(b, h) + aoff + m * 2048 + k * 1024); } while (0)
#define PG8_LDB(dst, b, h) do { _Pragma("unroll") for (int n = 0; n < 2; ++n) _Pragma("unroll") for (int k = 0; k < 2; ++k) dst[n][k] = *(const LAS bf16x8*)(lds + PG8_SB(b, h) + boff + n * 2048 + k * 1024); } while (0)
#define PG8_CAT(X) __builtin_shufflevector(__builtin_bit_cast(i32x4, X[0]), __builtin_bit_cast(i32x4, X[1]), 0, 1, 2, 3, 4, 5, 6, 7)
#define PG8_MMA(ai, bj, At, Bt) do { __builtin_amdgcn_s_setprio(1); _Pragma("unroll") for (int m = 0; m < 4; ++m) _Pragma("unroll") for (int n = 0; n < 2; ++n) _Pragma("unroll") for (int k = 0; k < 2; ++k) { \
        if constexpr (Q == 2) { if (k == 0) acc[ai][bj][m][n] = __builtin_amdgcn_mfma_scale_f32_16x16x128_f8f6f4(PG8_CAT(Bt[n]), PG8_CAT(At[m]), acc[ai][bj][m][n], 0, 0, 0, 0x7c7c7c7c, 0, 0x7c7c7c7c); } \
        else if constexpr (I8) acc[ai][bj][m][n] = __builtin_amdgcn_mfma_i32_16x16x64_i8(__builtin_bit_cast(i32x4, Bt[n][k]), __builtin_bit_cast(i32x4, At[m][k]), acc[ai][bj][m][n], 0, 0, 0); \
        else acc[ai][bj][m][n] = __builtin_amdgcn_mfma_f32_16x16x32_bf16(Bt[n][k], At[m][k], acc[ai][bj][m][n], 0, 0, 0); } __builtin_amdgcn_s_setprio(0); } while (0)
#define PG8_WAIT_V(n) asm volatile("s_waitcnt vmcnt(" #n ")" ::: "memory")
#define PG8_WAIT_L(n) asm volatile("s_waitcnt lgkmcnt(" #n ")" ::: "memory")
#define PG8_BAR __builtin_amdgcn_s_barrier()
#define PG8_SCHED __builtin_amdgcn_sched_barrier(0)
#define PG8_ARAW(dst, u) do { if constexpr (GATHER) { _Pragma("unroll") for (int _h = 0; _h < 2; ++_h) _Pragma("unroll") for (int _i = 0; _i < 2; ++_i) { \
        int _R, _C; stage_rc(tid * 16 + _i * 8192, _R, _C); dst[_h][_i] = g.rowtok[(u).pm * BM + _h * HALF + _R]; } } } while (0)
#define PG8_AOFFS(dst, raw) do { if constexpr (GATHER) { _Pragma("unroll") for (int _h = 0; _h < 2; ++_h) _Pragma("unroll") for (int _i = 0; _i < 2; ++_i) { \
        int _R, _C; stage_rc(tid * 16 + _i * 8192, _R, _C); int _t = raw[_h][_i]; _t = _t < 0 ? 0 : _t; \
        dst[_h][_i] = (unsigned)_t * (unsigned)(K * 2) + (unsigned)(_C * 2); } } } while (0)
    Unit cur, nxt, nn; int ui = 0;
    if (!S.next(0, cur)) return;
    f32x4 pf0 = (f32x4){0.f, 0.f, 0.f, 0.f};
    if constexpr (Epi::PRE) E.pre(cur, tid, pf0);
    bool has_next = S.next(1, nxt); if (!has_next) nxt = cur;
    acc_t acc[2][2][4][2];
#pragma unroll
    for (int a = 0; a < 2; ++a)
#pragma unroll
        for (int b = 0; b < 2; ++b)
#pragma unroll
            for (int m = 0; m < 4; ++m)
#pragma unroll
                for (int n = 0; n < 2; ++n) acc[a][b][m][n] = acc_t{};
    bf16x8 At[4][2], B0[2][2], B1[2][2];
    unsigned oa[2][2], na[2][2]; int rt2[2][2];
    PG8_ARAW(rt2, cur); PG8_AOFFS(oa, rt2); PG8_ARAW(rt2, nxt); PG8_AOFFS(na, rt2);
    const char* cA = (const char*)g.A + (GATHER ? (size_t)0 : (size_t)cur.ph * tstep);
    const char* cB = (const char*)g.Bt + ((size_t)cur.e * g.estride) * 2 + (size_t)cur.pn * tstep;
    PG8_STAGE(PG8_SB(0, 0), cB, voffB); PG8_STAGE(PG8_SB(0, 1), cB + hstep, voffB); PG8_STAGEA(PG8_SA(0, 0), cA, oa, 0, 0); PG8_STAGEA(PG8_SA(0, 1), cA, oa, 1, 0);
    if (wr == 1) PG8_BAR;
    PG8_WAIT_V(2); PG8_BAR;
    if constexpr (Epi::PRE) E.post(tid, pf0, 0);
    PG8_STAGE(PG8_SB(1, 0), cB + kstep, voffB); PG8_STAGEA(PG8_SA(1, 0), cA, oa, 0, kstep); PG8_STAGE(PG8_SB(1, 1), cB + hstep + kstep, voffB);
    PG8_WAIT_V(6); PG8_BAR;
    for (;;) {
        const char* nA = (const char*)g.A + (GATHER ? (size_t)0 : (size_t)nxt.ph * tstep);
        const char* nB = (const char*)g.Bt + ((size_t)nxt.e * g.estride) * 2 + (size_t)nxt.pn * tstep;
        for (int t = 0; t < nt; t += 2) {
            const bool last = (t == nt - 2);
            const unsigned k1 = (unsigned)(t + 1) * kstep, k2 = last ? 0u : (unsigned)(t + 2) * kstep, k3 = k2 + kstep;
            const char* a2 = last ? nA : cA;
            const char* b2 = last ? nB : cB + (size_t)(t + 2) * kstep; const char* b3 = b2 + kstep;
            PG8_LDB(B0, 0, 0); PG8_LDB(B1, 0, 1); PG8_SCHED; PG8_LDA(At, 0, 0); PG8_STAGEA(PG8_SA(1, 1), cA, oa, 1, k1);
            if constexpr (GATHER) { if (last) {
#pragma unroll
                for (int h = 0; h < 2; ++h)
#pragma unroll
                    for (int i = 0; i < 2; ++i) oa[h][i] = na[h][i]; } }
            PG8_WAIT_V(8); PG8_WAIT_L(0); PG8_BAR; PG8_MMA(0, 0, At, B0); PG8_MMA(0, 1, At, B1); PG8_BAR; PG8_SCHED;
            PG8_LDA(At, 0, 1); PG8_STAGE(PG8_SB(0, 0), b2, voffB); PG8_STAGE(PG8_SB(0, 1), b2 + hstep, voffB); PG8_STAGEA(PG8_SA(0, 0), a2, oa, 0, k2);
            PG8_WAIT_V(8); PG8_WAIT_L(0); PG8_BAR; PG8_MMA(1, 0, At, B0); PG8_MMA(1, 1, At, B1); PG8_BAR; PG8_SCHED;
            PG8_LDB(B0, 1, 0); PG8_LDB(B1, 1, 1); PG8_SCHED; PG8_LDA(At, 1, 0); PG8_STAGEA(PG8_SA(0, 1), a2, oa, 1, k2);
            PG8_WAIT_V(8); PG8_WAIT_L(0); PG8_BAR; PG8_MMA(0, 0, At, B0); PG8_MMA(0, 1, At, B1); PG8_BAR; PG8_SCHED;
            PG8_LDA(At, 1, 1); PG8_STAGE(PG8_SB(1, 0), b3, voffB); PG8_STAGE(PG8_SB(1, 1), b3 + hstep, voffB); PG8_STAGEA(PG8_SA(1, 0), a2, oa, 0, k3);
            PG8_WAIT_V(8); PG8_WAIT_L(0); PG8_BAR; PG8_MMA(1, 0, At, B0); PG8_MMA(1, 1, At, B1); PG8_BAR; PG8_SCHED;
        }
        if (wr == 0) PG8_BAR;
        bool has_nn = has_next && S.next(ui + 2, nn); if (!has_nn) nn = nxt;
        PG8_ARAW(rt2, nn);
        f32x4 pf = (f32x4){0.f, 0.f, 0.f, 0.f};
        if constexpr (Epi::PRE) { if (has_next) E.pre(nxt, wid * 64 + lane_asm(), pf); }
        E.done(cur, wid * 64 + lane_asm());
        { const int l2 = lane_asm(); int wr_ = wr, wc_ = wc; asm volatile("" : "+s"(wr_), "+s"(wc_));
          E(acc, cur, wr_, wc_, l2 & 15, l2 >> 4, ui & 1); }
        if (!has_next) break;
        if constexpr (Epi::PRE) E.post(wid * 64 + lane_asm(), pf, (ui + 1) & 1);
        PG8_AOFFS(na, rt2);
#pragma unroll
        for (int a = 0; a < 2; ++a)
#pragma unroll
            for (int b = 0; b < 2; ++b)
#pragma unroll
                for (int m = 0; m < 4; ++m)
#pragma unroll
                    for (int n = 0; n < 2; ++n) acc[a][b][m][n] = acc_t{};
        cur = nxt; cA = nA; cB = nB; nxt = nn; has_next = has_nn; ++ui;
        if (wr == 1) PG8_BAR;
    }
    PG8_WAIT_V(0);
    PG8_BAR;
#undef PG8_SA
#undef PG8_SB
#undef PG8_STAGE
#undef PG8_STAGEA
#undef PG8_LDA
#undef PG8_LDB
#undef PG8_MMA
#undef PG8_CAT
#undef PG8_WAIT_V
#undef PG8_WAIT_L
#undef PG8_BAR
#undef PG8_SCHED
#undef PG8_ARAW
#undef PG8_AOFFS
}
}

#define XB_TMO      128
#define XB_XCNT(j)  (256  + 64 * (j))
#define XB_XSUB(j)  (1280 + 64 * (j))
#define XB_XGEN(j)  (2304 + 64 * (j))
#define XB_TOP      3328
#define XB_TOPGEN   3392
#define XCD_BAR_WORDS 3456
#define XB_SPIN_CAP (1u << 18)
__device__ __forceinline__ unsigned xb_ld(unsigned* p)              { return __hip_atomic_load(p, __ATOMIC_RELAXED, __HIP_MEMORY_SCOPE_AGENT); }
__device__ __forceinline__ unsigned xb_add(unsigned* p, unsigned v) { return __hip_atomic_fetch_add(p, v, __ATOMIC_RELAXED, __HIP_MEMORY_SCOPE_AGENT); }
__device__ __forceinline__ unsigned xb_xcc_id() { return (unsigned)__builtin_amdgcn_s_getreg((3 << 11) | 20) & 0xFu; }
#define XB_SPIN(cond, bar) do { unsigned _sp = 0; while (cond) { __builtin_amdgcn_s_sleep(1); \
    if ((++_sp & 255u) == 0u) { if (xb_ld(&(bar)[XB_TMO])) break; if (_sp > XB_SPIN_CAP) { atomicAdd(&(bar)[XB_TMO], 1u); break; } } } } while (0)
struct XcdBarrier { unsigned* bar; unsigned x; volatile LAS unsigned* st; int wv; };
__device__ __forceinline__ XcdBarrier xcd_barrier_post(unsigned* bar, volatile LAS unsigned* st, int wv) {
    XcdBarrier b; b.bar = bar; b.x = xb_xcc_id(); b.st = st; b.wv = wv;
    if (wv == 0 && lane_asm() == 0) (void)xb_add(&bar[XB_XCNT(b.x)], 1u);
    return b;
}
__device__ __forceinline__ void xcd_barrier_complete(unsigned* bar, unsigned x, unsigned& nloc, unsigned& nx) {
    const unsigned G = gridDim.x * gridDim.y * gridDim.z;
    unsigned sum, cnt, mine, sp = 0u;
    for (;;) {
        sum = 0u; cnt = 0u; mine = 0u;
#pragma unroll
        for (unsigned j = 0; j < 16; ++j) { const unsigned c = xb_ld(&bar[XB_XCNT(j)]); sum += c; cnt += (c > 0u) ? 1u : 0u; mine = (j == x) ? c : mine; }
        if (sum == G) break;
        __builtin_amdgcn_s_sleep(1);
        if ((++sp & 255u) == 0u) { if (xb_ld(&bar[XB_TMO])) break; if (sp > XB_SPIN_CAP) { atomicAdd(&bar[XB_TMO], 1u); break; } }
    }
    nloc = mine > 0u ? mine : 1u; nx = cnt > 0u ? cnt : 1u;
}
__device__ __forceinline__ void xcd_barrier(const XcdBarrier& b) {
    asm volatile("s_waitcnt vmcnt(0)" ::: "memory");
    __syncthreads();
    if (b.wv == 0 && lane_asm() == 0) {
        unsigned* bar = b.bar;
        __builtin_amdgcn_s_waitcnt(0);
        unsigned nloc = b.st[0], nx = b.st[1];
        if (nloc == 0u) { xcd_barrier_complete(bar, b.x, nloc, nx); b.st[0] = nloc; b.st[1] = nx; }
        const unsigned old = xb_add(&bar[XB_XSUB(b.x)], 1u);
        const unsigned gen = old / nloc;
        if (old + 1u == (gen + 1u) * nloc) {
            __builtin_amdgcn_fence(__ATOMIC_RELEASE, "agent");
            asm volatile("s_waitcnt vmcnt(0)" ::: "memory");
            const unsigned og = xb_add(&bar[XB_TOP], 1u);
            const unsigned tg = og / nx;
            if (og + 1u == (tg + 1u) * nx) xb_add(&bar[XB_TOPGEN], 1u);
            else XB_SPIN(xb_ld(&bar[XB_TOPGEN]) == tg, bar);
            __builtin_amdgcn_fence(__ATOMIC_ACQUIRE, "agent");
            xb_add(&bar[XB_XGEN(b.x)], 1u);
            asm volatile("s_waitcnt vmcnt(0)" ::: "memory");
        } else {
            XB_SPIN(xb_ld(&bar[XB_XGEN(b.x)]) == gen, bar);
            __builtin_amdgcn_fence(__ATOMIC_ACQUIRE, "agent");
            asm volatile("s_waitcnt vmcnt(0)" ::: "memory");
        }
    }
    __syncthreads();
}

struct Frame {
    LAS unsigned char* lds;
    int tid, lane, wave, vcu, G;
    unsigned char* ws;
};
struct Args { const float* in[26]; float* out; unsigned char* ws; int ph_lo, ph_hi; };
enum { I_X = 0, I_MIXG, I_WIN, I_CONVW, I_CONVB, I_WQ, I_WK, I_WV, I_WIF, I_BIF, I_SKIP, I_MHG, I_GMVG, I_WSP, I_BSP, I_GMOG, I_WOUT, I_FFNG,
       I_DW1, I_DW3, I_DW2, I_ROUTER, I_MW1, I_MW3, I_MW2, I_FING };

DI float rs_from(const f32x4 p) { return __builtin_amdgcn_rsqf(((p.x + p.y) + (p.z + p.w)) * (1.0f / D) + EPS); }
constexpr int L_PF = RING_BYTES + 4096;
constexpr int L_SSL = RING_BYTES;

struct EpiIn {
    static constexpr bool PERM = true, PRE = true;
    bf16* O; const float* ssq; LAS unsigned char* lds; float* vst; bool scaled;
    DI void done(const pg8::Unit&, int) const {}
    DI void pre(const pg8::Unit& u, int tid, f32x4& pf) const { if (tid < 256) pf = *(const f32x4*)(ssq + (size_t)(u.pm * 256 + tid) * 4); }
    DI void post(int tid, const f32x4& pf, int slot) const { if (tid < 256) ((LAS float*)(lds + L_PF))[slot * 512 + tid] = scaled ? 1.0f : rs_from(pf); }
    DI void operator()(const f32x4 (&acc)[2][2][4][2], const pg8::Unit& u, int wr, int wc, int fr, int fq, int slot) const {
        const int row0 = u.pm * 256 + wr * 64 + fr, col0 = u.pn * 256 + wc * 32 + 8 * fq, act = u.pn >> 1;
        f32x4 pp[2][4];
#pragma unroll
        for (int ai = 0; ai < 2; ++ai)
#pragma unroll
            for (int m = 0; m < 4; ++m) pp[ai][m] = (f32x4){((const LAS float*)(lds + L_PF))[slot * 512 + ai * 128 + wr * 64 + m * 16 + fr], 0.f, 0.f, 0.f};
#pragma unroll
        for (int ai = 0; ai < 2; ++ai)
#pragma unroll
            for (int m = 0; m < 4; ++m) { const int row = row0 + ai * 128 + m * 16; const float r = pp[ai][m].x; bf16* rowp = O + (size_t)row * DIN + col0; float s1 = 0.f, s2 = 0.f;
#pragma unroll
                for (int bj = 0; bj < 2; ++bj) { float v[8];
#pragma unroll
                    for (int j = 0; j < 4; ++j) { v[j] = acc[ai][bj][m][0][j] * r; v[4 + j] = acc[ai][bj][m][1][j] * r; }
                    if (act == 1) {
#pragma unroll
                        for (int j = 0; j < 8; ++j) v[j] = sigmoidf(v[j]); }
                    else if (act >= 2) {
#pragma unroll
                        for (int j = 0; j < 8; ++j) v[j] = geluf(v[j]); }
                    u32x4 w; w.x = pg8::cvt_pk_bf16(v[0], v[1]); w.y = pg8::cvt_pk_bf16(v[2], v[3]); w.z = pg8::cvt_pk_bf16(v[4], v[5]); w.w = pg8::cvt_pk_bf16(v[6], v[7]);
                    *(u32x4*)(rowp + bj * 128) = w;
                    if (act == 3) { s1 += ((v[0] + v[1]) + (v[2] + v[3])) + ((v[4] + v[5]) + (v[6] + v[7])); s2 += ((v[0] * v[0] + v[1] * v[1]) + (v[2] * v[2] + v[3] * v[3])) + ((v[4] * v[4] + v[5] * v[5]) + (v[6] * v[6] + v[7] * v[7])); } }
                if (act == 3) { s1 += __shfl_xor(s1, 16); s1 += __shfl_xor(s1, 32); s2 += __shfl_xor(s2, 16); s2 += __shfl_xor(s2, 32);
                    if (fq == 0) *(f32x2*)(vst + ((size_t)row * 8 + (u.pn - 6) * 4 + wc) * 2) = (f32x2){s1, s2}; } }
    }
};
template <bool BF> struct EpiResT {
    static constexpr bool PERM = true, PRE = false;
    const float* base; bf16* xb; float* ssq; LAS unsigned char* lds;
    DI void done(const pg8::Unit&, int) const {}
    DI void operator()(const f32x4 (&acc)[2][2][4][2], const pg8::Unit& u, int wr, int wc, int fr, int fq, int slot) const {
        const int row0 = u.pm * 256 + wr * 64 + fr, col0 = u.pn * 256 + wc * 32 + 8 * fq;
        LAS float* SSL = (LAS float*)(lds + L_SSL);
#pragma unroll
        for (int ai = 0; ai < 2; ++ai) {
            f32x4 bs[4][2][2]; u32x4 bb[4][2];
#pragma unroll
            for (int m = 0; m < 4; ++m)
#pragma unroll
                for (int bj = 0; bj < 2; ++bj) { const size_t o_ = (size_t)(row0 + ai * 128 + m * 16) * D + col0 + bj * 128;
                    if constexpr (BF) bb[m][bj] = *(const u32x4*)(xb + o_); else { bs[m][bj][0] = *(const f32x4*)(base + o_); bs[m][bj][1] = *(const f32x4*)(base + o_ + 4); } }
#pragma unroll
            for (int m = 0; m < 4; ++m) { const int row = row0 + ai * 128 + m * 16; const size_t off = (size_t)row * D + col0; float ss = 0.f;
#pragma unroll
                for (int bj = 0; bj < 2; ++bj) { f32x4 b0, b1;
                    if constexpr (BF) { b0 = (f32x4){bflo(bb[m][bj].x), bfhi(bb[m][bj].x), bflo(bb[m][bj].y), bfhi(bb[m][bj].y)}; b1 = (f32x4){bflo(bb[m][bj].z), bfhi(bb[m][bj].z), bflo(bb[m][bj].w), bfhi(bb[m][bj].w)}; }
                    else { b0 = bs[m][bj][0]; b1 = bs[m][bj][1]; }
                    const f32x4 o0 = b0 + acc[ai][bj][m][0], o1 = b1 + acc[ai][bj][m][1];
                    ss += ((o0.x * o0.x + o0.y * o0.y) + (o0.z * o0.z + o0.w * o0.w)) + ((o1.x * o1.x + o1.y * o1.y) + (o1.z * o1.z + o1.w * o1.w));
                    u32x4 w; w.x = pg8::cvt_pk_bf16(o0.x, o0.y); w.y = pg8::cvt_pk_bf16(o0.z, o0.w); w.z = pg8::cvt_pk_bf16(o1.x, o1.y); w.w = pg8::cvt_pk_bf16(o1.z, o1.w);
                    *(u32x4*)(xb + off + bj * 128) = w; }
                ss += __shfl_xor(ss, 16); ss += __shfl_xor(ss, 32);
                if (fq == 0) SSL[(ai * 128 + wr * 64 + m * 16 + fr) * 4 + wc] = ss; }
            asm volatile("" ::: "memory"); }
        LDS_WAIT(); __builtin_amdgcn_s_barrier(); asm volatile("" ::: "memory");
        const int tix = (wr * 4 + wc) * 64 + fq * 16 + fr;
        if (tix < 256) { const f32x4 p = *(const LAS f32x4*)(SSL + tix * 4); ssq[(size_t)(u.pm * 256 + tix) * 4 + u.pn] = (p.x + p.y) + (p.z + p.w); }
    }
};
template <bool MOE> struct EpiGlu {
    static constexpr bool PERM = true, PRE = false;
    bf16* O; int ld; const float* ssq; const int* rowtok; unsigned* hidcnt; unsigned need;
    DI void done(const pg8::Unit&, int) const {}
    DI void operator()(const f32x4 (&acc)[2][2][4][2], const pg8::Unit& u, int wr, int wc, int fr, int fq, int slot) const {
        const int row0 = u.pm * 256 + wr * 64 + fr, orow0 = u.ph * 256 + wr * 64 + fr, col0 = u.pn * 128 + wc * 32 + 8 * fq;
        f32x4 pp[2][4];
#pragma unroll
        for (int ai = 0; ai < 2; ++ai)
#pragma unroll
            for (int m = 0; m < 4; ++m) { pp[ai][m] = (f32x4){0.f, 0.f, 0.f, 0.f}; if (!MOE) pp[ai][m] = *(const f32x4*)(ssq + (size_t)(row0 + ai * 128 + m * 16) * 4); }
        if (MOE) { if (need) { unsigned sp = 0; while ((unsigned)__builtin_amdgcn_readfirstlane(__hip_atomic_load(hidcnt + 64 * u.ph, __ATOMIC_RELAXED, __HIP_MEMORY_SCOPE_AGENT)) < need) { __builtin_amdgcn_s_sleep(2); if (++sp > (1u << 22)) break; } } }
#pragma unroll
        for (int ai = 0; ai < 2; ++ai)
#pragma unroll
            for (int m = 0; m < 4; ++m) { const float r = MOE ? 1.0f : rs_from(pp[ai][m]); float v[8];
#pragma unroll
                for (int j = 0; j < 4; ++j) { v[j] = siluf(acc[ai][0][m][0][j] * r) * (acc[ai][1][m][0][j] * r); v[4 + j] = siluf(acc[ai][0][m][1][j] * r) * (acc[ai][1][m][1][j] * r); }
                u32x4 w; w.x = pg8::cvt_pk_bf16(v[0], v[1]); w.y = pg8::cvt_pk_bf16(v[2], v[3]); w.z = pg8::cvt_pk_bf16(v[4], v[5]); w.w = pg8::cvt_pk_bf16(v[6], v[7]);
                *(u32x4*)(O + (size_t)(orow0 + ai * 128 + m * 16) * ld + col0) = w; }
    }
};
template <bool F8> struct EpiGluI8T {
    static constexpr bool PERM = true, PRE = true;
    bf16* O; int ld; const float* rowsa; const float* sw13; unsigned* hidcnt; unsigned need; LAS unsigned char* lds;
    DI void done(const pg8::Unit&, int) const {}
    DI void pre(const pg8::Unit& u, int tid, f32x4& pf) const { if (tid < 256) { pf.x = rowsa[u.pm * 256 + tid]; pf.y = sw13[(size_t)u.e * (2 * DFE) + u.pn * 256 + tid]; } }
    DI void post(int tid, const f32x4& pf, int slot) const { if (tid < 256) { LAS float* p = (LAS float*)(lds + L_PF) + slot * 512 + tid; p[0] = pf.x; p[256] = pf.y; } }
    DI void operator()(const i32x4 (&acc)[2][2][4][2], const pg8::Unit& u, int wr, int wc, int fr, int fq, int slot) const {
        const int row0 = u.pm * 256 + wr * 64 + fr, orow0 = u.ph * 256 + wr * 64 + fr, col0 = u.pn * 128 + wc * 32 + 8 * fq;
        const LAS float* SL = (const LAS float*)(lds + L_PF) + slot * 512;
        float sa[2][4];
#pragma unroll
        for (int ai = 0; ai < 2; ++ai)
#pragma unroll
            for (int m = 0; m < 4; ++m) sa[ai][m] = SL[ai * 128 + wr * 64 + m * 16 + fr];
        const LAS float* swp = SL + 256 + wc * 32 + 8 * fq;
        const f32x4 sg0 = *(const LAS f32x4*)(swp), sg1 = *(const LAS f32x4*)(swp + 4), su0 = *(const LAS f32x4*)(swp + 128), su1 = *(const LAS f32x4*)(swp + 132);
        if (need) { unsigned sp = 0; while ((unsigned)__builtin_amdgcn_readfirstlane(__hip_atomic_load(hidcnt + 64 * u.ph, __ATOMIC_RELAXED, __HIP_MEMORY_SCOPE_AGENT)) < need) { __builtin_amdgcn_s_sleep(2); if (++sp > (1u << 22)) break; } }
        const float sg[8] = {sg0.x, sg0.y, sg0.z, sg0.w, sg1.x, sg1.y, sg1.z, sg1.w}, su[8] = {su0.x, su0.y, su0.z, su0.w, su1.x, su1.y, su1.z, su1.w};
#pragma unroll
        for (int ai = 0; ai < 2; ++ai)
#pragma unroll
            for (int m = 0; m < 4; ++m) { const float r = sa[ai][m] * (1.0f / 127.0f); float v[8];
#pragma unroll
                for (int j = 0; j < 4; ++j) { v[j] = siluf((float)acc[ai][0][m][0][j] * (r * sg[j])) * ((float)acc[ai][1][m][0][j] * (r * su[j]));
                    v[4 + j] = siluf((float)acc[ai][0][m][1][j] * (r * sg[4 + j])) * ((float)acc[ai][1][m][1][j] * (r * su[4 + j])); }
                if constexpr (F8) { int w0 = __builtin_amdgcn_cvt_pk_fp8_f32(v[0], v[1], 0, false); w0 = __builtin_amdgcn_cvt_pk_fp8_f32(v[2], v[3], w0, true);
                    int w1 = __builtin_amdgcn_cvt_pk_fp8_f32(v[4], v[5], 0, false); w1 = __builtin_amdgcn_cvt_pk_fp8_f32(v[6], v[7], w1, true);
                    *(u32x2*)((unsigned char*)O + (size_t)(orow0 + ai * 128 + m * 16) * ld + col0) = (u32x2){(unsigned)w0, (unsigned)w1}; }
                else { u32x4 w; w.x = pg8::cvt_pk_bf16(v[0], v[1]); w.y = pg8::cvt_pk_bf16(v[2], v[3]); w.z = pg8::cvt_pk_bf16(v[4], v[5]); w.w = pg8::cvt_pk_bf16(v[6], v[7]);
                    *(u32x4*)(O + (size_t)(orow0 + ai * 128 + m * 16) * ld + col0) = w; } }
    }
};
typedef EpiGluI8T<false> EpiGluI8;
struct EpiGluF8 {
    static constexpr bool PERM = true, PRE = false;
    unsigned char* O; int ld; unsigned* hidcnt; unsigned need;
    DI void done(const pg8::Unit&, int) const {}
    DI void operator()(const f32x4 (&acc)[2][2][4][2], const pg8::Unit& u, int wr, int wc, int fr, int fq, int slot) const {
        const int orow0 = u.ph * 256 + wr * 64 + fr, col0 = u.pn * 128 + wc * 32 + 8 * fq;
        if (need) { unsigned sp = 0; while ((unsigned)__builtin_amdgcn_readfirstlane(__hip_atomic_load(hidcnt + 64 * u.ph, __ATOMIC_RELAXED, __HIP_MEMORY_SCOPE_AGENT)) < need) { __builtin_amdgcn_s_sleep(2); if (++sp > (1u << 22)) break; } }
#pragma unroll
        for (int ai = 0; ai < 2; ++ai)
#pragma unroll
            for (int m = 0; m < 4; ++m) { float v[8];
#pragma unroll
                for (int n = 0; n < 2; ++n)
#pragma unroll
                    for (int j = 0; j < 4; ++j) { const float t = acc[ai][0][m][n][j]; v[4 * n + j] = (t * acc[ai][1][m][n][j]) * __builtin_amdgcn_rcpf(1.0f + __builtin_amdgcn_exp2f(t)); }
                int w0 = __builtin_amdgcn_cvt_pk_fp8_f32(v[0], v[1], 0, false); w0 = __builtin_amdgcn_cvt_pk_fp8_f32(v[2], v[3], w0, true);
                int w1 = __builtin_amdgcn_cvt_pk_fp8_f32(v[4], v[5], 0, false); w1 = __builtin_amdgcn_cvt_pk_fp8_f32(v[6], v[7], w1, true);
                *(u32x2*)(O + (size_t)(orow0 + ai * 128 + m * 16) * ld + col0) = (u32x2){(unsigned)w0, (unsigned)w1}; }
    }
};
struct EpiMoe2 {
    static constexpr bool PERM = true, PRE = true;
    bf16* xb; const int* rowtok; const float* rowgate; unsigned* hidcnt; LAS unsigned char* lds;
    DI void pre(const pg8::Unit& u, int tid, f32x4& pf) const { if (tid < 256) { pf.x = __builtin_bit_cast(float, rowtok[u.pm * 256 + tid]); pf.y = rowgate[u.pm * 256 + tid]; } }
    DI void post(int tid, const f32x4& pf, int slot) const { if (tid < 256) { LAS float* p = (LAS float*)(lds + L_PF) + slot * 512 + tid; p[0] = pf.x; p[256] = pf.y; } }
    DI void done(const pg8::Unit& u, int tid) const { if (tid == 0) __hip_atomic_fetch_add(hidcnt + 64 * u.ph, 1u, __ATOMIC_RELAXED, __HIP_MEMORY_SCOPE_AGENT); }
    DI void operator()(const f32x4 (&acc)[2][2][4][2], const pg8::Unit& u, int wr, int wc, int fr, int fq, int slot) const {
        const int row0 = u.pm * 256 + wr * 64 + fr, col0 = u.pn * 256 + wc * 32 + 8 * fq;
        int tok[2][4]; float gt[2][4];
#pragma unroll
        for (int ai = 0; ai < 2; ++ai)
#pragma unroll
            for (int m = 0; m < 4; ++m) { const LAS float* p = (const LAS float*)(lds + L_PF) + slot * 512 + ai * 128 + wr * 64 + m * 16 + fr; tok[ai][m] = __builtin_bit_cast(int, p[0]); gt[ai][m] = p[256]; }
        u32x4 bb[2][4][2];
#pragma unroll
        for (int ai = 0; ai < 2; ++ai)
#pragma unroll
            for (int m = 0; m < 4; ++m) { const size_t off = (size_t)(tok[ai][m] < 0 ? 0 : tok[ai][m]) * D + col0;
#pragma unroll
                for (int bj = 0; bj < 2; ++bj) bb[ai][m][bj] = *(const u32x4*)(xb + off + bj * 128); }
#pragma unroll
        for (int ai = 0; ai < 2; ++ai)
#pragma unroll
            for (int m = 0; m < 4; ++m) { if (tok[ai][m] >= 0) { const size_t off = (size_t)tok[ai][m] * D + col0;
#pragma unroll
                for (int bj = 0; bj < 2; ++bj) { const u32x4 b = bb[ai][m][bj];
                    const f32x4 o0 = (f32x4){bflo(b.x), bfhi(b.x), bflo(b.y), bfhi(b.y)} + gt[ai][m] * acc[ai][bj][m][0], o1 = (f32x4){bflo(b.z), bfhi(b.z), bflo(b.w), bfhi(b.w)} + gt[ai][m] * acc[ai][bj][m][1];
                    u32x4 w; w.x = pg8::cvt_pk_bf16(o0.x, o0.y); w.y = pg8::cvt_pk_bf16(o0.z, o0.w); w.z = pg8::cvt_pk_bf16(o1.x, o1.y); w.w = pg8::cvt_pk_bf16(o1.z, o1.w);
                    *(u32x4*)(xb + off + bj * 128) = w; } } }
    }
};

DI void tr_item(const float* W, int N, const float* kscale, bf16* WT, int ldk, int mode, int add, int item, LAS float* scr, int lane) {
    const int nblk = N / 64, kb = item / nblk, nb = item % nblk, k0 = 64 * kb, n0 = 64 * nb;
    const int drow0 = mode ? (((n0 >> 7) << 8) + (n0 & 127) + add) : n0;
    const int kr = lane >> 4, nc = (lane & 15) * 4;
    f32x4 v[16];
#pragma unroll
    for (int i = 0; i < 16; ++i) v[i] = *(const f32x4*)(W + (size_t)(k0 + 4 * i + kr) * N + n0 + nc);
#pragma unroll
    for (int i = 0; i < 16; ++i) { const int kk = 4 * i + kr; f32x4 x = v[i]; if (kscale) x = x * kscale[k0 + kk];
        LAS float* d = scr + kk * 65 + nc; d[0] = x.x; d[1] = x.y; d[2] = x.z; d[3] = x.w; }
    LDS_WAIT(); asm volatile("" ::: "memory");
    const int c = lane & 7;
#pragma unroll
    for (int j = 0; j < 8; ++j) { const int n = (lane >> 3) + 8 * j; const LAS float* sp = scr + (8 * c) * 65 + n;
        u32x4 o; o.x = pk2(sp[0 * 65], sp[1 * 65]); o.y = pk2(sp[2 * 65], sp[3 * 65]); o.z = pk2(sp[4 * 65], sp[5 * 65]); o.w = pk2(sp[6 * 65], sp[7 * 65]);
        *(u32x4*)(WT + (size_t)(drow0 + n) * ldk + k0 + 8 * c) = o; }
    LDS_WAIT(); asm volatile("" ::: "memory");
}
DI void absmax_item(const float* W, int N, const float* ks, unsigned* sw, int add, int item, int lane);
DI void f8_item(const float* W, int N, const float* ks, float mul, unsigned char* dst, int ldk, bool il, int add, int item, LAS float* scr, int lane);
DI void p0_prologue(const Frame& F, const Args& a) {
    LAS float* scr = (LAS float*)(F.lds + F.wave * 16896);
    const int gw = F.vcu * 8 + F.wave, NGW = F.G * 8, lane = F.lane;
    unsigned char* ws = F.ws;
    constexpr int I_IN = 16 * 32, I_OUT = 16 * 16, I_W1 = 16 * 43, I_W2 = 43 * 16, I_QKV = 2 * 2;
    constexpr int NITEMS = 2 * I_IN + 2 * I_OUT + 2 * I_W1 + 24 * I_QKV;
    for (int it = gw; it < NITEMS; it += NGW) {
        int r = it;
        if (r < 2 * I_IN) { const int l = r / I_IN; tr_item(a.in[I_WIN] + (size_t)l * D * DIN, DIN, a.in[I_MIXG] + l * D, (bf16*)(ws + WS_WIN) + (size_t)l * DIN * D, D, 0, 0, r % I_IN, scr, lane); continue; } r -= 2 * I_IN;
        if (r < 2 * I_OUT) { const int l = r / I_OUT; tr_item(a.in[I_WOUT] + (size_t)l * D * D, D, nullptr, (bf16*)(ws + WS_WOUT) + (size_t)l * D * D, D, 0, 0, r % I_OUT, scr, lane); continue; } r -= 2 * I_OUT;
        if (r < I_W1) { absmax_item(a.in[I_DW1], DFF, a.in[I_FFNG], (unsigned*)(ws + WS_SWD), 0, r, lane); continue; } r -= I_W1;
        if (r < I_W1) { absmax_item(a.in[I_DW3], DFF, a.in[I_FFNG], (unsigned*)(ws + WS_SWD), 128, r, lane); continue; } r -= I_W1;
        { const int mtx = r / I_QKV, m = mtx / 8, lh = mtx % 8;
          tr_item(a.in[I_WQ + m] + (size_t)lh * 128 * 128, 128, nullptr, (bf16*)(ws + WS_WQ) + (size_t)mtx * 128 * 128, 128, 0, 0, r % I_QKV, scr, lane); }
    }
    { const int gt = gw * 64 + lane, NGT = NGW * 64; const u32x4 z = (u32x4){0u, 0u, 0u, 0u};
      for (int i = gt; i < 128 * (D / 16); i += NGT) { const int rr = i / (D / 16), c16 = i % (D / 16); const int row = 21 * 256 + (rr < 64 ? 64 + rr : 192 + (rr - 64)); *(u32x4*)((signed char*)(ws + WS_W13) + (size_t)row * D + c16 * 16) = z; }
      for (int i = gt; i < D * 4; i += NGT) { const int row = i / 4, c4 = i % 4; *(u32x4*)(ws + WS_W2 + (size_t)row * DFFP + DFF + c4 * 16) = z; } }
    for (int m0 = gw * 4; m0 < T; m0 += NGW * 4) {
        f32x4 v[4][4];
#pragma unroll
        for (int r = 0; r < 4; ++r) { const f32x4* xr = (const f32x4*)(a.in[I_X] + (size_t)(m0 + r) * D) + lane;
#pragma unroll
            for (int j = 0; j < 4; ++j) v[r][j] = xr[64 * j]; }
#pragma unroll
        for (int r = 0; r < 4; ++r) { float s_ = 0.f;
#pragma unroll
            for (int j = 0; j < 4; ++j) s_ += (v[r][j].x * v[r][j].x + v[r][j].y * v[r][j].y) + (v[r][j].z * v[r][j].z + v[r][j].w * v[r][j].w);
            s_ = wave_sum(s_);
            u32x2* o8 = (u32x2*)((bf16*)(ws + WS_XB) + (size_t)(m0 + r) * D) + lane;
#pragma unroll
            for (int j = 0; j < 4; ++j) { u32x2 w; w.x = pk2(v[r][j].x, v[r][j].y); w.y = pk2(v[r][j].z, v[r][j].w); o8[64 * j] = w; }
            if (lane < 4) ((float*)(ws + WS_SSQ))[(size_t)(m0 + r) * 4 + lane] = lane == 0 ? s_ : 0.f; }
    }
    for (int it = gw; it < 2 * 16; it += NGW) {
        const int l = it / 16, c = (it % 16) * 64 + lane, part = c >> 9, cc = c & 511, h = cc >> 7, d = cc & 127;
        const float* wif = a.in[I_WIF] + (size_t)l * 1536 * 8;
        float accj[8];
#pragma unroll
        for (int j = 0; j < 8; ++j) accj[j] = 0.f;
        if (part == 0) {
            const float* wq = a.in[I_WQ] + ((size_t)(l * 4 + h) * 128 + d) * 128; const float* wk = a.in[I_WK] + ((size_t)(l * 4 + h) * 128 + d) * 128;
            for (int e = 0; e < 128; ++e) { const float q = wq[e], k = wk[e]; const float* fq_ = wif + (size_t)(128 * h + e) * 8; const float* fk_ = wif + (size_t)(512 + 128 * h + e) * 8;
#pragma unroll
                for (int j = 0; j < 8; ++j) accj[j] += q * fq_[j] + k * fk_[j]; }
        } else {
            const float* wv = a.in[I_WV] + ((size_t)(l * 4 + h) * 128 + d) * 128;
            for (int e = 0; e < 128; ++e) { const float v = wv[e]; const float* fv_ = wif + (size_t)(1024 + 128 * h + e) * 8;
#pragma unroll
                for (int j = 0; j < 8; ++j) accj[j] += v * fv_[j]; }
        }
        bf16* wg = (bf16*)(ws + WS_WG) + (size_t)l * 16 * 1024;
#pragma unroll
        for (int j = 0; j < 8; ++j) { wg[j * 1024 + c] = (bf16)f2bf(accj[j]); wg[(8 + j) * 1024 + c] = 0; }
    }
    { const int gt = gw * 64 + lane, NGT = NGW * 64;
      for (int i = gt; i < 2 * 4 * 128 * 128; i += NGT) { const int ii = (i >> 7) & 127, jj = i & 127; const float v = ((ii >> 6) >= (jj >> 6)) ? a.in[I_WSP][i] : 0.f; ((bf16*)(ws + WS_WSP))[i] = (bf16)f2bf(v); } }
}
DI void absmax_item(const float* W, int N, const float* ks, unsigned* sw, int add, int item, int lane) {
    const int nblk = N / 64, kb = item / nblk, nb = item % nblk, k0 = 64 * kb, n0 = 64 * nb, kr = lane >> 4, nc = (lane & 15) * 4;
    f32x4 v[16];
#pragma unroll
    for (int i = 0; i < 16; ++i) v[i] = *(const f32x4*)(W + (size_t)(k0 + 4 * i + kr) * N + n0 + nc);
    f32x4 mx = (f32x4){0.f, 0.f, 0.f, 0.f};
#pragma unroll
    for (int i = 0; i < 16; ++i) { const f32x4 x = v[i] * ks[k0 + 4 * i + kr]; mx.x = fmaxf(mx.x, fabsf(x.x)); mx.y = fmaxf(mx.y, fabsf(x.y)); mx.z = fmaxf(mx.z, fabsf(x.z)); mx.w = fmaxf(mx.w, fabsf(x.w)); }
#pragma unroll
    for (int c = 0; c < 4; ++c) { mx[c] = fmaxf(mx[c], __shfl_xor(mx[c], 16)); mx[c] = fmaxf(mx[c], __shfl_xor(mx[c], 32)); }
    if (kr == 0) { unsigned* p = sw + ((n0 >> 7) << 8) + (n0 & 127) + add + nc;
#pragma unroll
        for (int c = 0; c < 4; ++c) atomicMax(p + c, __builtin_bit_cast(unsigned, mx[c])); }
}
DI void quant_item(const float* W, int N, const float* ks, const float* sw, signed char* dst, int add, int item, LAS float* scr, int lane) {
    const int nblk = N / 64, kb = item / nblk, nb = item % nblk, k0 = 64 * kb, n0 = 64 * nb, kr = lane >> 4, nc = (lane & 15) * 4;
    const int drow0 = ((n0 >> 7) << 8) + (n0 & 127) + add;
    f32x4 v[16];
#pragma unroll
    for (int i = 0; i < 16; ++i) v[i] = *(const f32x4*)(W + (size_t)(k0 + 4 * i + kr) * N + n0 + nc);
    const int kq = lane & 3, nl = lane >> 2;
    float inv[4];
#pragma unroll
    for (int j = 0; j < 4; ++j) { const float amax = sw[drow0 + nl + 16 * j]; inv[j] = amax > 0.f ? 127.0f / amax : 0.f; }
#pragma unroll
    for (int i = 0; i < 16; ++i) { const int kk = 4 * i + kr; const f32x4 x = v[i] * ks[k0 + kk]; LAS float* p = scr + kk * 65 + nc; p[0] = x.x; p[1] = x.y; p[2] = x.z; p[3] = x.w; }
    LDS_WAIT(); asm volatile("" ::: "memory");
#pragma unroll
    for (int j = 0; j < 4; ++j) { const int n = nl + 16 * j; u32x4 o;
#pragma unroll
        for (int d = 0; d < 4; ++d) { unsigned wd = 0;
#pragma unroll
            for (int b = 0; b < 4; ++b) { const float q = rintf(scr[(16 * kq + 4 * d + b) * 65 + n] * inv[j]); const int qi = (int)fminf(fmaxf(q, -127.f), 127.f); wd |= ((unsigned)qi & 0xffu) << (8 * b); }
            o[d] = wd; }
        *(u32x4*)(dst + (size_t)(drow0 + n) * D + k0 + 16 * kq) = o; }
    LDS_WAIT(); asm volatile("" ::: "memory");
}
DI void f8_item(const float* W, int N, const float* ks, float mul, unsigned char* dst, int ldk, bool il, int add, int item, LAS float* scr, int lane) {
    const int nblk = N / 64, kb = item / nblk, nb = item % nblk, k0 = 64 * kb, n0 = 64 * nb, kr = lane >> 4, nc = (lane & 15) * 4;
    const int drow0 = il ? ((n0 >> 7) << 8) + (n0 & 127) + add : n0;
    f32x4 v[16];
#pragma unroll
    for (int i = 0; i < 16; ++i) v[i] = *(const f32x4*)(W + (size_t)(k0 + 4 * i + kr) * N + n0 + nc);
    const int kq = lane & 3, nl = lane >> 2;
#pragma unroll
    for (int i = 0; i < 16; ++i) { const int kk = 4 * i + kr; const f32x4 x = v[i] * (ks ? ks[k0 + kk] * mul : mul); LAS float* p = scr + kk * 65 + nc; p[0] = x.x; p[1] = x.y; p[2] = x.z; p[3] = x.w; }
    LDS_WAIT(); asm volatile("" ::: "memory");
#pragma unroll
    for (int j = 0; j < 4; ++j) { const int n = nl + 16 * j; u32x4 o;
#pragma unroll
        for (int d = 0; d < 4; ++d) { const LAS float* q = scr + (16 * kq + 4 * d) * 65 + n;
            int wd = __builtin_amdgcn_cvt_pk_fp8_f32(q[0], q[65], 0, false); wd = __builtin_amdgcn_cvt_pk_fp8_f32(q[130], q[195], wd, true); o[d] = (unsigned)wd; }
        *(u32x4*)(dst + (size_t)(drow0 + n) * ldk + k0 + 16 * kq) = o; }
    LDS_WAIT(); asm volatile("" ::: "memory");
}
DI void moe_weights(const Frame& F, const Args& a) {
    LAS float* scr = (LAS float*)(F.lds + F.wave * 16896);
    const int gw = F.vcu * 8 + F.wave, NGW = F.G * 8, lane = F.lane;
    constexpr int I_1 = 16 * 56, I_2 = 56 * 16;
    constexpr int NITEMS = 16 * I_1 + 8 * I_2;
    for (int it = gw; it < NITEMS; it += NGW) {
        int r = it;
        if (r < 16 * I_1) { const int m = r / I_1, e = m >> 1, w3 = m & 1;
            f8_item(a.in[w3 ? I_MW3 : I_MW1] + (size_t)e * D * DFE, DFE, a.in[I_FFNG] + D, w3 ? -64.0f * 0.69314718056f : -64.0f * 1.44269504089f, F.ws + WS_MW13 + (size_t)e * (2 * DFE) * D, D, true, w3 ? 128 : 0, r % I_1, scr, lane); continue; }
        r -= 16 * I_1;
        { const int e = r / I_2; f8_item(a.in[I_MW2] + (size_t)e * DFE * D, D, nullptr, 64.0f, F.ws + WS_MW2 + (size_t)e * D * DFE, DFE, false, 0, r % I_2, scr, lane); }
    }
}
DI void dense_quant(const Frame& F, const Args& a) {
    LAS float* scr = (LAS float*)(F.lds + F.wave * 16896);
    const int gw = F.vcu * 8 + F.wave, NGW = F.G * 8, lane = F.lane;
    constexpr int I_1 = 16 * 43, I_W2 = 43 * 16;
    for (int it = gw; it < 2 * I_1 + I_W2; it += NGW) { const int w3 = it / I_1;
        if (it >= 2 * I_1) { f8_item(a.in[I_DW2], D, nullptr, 64.0f, F.ws + WS_W2, DFFP, false, 0, it - 2 * I_1, scr, lane); continue; }
        quant_item(a.in[w3 ? I_DW3 : I_DW1], DFF, a.in[I_FFNG], (const float*)(F.ws + WS_SWD), (signed char*)(F.ws + WS_W13), w3 ? 128 : 0, it % I_1, scr, lane); }
}
DI void rows_to_int8(const Frame& F) {
    unsigned char* ws = F.ws; const int gw = F.vcu * 8 + F.wave, NGW = F.G * 8, lane = F.lane;
    const bf16* xb = (const bf16*)(ws + WS_XB); const float* ssq = (const float*)(ws + WS_SSQ);
    u32x4 va[4], vb[4], na[4], nb[4];
#define RQ_LOAD(A_, B_, mbase) do { _Pragma("unroll") for (int r = 0; r < 4; ++r) { const u32x4* p_ = (const u32x4*)(xb + (size_t)((mbase) + r) * D) + lane; A_[r] = p_[0]; B_[r] = p_[64]; } } while (0)
    int m0 = gw * 4; if (m0 >= T) return;
    RQ_LOAD(va, vb, m0);
#pragma unroll 1
    for (;;) { const int mn = m0 + NGW * 4; const bool more = mn < T;
        if (more) RQ_LOAD(na, nb, mn);
#pragma unroll
        for (int r = 0; r < 4; ++r) { const int m = m0 + r; const float rs = rs_from(*(const f32x4*)(ssq + (size_t)m * 4));
            const unsigned wv[8] = {va[r].x, va[r].y, va[r].z, va[r].w, vb[r].x, vb[r].y, vb[r].z, vb[r].w};
            float am = 0.f;
#pragma unroll
            for (int i = 0; i < 8; ++i) am = fmaxf(am, fmaxf(fabsf(bflo(wv[i])), fabsf(bfhi(wv[i]))));
            am = wave_max(am) * rs; const float inv = am > 0.f ? 127.0f / am : 0.f, qs = rs * inv;
            unsigned o[4];
#pragma unroll
            for (int i = 0; i < 4; ++i) { const int q0 = (int)rintf(bflo(wv[2 * i]) * qs), q1 = (int)rintf(bfhi(wv[2 * i]) * qs), q2 = (int)rintf(bflo(wv[2 * i + 1]) * qs), q3 = (int)rintf(bfhi(wv[2 * i + 1]) * qs);
                o[i] = ((unsigned)q0 & 0xffu) | (((unsigned)q1 & 0xffu) << 8) | (((unsigned)q2 & 0xffu) << 16) | (((unsigned)q3 & 0xffu) << 24); }
            u32x2* d8 = (u32x2*)((signed char*)(ws + WS_XB8D) + (size_t)m * D) + lane;
            d8[0] = (u32x2){o[0], o[1]}; d8[64] = (u32x2){o[2], o[3]};
            if (lane == 0) ((float*)(ws + WS_SA))[m] = am * (1.0f / 127.0f); }
        if (!more) break;
        m0 = mn;
#pragma unroll
        for (int r = 0; r < 4; ++r) { va[r] = na[r]; vb[r] = nb[r]; } }
#undef RQ_LOAD
}

struct Mix { int l; const bf16* proj; const float *convw, *convb, *bif, *skip, *mhg, *gmvg, *bsp, *gmog; const bf16 *wg, *wq, *wk, *wv, *wsp; };
constexpr int L_XM = 0, L_XC = 18432, L_Q = 35840, L_K = 53248, L_KTW = 70656, L_VT = 89088, L_SM = 110592;
constexpr int L_RED = L_Q;
constexpr int S128 = 272, S64 = 144;
DI bf16x8 ldf(const LAS unsigned char* p) { return *(const LAS bf16x8*)p; }

DI void load_xm_conv(const Frame& F, const Mix& M, int t0, bool first, int h) {
    LAS unsigned char* lds = F.lds; const int tid = F.tid;
#pragma unroll
    for (int it = 0; it < 3; ++it) { const int p = tid + 512 * it; if (p < 67 * 16) { const int row = p >> 4, c16 = p & 15; u32x4 v = (u32x4){0u, 0u, 0u, 0u};
        if (!(first && row < 3)) v = *(const u32x4*)(M.proj + (size_t)(t0 - 3 + row) * DIN + h * 128 + c16 * 8);
        *(LAS u32x4*)(lds + L_XM + row * S128 + c16 * 16) = v; } }
    const int cg = tid & 15, ch = h * 128 + cg * 8;
    float cw[4][8], cb[8];
#pragma unroll
    for (int j = 0; j < 4; ++j) { const f32x4 a = *(const f32x4*)(M.convw + j * 512 + ch), b = *(const f32x4*)(M.convw + j * 512 + ch + 4);
        cw[j][0] = a.x; cw[j][1] = a.y; cw[j][2] = a.z; cw[j][3] = a.w; cw[j][4] = b.x; cw[j][5] = b.y; cw[j][6] = b.z; cw[j][7] = b.w; }
    { const f32x4 a = *(const f32x4*)(M.convb + ch), b = *(const f32x4*)(M.convb + ch + 4); cb[0] = a.x; cb[1] = a.y; cb[2] = a.z; cb[3] = a.w; cb[4] = b.x; cb[5] = b.y; cb[6] = b.z; cb[7] = b.w; }
    __syncthreads();
#pragma unroll
    for (int it = 0; it < 2; ++it) { const int t = (tid >> 4) + 32 * it; float y[8];
#pragma unroll
        for (int c = 0; c < 8; ++c) y[c] = cb[c];
#pragma unroll
        for (int j = 0; j < 4; ++j) { const u32x4 x = *(const LAS u32x4*)(lds + L_XM + (t + j) * S128 + cg * 16);
            y[0] += cw[j][0] * bflo(x.x); y[1] += cw[j][1] * bfhi(x.x); y[2] += cw[j][2] * bflo(x.y); y[3] += cw[j][3] * bfhi(x.y);
            y[4] += cw[j][4] * bflo(x.z); y[5] += cw[j][5] * bfhi(x.z); y[6] += cw[j][6] * bflo(x.w); y[7] += cw[j][7] * bfhi(x.w); }
        u32x4 o; o.x = pk2(siluf(y[0]), siluf(y[1])); o.y = pk2(siluf(y[2]), siluf(y[3])); o.z = pk2(siluf(y[4]), siluf(y[5])); o.w = pk2(siluf(y[6]), siluf(y[7]));
        *(LAS u32x4*)(lds + L_XC + t * S128 + cg * 16) = o; }
    __syncthreads();
}

DI void mlstm_local_unit(const Frame& F, const Mix& M, int u) {
    LAS unsigned char* lds = F.lds; const int tid = F.tid, lane = F.lane, w = F.wave, fr = lane & 15, fq = lane >> 4;
    const int t0 = u * CH; const bool first = (u % NCH) == 0; const int bb = u / NCH, cc = u % NCH;
    LAS float* IG = (LAS float*)(lds + L_SM); LAS float* BBs = IG + 256; LAS float* WSC = IG + 512;
    unsigned char* ws = F.ws;
    if (tid < 16 * 8) { const int row = 128 + (tid >> 3), c = tid & 7; const unsigned v = (row == 128) ? 0x3f803f80u : 0u; *(LAS u32x4*)(lds + L_VT + row * S64 + c * 16) = (u32x4){v, v, v, v}; }
    f32x4 accg[4];
#pragma unroll
    for (int tt = 0; tt < 4; ++tt) accg[tt] = (f32x4){0.f, 0.f, 0.f, 0.f};
    for (int h = 0; h < 4; ++h) {
        load_xm_conv(F, M, t0, first, h);
        const int cbase = (w < 4) ? (h * 128 + 32 * w) : (512 + h * 128 + 32 * (w - 4));
        const bf16x8 a = *(const bf16x8*)(M.wg + (size_t)fr * 1024 + cbase + 8 * fq);
#pragma unroll
        for (int tt = 0; tt < 4; ++tt) { const int t = 16 * tt + fr;
            const bf16x8 b = (w < 4) ? ldf(lds + L_XC + t * S128 + (32 * w + 8 * fq) * 2) : ldf(lds + L_XM + (t + 3) * S128 + (32 * (w - 4) + 8 * fq) * 2);
            accg[tt] = MFMA16(a, b, accg[tt]); }
        __syncthreads();
    }
    if (fq < 2) {
#pragma unroll
        for (int tt = 0; tt < 4; ++tt)
#pragma unroll
            for (int r = 0; r < 4; ++r) *(LAS float*)(lds + L_RED + ((w * 8 + 4 * fq + r) * 64 + 16 * tt + fr) * 4) = accg[tt][r];
    }
    __syncthreads();
    { float pre = M.bif[w];
#pragma unroll
      for (int ww = 0; ww < 8; ++ww) pre += *(const LAS float*)(lds + L_RED + ((ww * 8 + w) * 64 + lane) * 4);
      if (w < 4) IG[w * 64 + lane] = pre;
      else { float lf = fminf(pre, 0.f) - softplus_neg(fabsf(pre));
#pragma unroll
          for (int o = 1; o < 64; o <<= 1) { const float v = __shfl_up(lf, o); if (lane >= o) lf += v; }
          BBs[(w - 4) * 64 + lane] = lf; } }
    __syncthreads();
    if (w < 4) { const float bt = BBs[w * 64 + lane], g = IG[w * 64 + lane] - bt, gmax = wave_max(g), bend = BBs[w * 64 + 63];
        WSC[w * 64 + lane] = fexp(g - gmax);
        float* gb = (float*)(ws + WS_GB) + (size_t)(u * 4 + w) * 128; gb[lane] = bt; gb[64 + lane] = g;
        if (lane == 0) { float* sc = (float*)(ws + WS_SC) + ((size_t)(bb * 4 + w) * NCH + cc) * 2; sc[0] = bend; sc[1] = bend + gmax; } }
    __syncthreads();
    for (int h = 0; h < 4; ++h) {
        load_xm_conv(F, M, t0, first, h);
        const int lh = M.l * 4 + h;
        bf16x8 aq[4], bk[4], bv[4];
#pragma unroll
        for (int ks = 0; ks < 4; ++ks) { const size_t o = ((size_t)lh * 128 + 16 * w + fr) * 128 + 32 * ks + 8 * fq;
            aq[ks] = *(const bf16x8*)(M.wq + o); bk[ks] = *(const bf16x8*)(M.wk + o); bv[ks] = *(const bf16x8*)(M.wv + o); }
#pragma unroll
        for (int tt = 0; tt < 4; ++tt) {
            bf16x8 xcf[4], xmf[4];
#pragma unroll
            for (int ks = 0; ks < 4; ++ks) { xcf[ks] = ldf(lds + L_XC + (16 * tt + fr) * S128 + (32 * ks + 8 * fq) * 2); xmf[ks] = ldf(lds + L_XM + (16 * tt + fr + 3) * S128 + (32 * ks + 8 * fq) * 2); }
            f32x4 cq = (f32x4){0.f, 0.f, 0.f, 0.f}, ck = cq, ckt = cq, cv = cq;
#pragma unroll
            for (int ks = 0; ks < 4; ++ks) { cq = MFMA16(aq[ks], xcf[ks], cq); ck = MFMA16(bk[ks], xcf[ks], ck); ckt = MFMA16(xcf[ks], bk[ks], ckt); cv = MFMA16(xmf[ks], bv[ks], cv); }
            { const int t = 16 * tt + fr, e = 16 * w + 4 * fq;
              u32x2 o; o.x = pk2(cq[0] * 0.08838834764831845f, cq[1] * 0.08838834764831845f); o.y = pk2(cq[2] * 0.08838834764831845f, cq[3] * 0.08838834764831845f);
              *(LAS u32x2*)(lds + L_Q + t * S128 + e * 2) = o;
              o.x = pk2(ck[0], ck[1]); o.y = pk2(ck[2], ck[3]); *(LAS u32x2*)(lds + L_K + t * S128 + e * 2) = o; }
            { const int s = 16 * tt + 4 * fq, e = 16 * w + fr;
              const f32x4 wv = *(const LAS f32x4*)(WSC + h * 64 + s);
              u32x2 o; o.x = pk2(ckt[0] * wv.x, ckt[1] * wv.y); o.y = pk2(ckt[2] * wv.z, ckt[3] * wv.w); *(LAS u32x2*)(lds + L_KTW + e * S64 + s * 2) = o;
              o.x = pk2(cv[0], cv[1]); o.y = pk2(cv[2], cv[3]); *(LAS u32x2*)(lds + L_VT + e * S64 + s * 2) = o; }
        }
        __syncthreads();
        { bf16* qg = (bf16*)(ws + WS_QG) + (size_t)(u * 4 + h) * 8192; bf16* kg = (bf16*)(ws + WS_KG) + (size_t)(u * 4 + h) * 8192; bf16* vg = (bf16*)(ws + WS_VG) + (size_t)(u * 4 + h) * 8192;
#pragma unroll
          for (int i = 0; i < 2; ++i) { const int p = tid + 512 * i; { const int row = p >> 4, c16 = p & 15;
              *(u32x4*)(qg + row * 128 + c16 * 8) = *(const LAS u32x4*)(lds + L_Q + row * S128 + c16 * 16); *(u32x4*)(kg + row * 128 + c16 * 8) = *(const LAS u32x4*)(lds + L_K + row * S128 + c16 * 16); }
              { const int row = p >> 3, c8 = p & 7; *(u32x4*)(vg + row * 64 + c8 * 8) = *(const LAS u32x4*)(lds + L_VT + row * S64 + c8 * 16); } } }
        { bf16x8 ak[2];
#pragma unroll
          for (int ks = 0; ks < 2; ++ks) ak[ks] = ldf(lds + L_KTW + (16 * w + fr) * S64 + (32 * ks + 8 * fq) * 2);
          bf16* st = (bf16*)(ws + WS_ST) + (size_t)(u * 4 + h) * 144 * 128;
#pragma unroll
          for (int vt = 0; vt < 9; ++vt) { f32x4 c = (f32x4){0.f, 0.f, 0.f, 0.f};
#pragma unroll
              for (int ks = 0; ks < 2; ++ks) c = MFMA16(ak[ks], ldf(lds + L_VT + (16 * vt + fr) * S64 + (32 * ks + 8 * fq) * 2), c);
              u32x2 o; o.x = pk2(c[0], c[1]); o.y = pk2(c[2], c[3]); *(u32x2*)(st + (size_t)(16 * vt + fr) * 128 + 16 * w + 4 * fq) = o; } }
        __syncthreads();
    }
}

DI bf16x8 cat2(u32x2 a, u32x2 b) { u32x4 o; o.x = a.x; o.y = a.y; o.z = b.x; o.w = b.y; return __builtin_bit_cast(bf16x8, o); }
constexpr int L3_XC = 0, S3_XC = 1040;
constexpr int L3_XM = 66560;
constexpr int L3_VT = 85504, L3_VT2 = 106496;
constexpr int L3_SM = 127232;
#ifndef PROBE_P1
#define PROBE_P1 0
#endif
#ifndef PROBE_ST
#define PROBE_ST 0
#endif
#ifndef PROBE_A
#define PROBE_A 0
#endif
#ifndef PROBE_B
#define PROBE_B 0
#endif
#ifndef PROBE_P2
#define PROBE_P2 0
#endif
DI void mlstm_local3(const Frame& F, const Mix& M, int u) {
    LAS unsigned char* lds = F.lds; const int tid = F.tid, lane = F.lane, w = F.wave, fr = lane & 15, fq = lane >> 4;
    const int t0 = u * CH; const bool first = (u % NCH) == 0; const int bb = u / NCH, cc = u % NCH;
    LAS float* IG = (LAS float*)(lds + L3_SM); LAS float* BBs = IG + 256; LAS float* WSC = IG + 512;
    unsigned char* ws = F.ws;
    { const int b = tid >> 8, i = tid & 255, row = 128 + (i >> 4), c = i & 15; const unsigned v = (row == 128) ? 0x3f803f80u : 0u; LAS unsigned* p = (LAS unsigned*)(lds + (b ? L3_VT2 : L3_VT) + row * S64 + c * 8); p[0] = v; p[1] = v; }
    u32x4 xq[3];
#define L3_LOADX(hh) do { _Pragma("unroll") for (int it = 0; it < 3; ++it) { const int p = tid + 512 * it; xq[it] = (u32x4){0u, 0u, 0u, 0u}; if (p < 67 * 16) { const int row = p >> 4, c16 = p & 15; \
        if (!(first && row < 3)) xq[it] = *(const u32x4*)(M.proj + (size_t)(t0 - 3 + row) * DIN + (hh) * 128 + c16 * 8); } } } while (0)
#define L3_STOREX() do { _Pragma("unroll") for (int it = 0; it < 3; ++it) { const int p = tid + 512 * it; if (p < 67 * 16) { const int row = p >> 4, c16 = p & 15; *(LAS u32x4*)(lds + L3_XM + row * S128 + c16 * 16) = xq[it]; } } } while (0)
    f32x4 accg[4];
#pragma unroll 1
    for (int rp1 = 0; rp1 < 1 + PROBE_P1; ++rp1) {
    L3_LOADX(0);
#pragma unroll
    for (int tt = 0; tt < 4; ++tt) accg[tt] = (f32x4){0.f, 0.f, 0.f, 0.f};
#pragma unroll 1
    for (int h = 0; h < 4; ++h) {
        L3_STOREX();
        const int cg = tid & 15, ch = h * 128 + cg * 8;
        float cw[4][8], cb[8];
#pragma unroll
        for (int j = 0; j < 4; ++j) { const f32x4 a = *(const f32x4*)(M.convw + j * 512 + ch), b = *(const f32x4*)(M.convw + j * 512 + ch + 4);
            cw[j][0] = a.x; cw[j][1] = a.y; cw[j][2] = a.z; cw[j][3] = a.w; cw[j][4] = b.x; cw[j][5] = b.y; cw[j][6] = b.z; cw[j][7] = b.w; }
        { const f32x4 a = *(const f32x4*)(M.convb + ch), b = *(const f32x4*)(M.convb + ch + 4); cb[0] = a.x; cb[1] = a.y; cb[2] = a.z; cb[3] = a.w; cb[4] = b.x; cb[5] = b.y; cb[6] = b.z; cb[7] = b.w; }
        __syncthreads();
        if (h < 3) L3_LOADX(h + 1);
        bf16* xcg = (bf16*)(ws + WS_XCG) + ((size_t)u * 4 + h) * 8192;
#pragma unroll 1
        for (int it = 0; it < 2; ++it) { const int t = (tid >> 4) + 32 * it; float y[8];
#pragma unroll
            for (int c = 0; c < 8; ++c) y[c] = cb[c];
#pragma unroll
            for (int j = 0; j < 4; ++j) { const u32x4 x = *(const LAS u32x4*)(lds + L3_XM + (t + j) * S128 + cg * 16);
                y[0] += cw[j][0] * bflo(x.x); y[1] += cw[j][1] * bfhi(x.x); y[2] += cw[j][2] * bflo(x.y); y[3] += cw[j][3] * bfhi(x.y);
                y[4] += cw[j][4] * bflo(x.z); y[5] += cw[j][5] * bfhi(x.z); y[6] += cw[j][6] * bflo(x.w); y[7] += cw[j][7] * bfhi(x.w); }
            u32x4 o; o.x = pk2(siluf(y[0]), siluf(y[1])); o.y = pk2(siluf(y[2]), siluf(y[3])); o.z = pk2(siluf(y[4]), siluf(y[5])); o.w = pk2(siluf(y[6]), siluf(y[7]));
            *(LAS u32x4*)(lds + L3_XC + t * S3_XC + (h * 128 + cg * 8) * 2) = o;
            *(u32x4*)(xcg + (size_t)t * 128 + cg * 8) = o; }
        const int cbase = (w < 4) ? (h * 128 + 32 * w) : (512 + h * 128 + 32 * (w - 4));
        const bf16x8 ag = *(const bf16x8*)(M.wg + (size_t)fr * 1024 + cbase + 8 * fq);
        __syncthreads();
#pragma unroll
        for (int tt = 0; tt < 4; ++tt) { const int t = 16 * tt + fr;
            const bf16x8 b = (w < 4) ? ldf(lds + L3_XC + t * S3_XC + (h * 128 + 32 * w + 8 * fq) * 2) : ldf(lds + L3_XM + (t + 3) * S128 + (32 * (w - 4) + 8 * fq) * 2);
            accg[tt] = MFMA16(ag, b, accg[tt]); }
        __syncthreads();
    }
    }
    if (fq < 2) {
#pragma unroll
        for (int tt = 0; tt < 4; ++tt)
#pragma unroll
            for (int r = 0; r < 4; ++r) *(LAS float*)(lds + L3_VT2 + ((w * 8 + 4 * fq + r) * 64 + 16 * tt + fr) * 4) = accg[tt][r];
    }
    __syncthreads();
    { float pre = M.bif[w];
#pragma unroll
      for (int ww = 0; ww < 8; ++ww) pre += *(const LAS float*)(lds + L3_VT2 + ((ww * 8 + w) * 64 + lane) * 4);
      if (w < 4) IG[w * 64 + lane] = pre;
      else { float lf = fminf(pre, 0.f) - softplus_neg(fabsf(pre));
#pragma unroll
          for (int o = 1; o < 64; o <<= 1) { const float v = __shfl_up(lf, o); if (lane >= o) lf += v; }
          BBs[(w - 4) * 64 + lane] = lf; } }
    __syncthreads();
    if (w < 4) { const float bt = BBs[w * 64 + lane], g = IG[w * 64 + lane] - bt, gmax = wave_max(g), bend = BBs[w * 64 + 63];
        WSC[w * 64 + lane] = fexp(g - gmax);
        float* gb = (float*)(ws + WS_GB) + (size_t)(u * 4 + w) * 128; gb[lane] = bt; gb[64 + lane] = g;
        if (lane == 0) { float* sc = (float*)(ws + WS_SC) + ((size_t)(bb * 4 + w) * NCH + cc) * 2; sc[0] = bend; sc[1] = bend + gmax; } }
    __syncthreads();
    bf16x8 aq[4], bk[4], bv[4], nq[4], nk[4], nv[4];
#define L3_LOADW(hh, Q_, K_, V_) do { _Pragma("unroll") for (int ks = 0; ks < 4; ++ks) { const size_t o_ = ((size_t)(M.l * 4 + (hh)) * 128 + 16 * w + fr) * 128 + 32 * ks + 8 * fq; \
        Q_[ks] = *(const bf16x8*)(M.wq + o_); K_[ks] = *(const bf16x8*)(M.wk + o_); V_[ks] = *(const bf16x8*)(M.wv + o_); } } while (0)
    L3_LOADW(0, aq, bk, bv);
    L3_LOADX(0);
#pragma unroll 1
    for (int h = 0; h < 4; ++h) {
        L3_STOREX(); __syncthreads();
        const size_t uh = (size_t)u * 4 + h;
        LAS unsigned char* VT = lds + ((h & 1) ? L3_VT2 : L3_VT);
        bf16* qg = (bf16*)(ws + WS_QG) + uh * 8192; bf16* kg = (bf16*)(ws + WS_KG) + uh * 8192; bf16* vg = (bf16*)(ws + WS_VG) + uh * 8192; bf16* st = (bf16*)(ws + WS_ST) + uh * 144 * 128;
        u32x2 KP[4], QO[4], KO[4], VO[4];
#pragma unroll 1
        for (int _pa = 0; _pa < 1 + PROBE_A; ++_pa) {
#pragma unroll
        for (int tt = 0; tt < 4; ++tt) {
            bf16x8 xcf[4], xmf[4];
#pragma unroll
            for (int ks = 0; ks < 4; ++ks) { xcf[ks] = ldf(lds + L3_XC + (16 * tt + fr) * S3_XC + (h * 128 + 32 * ks + 8 * fq) * 2); xmf[ks] = ldf(lds + L3_XM + (16 * tt + fr + 3) * S128 + (32 * ks + 8 * fq) * 2); }
            f32x4 cq = (f32x4){0.f, 0.f, 0.f, 0.f}, ck = cq, ckt = cq, cv = cq;
#pragma unroll
            for (int ks = 0; ks < 4; ++ks) { cq = MFMA16(aq[ks], xcf[ks], cq); ck = MFMA16(bk[ks], xcf[ks], ck); ckt = MFMA16(xcf[ks], bk[ks], ckt); cv = MFMA16(xmf[ks], bv[ks], cv); }
            QO[tt].x = pk2(cq[0] * 0.08838834764831845f, cq[1] * 0.08838834764831845f); QO[tt].y = pk2(cq[2] * 0.08838834764831845f, cq[3] * 0.08838834764831845f);
            KO[tt].x = pk2(ck[0], ck[1]); KO[tt].y = pk2(ck[2], ck[3]);
            { const int s = 16 * tt + 4 * fq, e = 16 * w + fr;
              const f32x4 wv = *(const LAS f32x4*)(WSC + h * 64 + s);
              KP[tt].x = pk2(ckt[0] * wv.x, ckt[1] * wv.y); KP[tt].y = pk2(ckt[2] * wv.z, ckt[3] * wv.w);
              VO[tt].x = pk2(cv[0], cv[1]); VO[tt].y = pk2(cv[2], cv[3]); *(LAS u32x2*)(VT + e * S64 + s * 2) = VO[tt]; }
        }
        }
        if (h < 3) { L3_LOADX(h + 1); L3_LOADW(h + 1, nq, nk, nv); }
#pragma unroll
        for (int tt = 0; tt < 4; ++tt) { const size_t off = (size_t)((tt * 8 + w) * 256 + fr * 16 + 4 * fq);
            for (int _r = 0; _r < 1 + PROBE_ST; ++_r) { *(u32x2*)(qg + off) = QO[tt]; *(u32x2*)(kg + off) = KO[tt]; *(u32x2*)(vg + (size_t)((w * 4 + tt) * 256 + fr * 16 + 4 * fq)) = VO[tt]; asm volatile("" ::: "memory"); } }
        __syncthreads();
#pragma unroll 1
        for (int _pb = 0; _pb < 1 + PROBE_B; ++_pb)
        { const bf16x8 ak0 = cat2(KP[0], KP[1]), ak1 = cat2(KP[2], KP[3]);
#pragma unroll
          for (int vt = 0; vt < 9; ++vt) { const LAS unsigned char* vr = VT + (16 * vt + fr) * S64 + 8 * fq;
              const u32x2 v0 = *(const LAS u32x2*)(vr), v1 = *(const LAS u32x2*)(vr + 32), v2 = *(const LAS u32x2*)(vr + 64), v3 = *(const LAS u32x2*)(vr + 96);
              f32x4 c = (f32x4){0.f, 0.f, 0.f, 0.f}; c = MFMA16(ak0, cat2(v0, v1), c); c = MFMA16(ak1, cat2(v2, v3), c);
              u32x2 o; o.x = pk2(c[0], c[1]); o.y = pk2(c[2], c[3]); for (int _r = 0; _r < 1 + PROBE_ST; ++_r) { *(u32x2*)(st + (size_t)((vt * 8 + w) * 256 + fr * 16 + 4 * fq)) = o; asm volatile("" ::: "memory"); } } }
#pragma unroll
        for (int ks = 0; ks < 4; ++ks) { aq[ks] = nq[ks]; bk[ks] = nk[ks]; bv[ks] = nv[ks]; }
    }
    __syncthreads();
#undef L3_LOADW
#undef L3_LOADX
#undef L3_STOREX
}

constexpr int L_VNT = 0;
constexpr int L_MU = 36864;
DI void gmlp_unit(const Frame& F, const Mix& M, int ub) {
    LAS unsigned char* lds = F.lds; const int tid = F.tid, lane = F.lane, w = F.wave, fr = lane & 15, fq = lane >> 4;
    const int t0 = ub * 128;
    LAS float* MU = (LAS float*)(lds + L_MU); LAS float* RS = MU + 128; LAS float* GOL = MU + 256; LAS float* GVL = MU + 768;
    GOL[tid] = M.gmog[tid]; GVL[tid] = M.gmvg[tid];
    if (tid < 128) { const f32x4* p = (const f32x4*)((const float*)(F.ws + WS_VST) + (size_t)(t0 + tid) * 16); const f32x4 a = p[0], b = p[1], c = p[2], d = p[3];
        const float s1 = (a.x + a.z) + (b.x + b.z) + (c.x + c.z) + (d.x + d.z), s2 = (a.y + a.w) + (b.y + b.w) + (c.y + c.w) + (d.y + d.w);
        const float mu = s1 * (1.0f / 512.0f), var = fmaxf(s2 * (1.0f / 512.0f) - mu * mu, 0.f); MU[tid] = mu; RS[tid] = 1.0f / sqrtf(var + EPS); }
    float ss = 0.f;
    const int i_tok = 16 * w + fr;
    bf16* py = (bf16*)(F.ws + WS_Y) + (size_t)(t0 + i_tok) * D + 512 + 8 * fq;
    const int j = tid & 127, cq = tid >> 7;
    u32x4 xv[4]; bf16x8 bwn[4]; u32x4 ugn[4]; float biasn;
#define GM_ISSUE(g) do { const bf16* pv_ = M.proj + (size_t)(t0 + j) * DIN + 1536 + (g) * 128 + 32 * cq; _Pragma("unroll") for (int i = 0; i < 4; ++i) xv[i] = *(const u32x4*)(pv_ + 8 * i); \
        const bf16* pw_ = M.wsp + ((size_t)(M.l * 4 + (g)) * 128 + i_tok) * 128 + 8 * fq; _Pragma("unroll") for (int ks = 0; ks < 4; ++ks) bwn[ks] = *(const bf16x8*)(pw_ + 32 * ks); \
        biasn = M.bsp[(g) * 128 + i_tok]; const bf16* pu_ = M.proj + (size_t)(t0 + i_tok) * DIN + 1024 + (g) * 128 + 8 * fq; _Pragma("unroll") for (int p = 0; p < 4; ++p) ugn[p] = *(const u32x4*)(pu_ + 32 * p); } while (0)
    GM_ISSUE(0);
    __syncthreads();
#pragma unroll 1
    for (int g = 0; g < 4; ++g) {
        { const float mu = MU[j], rs = RS[j];
#pragma unroll
          for (int i = 0; i < 4; ++i) { const int c0 = 32 * cq + 8 * i; const u32x4 x = xv[i];
              const f32x4 ga = *(const LAS f32x4*)(GVL + g * 128 + c0), gb = *(const LAS f32x4*)(GVL + g * 128 + c0 + 4);
              const float v[8] = {(bflo(x.x) - mu) * rs * ga.x, (bfhi(x.x) - mu) * rs * ga.y, (bflo(x.y) - mu) * rs * ga.z, (bfhi(x.y) - mu) * rs * ga.w,
                                  (bflo(x.z) - mu) * rs * gb.x, (bfhi(x.z) - mu) * rs * gb.y, (bflo(x.w) - mu) * rs * gb.z, (bfhi(x.w) - mu) * rs * gb.w};
#pragma unroll
              for (int c = 0; c < 8; ++c) *(LAS bf16*)(lds + L_VNT + (32 * cq + 16 * (c >> 2) + 4 * i + (c & 3)) * S128 + j * 2) = (bf16)f2bf(v[c]); } }
        bf16x8 bw[4]; u32x4 ugv[4]; const float bias = biasn;
#pragma unroll
        for (int ks = 0; ks < 4; ++ks) bw[ks] = bwn[ks];
#pragma unroll
        for (int p = 0; p < 4; ++p) ugv[p] = ugn[p];
        __syncthreads();
        if (g < 3) GM_ISSUE(g + 1);
#pragma unroll
        for (int p = 0; p < 4; ++p) { f32x4 ce = (f32x4){0.f, 0.f, 0.f, 0.f}, co = ce;
#pragma unroll
            for (int ks = 0; ks < 4; ++ks) { ce = MFMA16(ldf(lds + L_VNT + (32 * p + fr) * S128 + (32 * ks + 8 * fq) * 2), bw[ks], ce); co = MFMA16(ldf(lds + L_VNT + (32 * p + 16 + fr) * S128 + (32 * ks + 8 * fq) * 2), bw[ks], co); }
            const u32x4 ug = ugv[p];
            u32x4 o; o.x = pk2(bflo(ug.x) * (ce[0] + bias), bfhi(ug.x) * (ce[1] + bias)); o.y = pk2(bflo(ug.y) * (ce[2] + bias), bfhi(ug.y) * (ce[3] + bias));
            o.z = pk2(bflo(ug.z) * (co[0] + bias), bfhi(ug.z) * (co[1] + bias)); o.w = pk2(bflo(ug.w) * (co[2] + bias), bfhi(ug.w) * (co[3] + bias));
#pragma unroll
            for (int q = 0; q < 4; ++q) { const float z0 = bflo(o[q]), z1 = bfhi(o[q]); ss += z0 * z0 + z1 * z1; }
            *(u32x4*)(py + g * 128 + 32 * p) = o; }
        __syncthreads();
    }
#undef GM_ISSUE
    ss += __shfl_xor(ss, 16); ss += __shfl_xor(ss, 32);
    const float r = 1.0f / sqrtf(ss * (1.0f / 512.0f) + EPS);
    VM_WAIT();
    u32x4 yv[4][4];
#pragma unroll
    for (int g = 0; g < 4; ++g)
#pragma unroll
        for (int p = 0; p < 4; ++p) yv[g][p] = *(const u32x4*)(py + g * 128 + 32 * p);
#pragma unroll
    for (int g = 0; g < 4; ++g)
#pragma unroll
        for (int p = 0; p < 4; ++p) { const f32x4 g0 = *(const LAS f32x4*)(GOL + g * 128 + 32 * p + 8 * fq), g1 = *(const LAS f32x4*)(GOL + g * 128 + 32 * p + 8 * fq + 4); const u32x4 x = yv[g][p];
            u32x4 o; o.x = pk2(bflo(x.x) * r * g0.x, bfhi(x.x) * r * g0.y); o.y = pk2(bflo(x.y) * r * g0.z, bfhi(x.y) * r * g0.w); o.z = pk2(bflo(x.z) * r * g1.x, bfhi(x.z) * r * g1.y); o.w = pk2(bflo(x.w) * r * g1.z, bfhi(x.w) * r * g1.w);
            *(u32x4*)(py + g * 128 + 32 * p) = o; }
}

DI void mlstm_scan(const Frame& F) {
    unsigned char* ws = F.ws;
    const int gt = (F.vcu * 8 + F.wave) * 64 + F.lane, NGT = F.G * 512;
    constexpr int PER_BH = 128 * 64;
    for (int it = gt; it < 16 * PER_BH; it += NGT) {
        const int bh = it / PER_BH, rem = it % PER_BH, b = bh >> 2, h = bh & 3;
        const bool extra = rem < 64;
        const int XOFF = (64 + (rem >> 3)) * 128 + (rem & 7) - rem;
        const float* sc = (const float*)(ws + WS_SC) + (size_t)bh * NCH * 2;
        unsigned* st = (unsigned*)((bf16*)(ws + WS_ST) + ((size_t)(b * NCH) * 4 + h) * 144 * 128) + rem;
        float* mp = (float*)(ws + WS_MP);
        float c0 = 0.f, c1 = 0.f, n0 = 0.f, n1 = 0.f, m = 0.f;
        unsigned x[16], y[16], xn[16], yn[16];
#pragma unroll
        for (int j = 0; j < 16; ++j) { x[j] = st[(size_t)j * 36864]; y[j] = extra ? st[(size_t)j * 36864 + XOFF] : 0u; }
#pragma unroll 1
        for (int cb = 0; cb < NCH; cb += 16) {
            const int nb = (cb + 16 < NCH) ? cb + 16 : cb;
#pragma unroll
            for (int j = 0; j < 16; ++j) { xn[j] = st[(size_t)(nb + j) * 36864]; yn[j] = extra ? st[(size_t)(nb + j) * 36864 + XOFF] : 0u; }
#pragma unroll
            for (int j = 0; j < 16; ++j) { const int c = cb + j; const float bend = sc[2 * c], mloc = sc[2 * c + 1];
                const float mn = fmaxf(bend + m, mloc), a = fexp(bend + m - mn), s = fexp(mloc - mn);
                const unsigned oc = pk2(c0, c1), on = pk2(n0, n1); const float om = m;
                c0 = a * c0 + s * bflo(x[j]); c1 = a * c1 + s * bfhi(x[j]); n0 = a * n0 + s * bflo(y[j]); n1 = a * n1 + s * bfhi(y[j]); m = mn;
                x[j] = oc; y[j] = on; if (rem == 0) mp[(size_t)(b * NCH + c) * 4 + h] = om; }
#pragma unroll
            for (int j = 0; j < 16; ++j) { st[(size_t)(cb + j) * 36864] = x[j]; if (extra) st[(size_t)(cb + j) * 36864 + XOFF] = y[j]; }
#pragma unroll
            for (int j = 0; j < 16; ++j) { x[j] = xn[j]; y[j] = yn[j]; }
        }
    }
}

constexpr int L_CP = 70656;
constexpr int L_VT_D = 109824, L_P = 0, L_SD = 9216, L_HM = L_Q;
constexpr int L_PAR = 12288;
DI void mlstm_out_stage_params(const Frame& F, const Mix& M) { LAS float* P = (LAS float*)(F.lds + L_PAR); P[F.tid] = M.mhg[F.tid]; P[512 + F.tid] = M.skip[F.tid]; }
struct OutLoads { u32x4 q[2], k[2], v[2], c[5], xc[2]; u32x2 og[4]; float bt, g, mprev; };
DI void mlstm_out_issue(const Frame& F, const Mix& M, int u, int h, OutLoads& R) {
    const int tid = F.tid, lane = F.lane, w = F.wave, fr = lane & 15, fq = lane >> 4; unsigned char* ws = F.ws;
    const size_t uh = (size_t)u * 4 + h; const int t0 = u * CH;
    const bf16* qg = (const bf16*)(ws + WS_QG) + uh * 8192; const bf16* kg = (const bf16*)(ws + WS_KG) + uh * 8192; const bf16* vg = (const bf16*)(ws + WS_VG) + uh * 8192;
    const bf16* cp = (const bf16*)(ws + WS_ST) + uh * 144 * 128;
#pragma unroll
    for (int i = 0; i < 2; ++i) { const int p = tid + 512 * i; R.q[i] = *(const u32x4*)(qg + p * 8); R.k[i] = *(const u32x4*)(kg + p * 8); R.v[i] = *(const u32x4*)(vg + p * 8); }
#pragma unroll
    for (int i = 0; i < 5; ++i) { const int p = tid + 512 * i; R.c[i] = (u32x4){0u, 0u, 0u, 0u}; if (p < 72 * 32) R.c[i] = *(const u32x4*)(cp + p * 8); }
    { const int tt = w & 3, vh = w >> 2, t = 16 * tt + fr; const bf16* og = M.proj + (size_t)(t0 + t) * DIN + 512 + h * 128 + 64 * vh + 4 * fq;
#pragma unroll
      for (int j = 0; j < 4; ++j) R.og[j] = *(const u32x2*)(og + 16 * j); }
    { const int t = tid >> 3, v0 = 16 * (tid & 7); const bf16* xcp = (const bf16*)(ws + WS_XCG) + uh * 8192 + (size_t)t * 128 + v0; R.xc[0] = *(const u32x4*)(xcp); R.xc[1] = *(const u32x4*)(xcp + 8); }
    R.bt = 0.f; R.g = 0.f; R.mprev = 0.f;
    if (w == 0) { const float* gb = (const float*)(ws + WS_GB) + uh * 128; R.bt = gb[lane]; R.g = gb[64 + lane]; R.mprev = ((const float*)(ws + WS_MP))[uh]; }
}
DI void mlstm_out_item(const Frame& F, const Mix& M, int u, int h, const OutLoads& R, bool has_next, int un, int hn, OutLoads& RN) {
    LAS unsigned char* lds = F.lds; const int tid = F.tid, lane = F.lane, w = F.wave, fr = lane & 15, fq = lane >> 4;
    const int t0 = u * CH;
    LAS float* AT = (LAS float*)(lds + L_SD); LAS float* DF = AT + 64; LAS float* EG = AT + 128; LAS float* MT = AT + 448;
    const LAS float* PAR = (const LAS float*)(lds + L_PAR);
    bf16* Y = (bf16*)(F.ws + WS_Y);
#pragma unroll
    for (int i = 0; i < 2; ++i) { const int p = tid + 512 * i, tile = p >> 5, rem = p & 31;
        { const int row = 16 * (tile >> 3) + (rem >> 1), col = 16 * (tile & 7) + 8 * (rem & 1);
          *(LAS u32x4*)(lds + L_Q + row * S128 + col * 2) = R.q[i]; *(LAS u32x4*)(lds + L_K + row * S128 + col * 2) = R.k[i]; }
        { const int row = 16 * (tile >> 2) + (rem >> 1), col = 16 * (tile & 3) + 8 * (rem & 1);
          *(LAS u32x4*)(lds + L_VT_D + row * S64 + col * 2) = R.v[i]; } }
#pragma unroll
    for (int i = 0; i < 5; ++i) { const int p = tid + 512 * i; if (p < 72 * 32) { const int tile = p >> 5, rem = p & 31, row = 16 * (tile >> 3) + (rem >> 1), col = 16 * (tile & 7) + 8 * (rem & 1);
        *(LAS u32x4*)(lds + L_CP + row * S128 + col * 2) = R.c[i]; } }
    if (tid < 16 * 8) { const int row = 128 + (tid >> 3), c = tid & 7; const unsigned v = (row == 128) ? 0x3f803f80u : 0u; LAS unsigned* p = (LAS unsigned*)(lds + L_VT_D + row * S64 + c * 16); p[0] = v; p[1] = v; p[2] = v; p[3] = v; }
    if (w == 0) { float cm = R.g;
#pragma unroll
        for (int o = 1; o < 64; o <<= 1) { const float v = __shfl_up(cm, o); if (lane >= o) cm = fmaxf(cm, v); }
        const float Mt = fmaxf(R.mprev, cm);
        MT[lane] = Mt; AT[lane] = fexp(R.mprev - Mt); DF[lane] = fexp(-(R.bt + Mt)); EG[lane] = R.g; }
    u32x2 og[4]; u32x4 xc[2];
#pragma unroll
    for (int j = 0; j < 4; ++j) og[j] = R.og[j];
    xc[0] = R.xc[0]; xc[1] = R.xc[1];
    __syncthreads();
    if (has_next) mlstm_out_issue(F, M, un, hn, RN);
    { const int tt = w & 3, t = 16 * tt + fr; const float Mt = MT[t];
      bf16x8 bq[4];
#pragma unroll
      for (int ks = 0; ks < 4; ++ks) bq[ks] = ldf(lds + L_Q + t * S128 + (32 * ks + 8 * fq) * 2);
#pragma unroll
      for (int j = 0; j < 2; ++j) { const int st = 2 * (w >> 2) + j; f32x4 c = (f32x4){0.f, 0.f, 0.f, 0.f};
          if (st <= tt) {
#pragma unroll
              for (int ks = 0; ks < 4; ++ks) c = MFMA16(ldf(lds + L_K + (16 * st + fr) * S128 + (32 * ks + 8 * fq) * 2), bq[ks], c); }
          const int s0 = 16 * st + 4 * fq; const f32x4 gs = *(const LAS f32x4*)(EG + s0);
          float p[4];
#pragma unroll
          for (int r = 0; r < 4; ++r) p[r] = (s0 + r <= t) ? c[r] * fexp(gs[r] - Mt) : 0.f;
          u32x2 o; o.x = pk2(p[0], p[1]); o.y = pk2(p[2], p[3]); *(LAS u32x2*)(lds + L_P + t * S64 + s0 * 2) = o; } }
    __syncthreads();
    { const int tt = w & 3, vh = w >> 2, t = 16 * tt + fr;
      bf16x8 bp[2], bq[4];
#pragma unroll
      for (int ks = 0; ks < 2; ++ks) bp[ks] = ldf(lds + L_P + t * S64 + (32 * ks + 8 * fq) * 2);
#pragma unroll
      for (int ks = 0; ks < 4; ++ks) bq[ks] = ldf(lds + L_Q + t * S128 + (32 * ks + 8 * fq) * 2);
      f32x4 ci[5], cx[5];
#pragma unroll
      for (int j = 0; j < 5; ++j) { const int vt = (j < 4) ? 4 * vh + j : 8; ci[j] = (f32x4){0.f, 0.f, 0.f, 0.f}; cx[j] = ci[j];
#pragma unroll
          for (int ks = 0; ks < 2; ++ks) ci[j] = MFMA16(ldf(lds + L_VT_D + (16 * vt + fr) * S64 + (32 * ks + 8 * fq) * 2), bp[ks], ci[j]);
#pragma unroll
          for (int ks = 0; ks < 4; ++ks) cx[j] = MFMA16(ldf(lds + L_CP + (16 * vt + fr) * S128 + (32 * ks + 8 * fq) * 2), bq[ks], cx[j]); }
      const float at = AT[t];
      float den = ci[4][0] + at * cx[4][0];
      den = __shfl(den, fr);
      den = fmaxf(fabsf(den), DF[t]);
      const float rden = 1.0f / den;
      __syncthreads();
#pragma unroll
      for (int j = 0; j < 4; ++j) { const float o[4] = {bflo(og[j].x), bfhi(og[j].x), bflo(og[j].y), bfhi(og[j].y)}; f32x4 x;
#pragma unroll
          for (int r = 0; r < 4; ++r) x[r] = o[r] * (ci[j][r] + at * cx[j][r]) * rden;
          *(LAS f32x4*)(lds + L_HM + (t * 132 + 64 * vh + 16 * j + 4 * fq) * 4) = x; } }
    __syncthreads();
    { const int t = tid >> 3, part = tid & 7, v0 = 16 * part;
      float s1 = 0.f, s2 = 0.f;
#pragma unroll
      for (int i = 0; i < 4; ++i) { const f32x4 x = *(const LAS f32x4*)(lds + L_HM + (t * 132 + v0 + 4 * i) * 4); s1 += (x.x + x.y) + (x.z + x.w); s2 += (x.x * x.x + x.y * x.y) + (x.z * x.z + x.w * x.w); }
      s1 += __shfl_xor(s1, 1); s1 += __shfl_xor(s1, 2); s1 += __shfl_xor(s1, 4); s2 += __shfl_xor(s2, 1); s2 += __shfl_xor(s2, 2); s2 += __shfl_xor(s2, 4);
      const float mu = s1 * (1.0f / 128.0f), var = fmaxf(s2 * (1.0f / 128.0f) - mu * mu, 0.f), rstd = __builtin_amdgcn_rsqf(var + EPS);
#pragma unroll
      for (int half = 0; half < 2; ++half) { const int c0 = h * 128 + v0 + 8 * half; const u32x4 xcv = xc[half];
          const f32x4 xa = *(const LAS f32x4*)(lds + L_HM + (t * 132 + v0 + 8 * half) * 4), xb = *(const LAS f32x4*)(lds + L_HM + (t * 132 + v0 + 8 * half + 4) * 4);
          const f32x4 ga = *(const LAS f32x4*)(PAR + c0), gb = *(const LAS f32x4*)(PAR + c0 + 4), sa = *(const LAS f32x4*)(PAR + 512 + c0), sb = *(const LAS f32x4*)(PAR + 512 + c0 + 4);
          u32x4 o; o.x = pk2((xa.x - mu) * rstd * ga.x + sa.x * bflo(xcv.x), (xa.y - mu) * rstd * ga.y + sa.y * bfhi(xcv.x));
          o.y = pk2((xa.z - mu) * rstd * ga.z + sa.z * bflo(xcv.y), (xa.w - mu) * rstd * ga.w + sa.w * bfhi(xcv.y));
          o.z = pk2((xb.x - mu) * rstd * gb.x + sb.x * bflo(xcv.z), (xb.y - mu) * rstd * gb.y + sb.y * bfhi(xcv.z));
          o.w = pk2((xb.z - mu) * rstd * gb.z + sb.z * bflo(xcv.w), (xb.w - mu) * rstd * gb.w + sb.w * bfhi(xcv.w));
          *(u32x4*)(Y + (size_t)(t0 + t) * D + c0) = o; } }
    __syncthreads();
}
DI void mlstm_out_phase(const Frame& F, const Mix& M) {
    mlstm_out_stage_params(F, M);
    int u = F.vcu, h = 0;
    if (u >= NU) return;
    OutLoads R, RN;
    mlstm_out_issue(F, M, u, h, R);
#pragma unroll 1
    for (;;) {
        int un = u, hn = h + 1; if (hn == 4) { hn = 0; un = u + F.G; } const bool hn_ok = un < NU;
        mlstm_out_item(F, M, u, h, R, hn_ok, un, hn, RN);
        if (!hn_ok) break;
        u = un; h = hn; R = RN;
    }
}

DI void route_tokens(const Frame& F, const Args& a) {
    LAS unsigned char* lds = F.lds; const int tid = F.tid, lane = F.lane, w = F.wave, ti = lane & 15, kq = lane >> 4;
    unsigned char* ws = F.ws;
    constexpr int WP = 2048 + 64;
    LAS unsigned char* WH = lds; LAS unsigned char* WL = lds + 8 * WP;
    LAS int* CNTL = (LAS int*)(lds + 16 * WP);
    const bf16* xb = (const bf16*)(ws + WS_XB);
    for (int i = tid; i < 8 * 1024; i += 512) { const int e = i >> 10, c = i & 1023; const float wv = a.in[I_ROUTER][c * 8 + e] * a.in[I_FFNG][D + c];
        const unsigned hi = f2bf(wv), lo = f2bf(wv - __builtin_bit_cast(float, hi << 16));
        *(LAS bf16*)(WH + e * WP + c * 2) = (bf16)hi; *(LAS bf16*)(WL + e * WP + c * 2) = (bf16)lo; }
    if (tid < 16) CNTL[tid] = 0;
    __syncthreads();
    const int TPW = (T + F.G - 1) / F.G, tb = F.vcu * TPW, te = (tb + TPW < T) ? tb + TPW : T;
#pragma unroll 1
    for (int t0 = tb + 16 * w; t0 < te; t0 += 128) {
        const int t = t0 + ti; const bool ok = t < te;
        u32x4 x[16][2];
#pragma unroll
        for (int u = 0; u < 16; ++u)
#pragma unroll
            for (int h = 0; h < 2; ++h) { x[u][h] = (u32x4){0u, 0u, 0u, 0u}; if (ok) x[u][h] = *(const u32x4*)(xb + (size_t)t * D + 64 * u + 16 * kq + 8 * h); }
        f32x4 acc = (f32x4){0.f, 0.f, 0.f, 0.f}; float ss = 0.f;
        const LAS unsigned char* wh = WH + (ti & 7) * WP + 32 * kq; const LAS unsigned char* wl = WL + (ti & 7) * WP + 32 * kq;
#pragma unroll
        for (int u = 0; u < 16; ++u)
#pragma unroll
            for (int h = 0; h < 2; ++h) { const bf16x8 xa = __builtin_bit_cast(bf16x8, x[u][h]);
                acc = MFMA16(ldf(wh + 128 * u + 16 * h), xa, acc); acc = MFMA16(ldf(wl + 128 * u + 16 * h), xa, acc);
#pragma unroll
                for (int c = 0; c < 4; ++c) { const float p = bflo(x[u][h][c]), q = bfhi(x[u][h][c]); ss += p * p + q * q; }
                __builtin_amdgcn_sched_barrier(0); }
        ss += __shfl_xor(ss, 16); ss += __shfl_xor(ss, 32);
        const float r = 1.0f / sqrtf(ss * (1.0f / D) + EPS);
        float lg[8];
#pragma unroll
        for (int i = 0; i < 4; ++i) { const float o = __shfl_xor(acc[i], 16); lg[i] = ((kq & 1) ? o : acc[i]) * r; lg[4 + i] = ((kq & 1) ? acc[i] : o) * r; }
        int i0 = 0; float l0 = lg[0];
#pragma unroll
        for (int e = 1; e < 8; ++e) if (lg[e] > l0) { l0 = lg[e]; i0 = e; }
        int i1 = -1; float l1 = -3.0e38f;
#pragma unroll
        for (int e = 0; e < 8; ++e) if (e != i0 && lg[e] > l1) { l1 = lg[e]; i1 = e; }
        if (i1 < 0) { i1 = i0 == 0 ? 1 : 0; l1 = lg[i0 == 0 ? 1 : 0]; }
        const float g0 = 1.0f / (1.0f + expf(l1 - l0));
        if (ok && kq == 0) { ((int*)(ws + WS_TOPI))[t * 2] = i0; ((int*)(ws + WS_TOPI))[t * 2 + 1] = i1; ((float*)(ws + WS_TOPG))[t * 2] = g0; ((float*)(ws + WS_TOPG))[t * 2 + 1] = 1.0f - g0;
            atomicAdd((int*)&CNTL[i0], 1); atomicAdd((int*)&CNTL[8 + i1], 1); }
        if (ok) {
            unsigned char* o8 = ws + WS_XR8 + (size_t)t * D + 16 * kq;
#pragma unroll
            for (int u = 0; u < 16; ++u) { u32x4 o;
#pragma unroll
                for (int h = 0; h < 2; ++h) { u32x4 xv = x[u][h]; asm volatile("" : "+v"(xv.x), "+v"(xv.y), "+v"(xv.z), "+v"(xv.w));
                    int w0 = __builtin_amdgcn_cvt_pk_fp8_f32(bflo(xv.x) * r, bfhi(xv.x) * r, 0, false); w0 = __builtin_amdgcn_cvt_pk_fp8_f32(bflo(xv.y) * r, bfhi(xv.y) * r, w0, true);
                    int w1 = __builtin_amdgcn_cvt_pk_fp8_f32(bflo(xv.z) * r, bfhi(xv.z) * r, 0, false); w1 = __builtin_amdgcn_cvt_pk_fp8_f32(bflo(xv.w) * r, bfhi(xv.w) * r, w1, true);
                    o[2 * h] = (unsigned)w0; o[2 * h + 1] = (unsigned)w1; }
                *(u32x4*)(o8 + 64 * u) = o; } }
    }
    __syncthreads();
    if (tid < 16) ((int*)(ws + WS_CNT))[F.vcu * 16 + tid] = CNTL[tid];
}
DI void route_scatter(const Frame& F) {
    LAS unsigned char* lds = F.lds; const int tid = F.tid;
    unsigned char* ws = F.ws;
    LAS int* TOT = (LAS int*)lds; LAS int* BASE = TOT + 16; LAS int* SEG = TOT + 32; LAS int* NTK = TOT + 48; LAS int* EL = TOT + 64;
    const int* cnt = (const int*)(ws + WS_CNT);
    { LAS int* PT = TOT + 64 + 1024; LAS int* PB = PT + 512;
      const int k = tid & 15, q = tid >> 4, per = (F.G + 31) / 32; int tot = 0, base = 0;
      for (int i = 0; i < per; ++i) { const int g = q * per + i; if (g < F.G) { const int c = cnt[g * 16 + k]; tot += c; if (g < F.vcu) base += c; } }
      PT[q * 16 + k] = tot; PB[q * 16 + k] = base; }
    __syncthreads();
    if (tid < 16) { LAS int* PT = TOT + 64 + 1024; LAS int* PB = PT + 512; int tot = 0, base = 0;
#pragma unroll
        for (int q = 0; q < 32; ++q) { tot += PT[q * 16 + tid]; base += PB[q * 16 + tid]; }
        TOT[tid] = tot; BASE[tid] = base; }
    __syncthreads();
    if (tid < 2) { int off = 0; for (int e = 0; e < 8; ++e) { SEG[tid * 8 + e] = off; off += (TOT[tid * 8 + e] + 255) & ~255; } NTK[tid] = off >> 8; }
    __syncthreads();
    int* rowtok = (int*)(ws + WS_ROWTOK); float* rowgate = (float*)(ws + WS_ROWGATE); int* tile = (int*)(ws + WS_TILE);
    if (F.vcu == 0) {
        for (int k = 0; k < 2; ++k) {
            if (tid == 0) tile[k * 256] = NTK[k];
            if (tid < NTK[k]) { int e = 0; for (int j = 1; j < 8; ++j) if (tid * 256 >= SEG[k * 8 + j]) e = j; tile[k * 256 + 1 + tid] = e; }
            for (int e = 0; e < 8; ++e) { const int tot = TOT[k * 8 + e], r = tot + tid; if (tid < 256 && r < ((tot + 255) & ~255)) { rowtok[k * MAXRT * 256 + SEG[k * 8 + e] + r] = -1; rowgate[k * MAXRT * 256 + SEG[k * 8 + e] + r] = 0.f; } }
        }
    }
    const int TPW = (T + F.G - 1) / F.G, tb = F.vcu * TPW, t = tb + tid; const bool act = tid < TPW && t < T;
    const int* topi = (const int*)(ws + WS_TOPI); const float* topg = (const float*)(ws + WS_TOPG);
    int e0 = -1, e1 = -1; if (act) { e0 = topi[t * 2]; e1 = topi[t * 2 + 1]; }
    EL[tid] = e0; EL[512 + tid] = e1;
    __syncthreads();
    if (act) { int r0 = 0, r1 = 0; for (int j = 0; j < tid; ++j) { r0 += (EL[j] == e0); r1 += (EL[512 + j] == e1); }
        const int p0 = SEG[e0] + BASE[e0] + r0, p1 = SEG[8 + e1] + BASE[8 + e1] + r1;
        rowtok[p0] = t; rowgate[p0] = topg[t * 2]; rowtok[MAXRT * 256 + p1] = t; rowgate[MAXRT * 256 + p1] = topg[t * 2 + 1]; }
}
DI void final_norm(const Frame& F, const Args& a) {
    const int gw = F.vcu * 8 + F.wave, NGW = F.G * 8, lane = F.lane;
    const bf16* xb = (const bf16*)(F.ws + WS_XB);
    f32x4 g[2][2];
#pragma unroll
    for (int jj = 0; jj < 2; ++jj) { g[jj][0] = *((const f32x4*)a.in[I_FING] + 128 * jj + 2 * lane); g[jj][1] = *((const f32x4*)a.in[I_FING] + 128 * jj + 2 * lane + 1); }
    for (int m0 = gw * 4; m0 < T; m0 += NGW * 4) {
        u32x4 v[4][2];
#pragma unroll
        for (int r = 0; r < 4; ++r)
#pragma unroll
            for (int jj = 0; jj < 2; ++jj) v[r][jj] = *((const u32x4*)(xb + (size_t)(m0 + r) * D) + lane + 64 * jj);
#pragma unroll
        for (int r = 0; r < 4; ++r) { float x[2][8]; float s = 0.f;
#pragma unroll
            for (int jj = 0; jj < 2; ++jj)
#pragma unroll
                for (int c = 0; c < 4; ++c) { x[jj][2 * c] = bflo(v[r][jj][c]); x[jj][2 * c + 1] = bfhi(v[r][jj][c]); }
#pragma unroll
            for (int jj = 0; jj < 2; ++jj) s += ((x[jj][0] * x[jj][0] + x[jj][1] * x[jj][1]) + (x[jj][2] * x[jj][2] + x[jj][3] * x[jj][3])) + ((x[jj][4] * x[jj][4] + x[jj][5] * x[jj][5]) + (x[jj][6] * x[jj][6] + x[jj][7] * x[jj][7]));
            s = wave_sum(s); const float rs = 1.0f / sqrtf(s * (1.0f / D) + EPS);
            f32x4* o = (f32x4*)(a.out + (size_t)(m0 + r) * D) + 2 * lane;
#pragma unroll
            for (int jj = 0; jj < 2; ++jj) { o[128 * jj] = (f32x4){x[jj][0], x[jj][1], x[jj][2], x[jj][3]} * rs * g[jj][0]; o[128 * jj + 1] = (f32x4){x[jj][4], x[jj][5], x[jj][6], x[jj][7]} * rs * g[jj][1]; } }
    }
}

#ifndef MK_PER_PHASE
#define MK_PER_PHASE 0
#endif
constexpr int N_PHASES = 21;
#ifndef PH_MASK
#define PH_MASK 0xFFFFFFFFu
#endif
#define PH_ON(k) && ((PH_MASK >> (k)) & 1u)
#ifndef REP_MASK
#define REP_MASK 0u
#endif
#ifndef REP_N
#define REP_N 2
#endif
#define REPS(k) for (int _rep = 0; _rep < 1 + (((REP_MASK >> (k)) & 1u) ? REP_N : 0); ++_rep)
DI int bxo() { int b = (int)blockIdx.x; asm volatile("" : "+s"(b)); return b; }
__global__ void __launch_bounds__(512, 2) trunk_fwd(Args args) {
    extern __shared__ __attribute__((aligned(16))) unsigned char lds_raw[];
    Frame F;
    F.lds = (LAS unsigned char*)lds_raw;
    const int wv0 = __builtin_amdgcn_readfirstlane((int)threadIdx.x >> 6);
    F.lane = lane_asm(); F.wave = wv0; F.tid = wv0 * 64 + F.lane;
    F.G = gridDim.x; { const int bx = blockIdx.x; F.vcu = (F.G % 8 == 0) ? (bx % 8) * (F.G / 8) + bx / 8 : bx; }
    F.ws = args.ws;
    volatile LAS unsigned* MISC = (volatile LAS unsigned*)(F.lds + MISC_OFF);
    for (int u = F.tid; u < (LDS_BYTES - MISC_OFF) / 4; u += 512) MISC[u] = 0u;
    __syncthreads();
    XcdBarrier bar; bar.bar = (unsigned*)(F.ws + WS_CTL) + CW_BAR; bar.x = 0; bar.st = nullptr; bar.wv = wv0;
    if (!MK_PER_PHASE) bar = xcd_barrier_post((unsigned*)(F.ws + WS_CTL) + CW_BAR, MISC + 8, wv0);
    const int lo = args.ph_lo, hi = args.ph_hi;
#define IN(k) (lo <= (k) && (k) < hi)
#define REFRESH() do { const int _l = lane_asm(); int _w = wv0; asm volatile("" : "+s"(_w)); F.lane = _l; F.wave = _w; F.tid = _w * 64 + _l; } while (0)
#define SEAM(k) do { if (IN(k) && IN((k) + 1)) xcd_barrier(bar); } while (0)
    unsigned char* ws = F.ws;
    bf16* xb = (bf16*)(ws + WS_XB); float* ssq = (float*)(ws + WS_SSQ);

    if (IN(0) PH_ON(0)) REPS(0) { REFRESH(); p0_prologue(F, args); __syncthreads(); }
    SEAM(0);
    for (int l = 0; l < 2; ++l) {
        const int pb = 1 + 8 * l;
        Mix M; M.l = l; M.proj = (const bf16*)(ws + WS_PROJ);
        M.convw = args.in[I_CONVW] + l * 4 * 512; M.convb = args.in[I_CONVB] + l * 512; M.bif = args.in[I_BIF] + l * 8; M.skip = args.in[I_SKIP] + l * 512; M.mhg = args.in[I_MHG] + l * 512;
        M.gmvg = args.in[I_GMVG] + l * 512; M.bsp = args.in[I_BSP] + l * 512; M.gmog = args.in[I_GMOG] + l * 512;
        M.wg = (const bf16*)(ws + WS_WG) + (size_t)l * 16 * 1024; M.wq = (const bf16*)(ws + WS_WQ); M.wk = M.wq + 8 * 128 * 128; M.wv = M.wq + 16 * 128 * 128; M.wsp = (const bf16*)(ws + WS_WSP);
        if (IN(pb) PH_ON(1)) REPS(1) { pg8::Gemm g{xb, (const bf16*)(ws + WS_WIN) + (size_t)l * DIN * D, D, 0, nullptr}; pg8::StaticOrder S; S.init(T, DIN, F.G, bxo());
            EpiIn E{(bf16*)(ws + WS_PROJ), ssq, F.lds, (float*)(ws + WS_VST), false}; pg8::gemm_phase<EpiIn, pg8::StaticOrder, false>(F.lds, g, S, E, F.wave); }
        SEAM(pb);
        if (IN(pb + 1) PH_ON(2)) REPS(2) { REFRESH(); __syncthreads(); if (l == 0) { dense_quant(F, args); __syncthreads(); } REPS(21) for (int u = F.vcu; u < NU; u += F.G) mlstm_local3(F, M, u);
            REFRESH();
            REPS(20) for (int ub = F.vcu; ub < T / 128; ub += F.G) { __syncthreads(); gmlp_unit(F, M, ub); } }
        SEAM(pb + 1);
        if (IN(pb + 2) PH_ON(3)) { REFRESH(); mlstm_scan(F); }
        SEAM(pb + 2);
        if (IN(pb + 3) PH_ON(4)) REPS(4) { REFRESH(); __syncthreads(); mlstm_out_phase(F, M); }
        SEAM(pb + 3);
        if (IN(pb + 4) PH_ON(5)) { const bool cw = l == 1, cfirst = (F.vcu & 1) == 0;
            if (cw && cfirst) { REFRESH(); __syncthreads(); moe_weights(F, args); __syncthreads(); }
            { pg8::Gemm g{(const bf16*)(ws + WS_Y), (const bf16*)(ws + WS_WOUT) + (size_t)l * D * D, D, 0, nullptr}; pg8::StaticOrder S; S.init(T, D, F.G, bxo());
              EpiResT<true> E{nullptr, xb, ssq, F.lds}; pg8::gemm_phase<EpiResT<true>, pg8::StaticOrder, false>(F.lds, g, S, E, F.wave); }
            if (cw && !cfirst) { REFRESH(); __syncthreads(); moe_weights(F, args); __syncthreads(); } }
        SEAM(pb + 4);
        if (l == 0) {
            if (IN(6) PH_ON(6)) { REFRESH(); rows_to_int8(F); }
            SEAM(6);
            if (IN(7) PH_ON(6)) REPS(6) { pg8::Gemm g{(const bf16*)(ws + WS_XB8D), (const bf16*)(ws + WS_W13), D / 2, 0, nullptr}; pg8::StaticOrder S; S.init(T, 2 * DFFP, F.G, bxo());
                EpiGluI8T<true> E{(bf16*)(ws + WS_HID), DFFP, (const float*)(ws + WS_SA), (const float*)(ws + WS_SWD), nullptr, 0u, F.lds}; pg8::gemm_phase<EpiGluI8T<true>, pg8::StaticOrder, false, 1>(F.lds, g, S, E, F.wave); }
            SEAM(7);
            if (IN(8) PH_ON(7)) { pg8::Gemm g{(const bf16*)(ws + WS_HID), (const bf16*)(ws + WS_W2), DFFP / 2, 0, nullptr}; pg8::StaticOrder S; S.init(T, D, F.G, bxo());
                EpiResT<true> E{nullptr, xb, ssq, F.lds}; pg8::gemm_phase<EpiResT<true>, pg8::StaticOrder, false, 2>(F.lds, g, S, E, F.wave); }
            SEAM(8);
        }
    }
    if (IN(14) PH_ON(13)) REPS(13) { REFRESH(); __syncthreads(); route_tokens(F, args); }
    SEAM(14);
    if (IN(15) PH_ON(14)) { REFRESH(); route_scatter(F); }
    SEAM(15);
    {
        const int* tile0 = (const int*)(ws + WS_TILE); const int* tile1 = tile0 + 256;
        const int S0 = __builtin_amdgcn_readfirstlane(tile0[0]), S1 = __builtin_amdgcn_readfirstlane(tile1[0]);
        unsigned* hidcnt = (unsigned*)(ws + WS_CTL) + CW_HID;
        for (int ph = 0; ph < 4; ++ph) {
            if (IN(16 + ph) PH_ON(15)) {
                int prev_units = 0;
                if (ph >= 1) {
                    const int p = ph - 1, k = p == 0 ? 0 : 1, first = p == 2 ? S1 - 64 : 0, nM = p == 0 ? S0 : (p == 1 ? S1 - 64 : 64), hid0 = p == 2 ? 72 : 0;
                    const int* rowtok = (const int*)(ws + WS_ROWTOK) + k * MAXRT * 256; const float* rowgate = (const float*)(ws + WS_ROWGATE) + k * MAXRT * 256;
                    pg8::Gemm g{(const bf16*)(ws + WS_MHID), (const bf16*)(ws + WS_MW2), DFE / 2, (size_t)D * DFE / 2, nullptr}; pg8::MoeOrder S; S.init(k ? tile1 : tile0, first, nM, hid0, D, F.G, bxo(), 0, 0);
                    EpiMoe2 E{xb, rowtok, rowgate, hidcnt, F.lds}; pg8::gemm_phase<EpiMoe2, pg8::MoeOrder, false, 2>(F.lds, g, S, E, F.wave);
                    prev_units = nM * (D / 256);
                }
                if (ph <= 2) {
                    const int p = ph, k = p == 0 ? 0 : 1, first = p == 2 ? S1 - 64 : 0, nM = p == 0 ? S0 : (p == 1 ? S1 - 64 : 64), hid0 = p == 2 ? 72 : 0;
                    const int* rowtok = (const int*)(ws + WS_ROWTOK) + k * MAXRT * 256;
                    pg8::Gemm g{(const bf16*)(ws + WS_XR8), (const bf16*)(ws + WS_MW13), D / 2, (size_t)2 * DFE * (D / 2), rowtok}; pg8::MoeOrder S; S.init(k ? tile1 : tile0, first, nM, hid0, 2 * DFE, F.G, bxo(), prev_units, 3);
                    EpiGluF8 E{ws + WS_MHID, DFE, hidcnt, p == 1 ? 4u : 0u}; pg8::gemm_phase<EpiGluF8, pg8::MoeOrder, true, 2>(F.lds, g, S, E, F.wave);
                }
            }
            SEAM(16 + ph);
        }
    }
    if (IN(20) PH_ON(19)) { REFRESH(); final_norm(F, args); }
#undef IN
#undef SEAM
}

extern "C" void kernel_launch(void* const* d_in, const int* in_sizes, int n_in, void* d_out, int out_size, void* d_ws, size_t ws_size, hipStream_t stream) {
    static int grid = 0;
    if (grid == 0) {
        if (n_in != 26 || in_sizes[0] != T * D || out_size != T * D || ws_size < WS_END) { fprintf(stderr, "kernel_launch: unexpected shapes / workspace (n_in %d, ws %zu < %zu)\n", n_in, ws_size, (size_t)WS_END); grid = -1; return; }
        int dev = 0, cus = 0, per_cu = 0;
        if (hipGetDevice(&dev) != hipSuccess || hipDeviceGetAttribute(&cus, hipDeviceAttributeMultiprocessorCount, dev) != hipSuccess) { grid = -1; return; }
        if (hipFuncSetAttribute((const void*)trunk_fwd, hipFuncAttributeMaxDynamicSharedMemorySize, LDS_BYTES) != hipSuccess) { fprintf(stderr, "kernel_launch: hipFuncSetAttribute failed\n"); grid = -1; return; }
        if (hipOccupancyMaxActiveBlocksPerMultiprocessor(&per_cu, (const void*)trunk_fwd, 512, LDS_BYTES) != hipSuccess || per_cu < 1) { fprintf(stderr, "kernel_launch: occupancy query says %d\n", per_cu); }
        (void)hipGetLastError();
        grid = cus;
    }
    if (grid < 0) return;
    (void)hipMemsetAsync((char*)d_ws + WS_CTL, 0, CTL_ZERO_BYTES, stream);
    Args a{};
    for (int i = 0; i < 26; ++i) a.in[i] = (const float*)d_in[i];
    a.out = (float*)d_out; a.ws = (unsigned char*)d_ws;
#if MK_PER_PHASE
    for (int p = 0; p < N_PHASES; ++p) { a.ph_lo = p; a.ph_hi = p + 1; hipLaunchKernelGGL(trunk_fwd, dim3(grid), dim3(512), LDS_BYTES, stream, a); }
#else
    a.ph_lo = 0; a.ph_hi = N_PHASES;
    hipLaunchKernelGGL(trunk_fwd, dim3(grid), dim3(512), LDS_BYTES, stream, a);
#endif
}
```

```cpp
#include <hip/hip_runtime.h>
#include <cstdio>
#include <cstdint>

#define LAS __attribute__((address_space(3)))
#define GAS __attribute__((address_space(1)))
typedef unsigned short bf16;
typedef short bf16x8 __attribute__((ext_vector_type(8)));
typedef short s16x4 __attribute__((ext_vector_type(4)));
typedef float f32x4 __attribute__((ext_vector_type(4)));
typedef float f32x2 __attribute__((ext_vector_type(2)));
typedef unsigned u32x4 __attribute__((ext_vector_type(4)));
typedef unsigned u32x2 __attribute__((ext_vector_type(2)));
typedef int i32x4 __attribute__((ext_vector_type(4)));
#define DI __device__ __forceinline__

constexpr int NB = 4, SEQ = 8192, T = NB * SEQ, D = 1024, DIN = 2048;
constexpr int CH = 64, NCH = SEQ / CH;
constexpr int NU = T / CH;
constexpr int DFF = 2752, DFFP = 2816;
constexpr int NE = 8, DFE = 3584;
constexpr int MAXRT = 136;
constexpr float EPS = 1e-6f;

constexpr size_t MiB = 1u << 20;
constexpr size_t WS_CTL = 0, CTL_ZERO_BYTES = 1 * MiB;
constexpr size_t WS_SSQ = 1 * MiB;
constexpr size_t WS_VST = 1 * MiB + 512 * 1024;
constexpr size_t WS_WG = 3 * MiB + 512 * 1024;
constexpr size_t WS_WQ = WS_WG + 64 * 1024;
constexpr size_t WS_WSP = WS_WQ + 3 * 256 * 1024;
constexpr size_t WS_GB = 5 * MiB;
constexpr size_t WS_SC = 6 * MiB;
constexpr size_t WS_MP = WS_SC + 64 * 1024;
constexpr size_t WS_TOPI = 6 * MiB + 256 * 1024;
constexpr size_t WS_TOPG = WS_TOPI + 256 * 1024;
constexpr size_t WS_CNT = WS_TOPG + 256 * 1024;
constexpr size_t WS_ROWTOK = 7 * MiB;
constexpr size_t WS_ROWGATE = WS_ROWTOK + 512 * 1024;
constexpr size_t WS_TILE = WS_ROWGATE + 512 * 1024 - 4096;
constexpr size_t WS_WIN = 8 * MiB;
constexpr size_t WS_WOUT = 16 * MiB;
constexpr size_t WS_W13 = 20 * MiB;
constexpr size_t WS_W2 = 31 * MiB;
constexpr size_t WS_XB = 40 * MiB;
constexpr size_t WS_BIG = 104 * MiB;
constexpr size_t WS_PROJ = WS_BIG;
constexpr size_t WS_QG = WS_BIG + 128 * MiB;
constexpr size_t WS_KG = WS_BIG + 160 * MiB;
constexpr size_t WS_VG = WS_BIG + 192 * MiB;
constexpr size_t WS_ST = WS_BIG + 224 * MiB;
constexpr size_t WS_Y = WS_BIG + 296 * MiB;
constexpr size_t WS_XCG = WS_BIG + 360 * MiB;
constexpr size_t WS_HID = WS_BIG;
constexpr size_t WS_MW13 = WS_BIG;
constexpr size_t WS_XR8 = WS_BIG + 64 * MiB;
constexpr size_t WS_MW2 = WS_BIG + 112 * MiB;
constexpr size_t WS_MHID = WS_BIG + 168 * MiB;
constexpr size_t WS_END = WS_BIG + 408 * MiB;
static_assert(WS_MHID + (size_t)MAXRT * 256 * DFE * 2 <= WS_END && WS_Y + (size_t)T * D * 2 <= WS_END, "ws map");
constexpr int CW_BAR = 4096;
constexpr size_t WS_SWD = WS_CTL + 496 * 1024;
constexpr size_t WS_XB8D = WS_BIG + 200 * MiB;
constexpr size_t WS_SW13 = WS_CTL + 256 * 1024;
constexpr size_t WS_ROWSA = WS_GB;
constexpr size_t WS_SA = WS_GB + 512 * 1024;
constexpr int CW_HID = 16384;

constexpr int RING_BYTES = 131072;
constexpr int MISC_OFF = RING_BYTES + 12288;
constexpr int LDS_BYTES = 147456;

typedef __bf16 bf16x2_t __attribute__((ext_vector_type(2)));
DI unsigned pk2(float lo, float hi) { const f32x2 v = {lo, hi}; return __builtin_bit_cast(unsigned, __builtin_convertvector(v, bf16x2_t)); }
DI unsigned f2bf(float f) { return pk2(f, f) & 0xffffu; }
DI float bf2f(unsigned b) { return __builtin_bit_cast(float, b << 16); }
DI float bflo(unsigned w) { return __builtin_bit_cast(float, w << 16); }
DI float bfhi(unsigned w) { return __builtin_bit_cast(float, w & 0xffff0000u); }
DI float fexp(float x) { return __builtin_amdgcn_exp2f(x * 1.44269504089f); }
DI float softplus_neg(float a) { return __builtin_amdgcn_logf(1.0f + __builtin_amdgcn_exp2f(-1.44269504089f * a)) * 0.69314718056f; }
DI float sigmoidf(float x) { return __builtin_amdgcn_rcpf(1.0f + fexp(-x)); }
DI float siluf(float x) { return x * sigmoidf(x); }
DI float geluf(float x) { return x * sigmoidf(1.59576912161f * (x + 0.044715f * x * x * x)); }
DI float dpp_f(float v, const int ctrl_sel) {
    const int x = __builtin_bit_cast(int, v); int r;
    if (ctrl_sel == 0) r = __builtin_amdgcn_update_dpp(x, x, 0xB1, 0xF, 0xF, false);
    else if (ctrl_sel == 1) r = __builtin_amdgcn_update_dpp(x, x, 0x4E, 0xF, 0xF, false);
    else if (ctrl_sel == 2) r = __builtin_amdgcn_update_dpp(x, x, 0x141, 0xF, 0xF, false);
    else r = __builtin_amdgcn_update_dpp(x, x, 0x140, 0xF, 0xF, false);
    return __builtin_bit_cast(float, r);
}
DI float rl_f(float v, int l) { return __builtin_bit_cast(float, __builtin_amdgcn_readlane(__builtin_bit_cast(int, v), l)); }
DI float wave_sum(float v) {
    v += dpp_f(v, 0); v += dpp_f(v, 1); v += dpp_f(v, 2); v += dpp_f(v, 3);
    return (rl_f(v, 0) + rl_f(v, 16)) + (rl_f(v, 32) + rl_f(v, 48));
}
DI float wave_max(float v) {
    v = fmaxf(v, dpp_f(v, 0)); v = fmaxf(v, dpp_f(v, 1)); v = fmaxf(v, dpp_f(v, 2)); v = fmaxf(v, dpp_f(v, 3));
    return fmaxf(fmaxf(rl_f(v, 0), rl_f(v, 16)), fmaxf(rl_f(v, 32), rl_f(v, 48)));
}
#define MFMA16(a, b, c) __builtin_amdgcn_mfma_f32_16x16x32_bf16((a), (b), (c), 0, 0, 0)
#define LDS_WAIT() asm volatile("s_waitcnt lgkmcnt(0)" ::: "memory")
#define VM_WAIT() asm volatile("s_waitcnt vmcnt(0)" ::: "memory")

DI int lane_asm() { int l; asm volatile("v_mbcnt_lo_u32_b32 %0, -1, 0\n\tv_mbcnt_hi_u32_b32 %0, -1, %0" : "=v"(l)); return l; }
namespace pg8 {
constexpr int BM = 256, BK = 64, HALF = 128, HTB = HALF * BK * 2, STAGE_BYTES = 8 * HTB, NXCD = 8, WGM = 8;
__host__ __device__ __forceinline__ int lds_byte(int r, int c) { const int st = (r >> 4) * 2 + (c >> 5), rr = r & 15, cc = c & 31, ob = rr * 64 + cc * 2; return st * 1024 + (ob ^ (((ob >> 9) & 1) << 5)); }
__host__ __device__ __forceinline__ void stage_rc(int b, int& R, int& C) { const int st = b / 1024, sb = b % 1024, swz = sb ^ (((sb >> 9) & 1) << 5); R = (st >> 1) * 16 + swz / 64; C = (st & 1) * 32 + (swz % 64) / 2; }
__host__ __device__ __forceinline__ int perm32(int rho) { const int n = rho >> 4, i = rho & 15; return 8 * (i >> 2) + 4 * n + (i & 3); }

struct Unit { int pm, pn, e, ph; };
struct Gemm { const bf16* A; const bf16* Bt; int K; size_t estride; const int* rowtok; };

DI void tile_of(int wgid, int nM, int nN, int& pm, int& pn) {
    const int nwg = nM * nN;
    { const int q = nwg / NXCD, r = nwg % NXCD, xcd = wgid % NXCD, off = wgid / NXCD; wgid = (xcd < r ? xcd * (q + 1) : r * (q + 1) + (xcd - r) * q) + off; }
    const int nig = WGM * nN, gid = wgid / nig, fm = gid * WGM, gsz = (nM - fm) < WGM ? (nM - fm) : WGM;
    pm = fm + ((wgid % nig) % gsz); pn = (wgid % nig) / gsz;
}
struct StaticOrder {
    int nM, nN, nwg, G, c;
    DI void init(int M, int N, int G_, int c_) { nM = M / BM; nN = N / BM; nwg = nM * nN; G = G_; c = c_; }
    DI bool next(int i, Unit& u) const {
        const long L = (long)i * G + c; if (L >= nwg) return false;
        tile_of((int)L, nM, nN, u.pm, u.pn); u.e = 0; u.ph = u.pm; return true;
    }
};
struct MoeOrder {
    const int* tile; int first, hid0, nM, nN, W, j, cnt, base, ex, SK;
    DI void init(const int* tile_, int first_, int nM_, int hid0_, int N, int G, int c, int prev_units, int SK_) {
        tile = tile_; first = first_; hid0 = hid0_; nM = nM_; nN = N / BM; SK = SK_;
        const int nwg = nM * nN; int x, nx;
        if (G % NXCD == 0) { x = c % NXCD; j = c / NXCD; W = G / NXCD; nx = NXCD; } else { x = 0; j = c; W = G; nx = 1; }
        const int q = nwg / nx, r = nwg % nx; cnt = q + (x < r ? 1 : 0); base = (x < r) ? x * (q + 1) : r * (q + 1) + (x - r) * q;
        const int q2 = prev_units / nx, r2 = prev_units % nx, cnt2 = q2 + (x < r2 ? 1 : 0); ex = cnt2 % W;
    }
    DI bool next(int i, Unit& u) const {
        const int R = i + (j < ex ? SK : 0);
        const int off = (R < SK) ? R * (W - ex) + (j - ex) : SK * (W - ex) + (R - SK) * W + j;
        if (off >= cnt) return false;
        constexpr int WGM = 2;
        const int wgid = base + off, nig = WGM * nN, gid = wgid / nig, fm = gid * WGM, gsz = (nM - fm) < WGM ? (nM - fm) : WGM;
        const int pl = fm + ((wgid % nig) % gsz); u.pn = (wgid % nig) / gsz; u.pm = first + pl; u.ph = hid0 + pl;
        u.e = __builtin_amdgcn_readfirstlane(tile[1 + u.pm]); return true;
    }
};

DI unsigned cvt_pk_bf16(float lo, float hi) { unsigned r; asm volatile("v_cvt_pk_bf16_f32 %0, %1, %2" : "=v"(r) : "v"(lo), "v"(hi)); return r; }

template <bool I8> struct AccT { typedef f32x4 type; };
template <> struct AccT<true> { typedef i32x4 type; };
template <class Epi, class Sched, bool GATHER, int Q = 0>
DI void gemm_phase(LAS unsigned char* lds, const Gemm g, const Sched& S, const Epi& E, const int wv) {
    constexpr bool I8 = Q == 1;
    typedef typename AccT<I8>::type acc_t;
    int wid = wv; asm volatile("" : "+s"(wid));
    const int tid = wid * 64 + lane_asm();
    const int lane = tid & 63, wr = wid >> 2, wc = wid & 3, fr = lane & 15, fq = lane >> 4;
    const int K = g.K, nt = K / BK;
    unsigned voffA[2], voffB[2];
#pragma unroll
    for (int i = 0; i < 2; ++i) { int R, C; stage_rc(tid * 16 + i * 8192, R, C); const int Rb = Epi::PERM ? ((R & ~31) + perm32(R & 31)) : R;
        voffA[i] = (unsigned)(R * K + C) * 2u; voffB[i] = (unsigned)(Rb * K + C) * 2u; }
    const unsigned kstep = (unsigned)(BK * 2);
    const size_t hstep = (size_t)HALF * K * 2;
    const size_t tstep = 2 * hstep;
    const unsigned ldsw = (unsigned)wid * 1024u;
    const int aoff = lds_byte(wr * 64 + fr, fq * 8), boff = lds_byte(wc * 32 + fr, fq * 8);
#define PG8_SA(b, h) (((b) * 2 + (h)) * HTB)
#define PG8_SB(b, h) ((4 + (b) * 2 + (h)) * HTB)
#define PG8_STAGE(bufoff, gbase, voff) do { _Pragma("unroll") for (int _i = 0; _i < 2; ++_i) { unsigned _vo = (voff)[_i]; asm volatile("" : "+v"(_vo)); \
        __builtin_amdgcn_global_load_lds((const unsigned*)((const char*)(gbase) + _vo), (LAS unsigned*)(lds + (bufoff) + ldsw + _i * 8192), 16, 0, 0); } } while (0)
#define PG8_STAGEA(bufoff, PA, OA, h, kb) do { if constexpr (GATHER) { _Pragma("unroll") for (int _i = 0; _i < 2; ++_i) { unsigned _vo = (OA)[h][_i]; asm volatile("" : "+v"(_vo)); \
        __builtin_amdgcn_global_load_lds((const unsigned*)((const char*)g.A + (size_t)_vo + (kb)), (LAS unsigned*)(lds + (bufoff) + ldsw + _i * 8192), 16, 0, 0); } } \
        else { PG8_STAGE(bufoff, (PA) + (h) * hstep + (kb), voffA); } } while (0)
#define PG8_LDA(dst, b, h) do { _Pragma("unroll") for (int m = 0; m < 4; ++m) _Pragma("unroll") for (int k = 0; k < 2; ++k) dst[m][k] = *(const LAS bf16x8*)(lds + PG8_SA(b, h) + aoff + m * 2048 + k * 1024); } while (0)
#define PG8_LDB(dst, b, h) do { _Pragma("unroll") for (int n = 0; n < 2; ++n) _Pragma("unroll") for (int k = 0; k < 2; ++k) dst[n][k] = *(const LAS bf16x8*)(lds + PG8_SB(b, h) + boff + n * 2048 + k * 1024); } while (0)
#define PG8_CAT(X) __builtin_shufflevector(__builtin_bit_cast(i32x4, X[0]), __builtin_bit_cast(i32x4, X[1]), 0, 1, 2, 3, 4, 5, 6, 7)
#define PG8_MMA(ai, bj, At, Bt) do { __builtin_amdgcn_s_setprio(1); _Pragma("unroll") for (int m = 0; m < 4; ++m) _Pragma("unroll") for (int n = 0; n < 2; ++n) _Pragma("unroll") for (int k = 0; k < 2; ++k) { \
        if constexpr (Q == 2) { if (k == 0) acc[ai][bj][m][n] = __builtin_amdgcn_mfma_scale_f32_16x16x128_f8f6f4(PG8_CAT(Bt[n]), PG8_CAT(At[m]), acc[ai][bj][m][n], 0, 0, 0, 0x7c7c7c7c, 0, 0x7c7c7c7c); } \
        else if constexpr (I8) acc[ai][bj][m][n] = __builtin_amdgcn_mfma_i32_16x16x64_i8(__builtin_bit_cast(i32x4, Bt[n][k]), __builtin_bit_cast(i32x4, At[m][k]), acc[ai][bj][m][n], 0, 0, 0); \
        else acc[ai][bj][m][n] = __builtin_amdgcn_mfma_f32_16x16x32_bf16(Bt[n][k], At[m][k], acc[ai][bj][m][n], 0, 0, 0); } __builtin_amdgcn_s_setprio(0); } while (0)
#define PG8_WAIT_V(n) asm volatile("s_waitcnt vmcnt(" #n ")" ::: "memory")
#define PG8_WAIT_L(n) asm volatile("s_waitcnt lgkmcnt(" #n ")" ::: "memory")
#define PG8_BAR __builtin_amdgcn_s_barrier()
#define PG8_SCHED __builtin_amdgcn_sched_barrier(0)
#define PG8_ARAW(dst, u) do { if constexpr (GATHER) { _Pragma("unroll") for (int _h = 0; _h < 2; ++_h) _Pragma("unroll") for (int _i = 0; _i < 2; ++_i) { \
        int _R, _C; stage_rc(tid * 16 + _i * 8192, _R, _C); dst[_h][_i] = g.rowtok[(u).pm * BM + _h * HALF + _R]; } } } while (0)
#define PG8_AOFFS(dst, raw) do { if constexpr (GATHER) { _Pragma("unroll") for (int _h = 0; _h < 2; ++_h) _Pragma("unroll") for (int _i = 0; _i < 2; ++_i) { \
        int _R, _C; stage_rc(tid * 16 + _i * 8192, _R, _C); int _t = raw[_h][_i]; _t = _t < 0 ? 0 : _t; \
        dst[_h][_i] = (unsigned)_t * (unsigned)(K * 2) + (unsigned)(_C * 2); } } } while (0)
    Unit cur, nxt, nn; int ui = 0;
    if (!S.next(0, cur)) return;
    f32x4 pf0 = (f32x4){0.f, 0.f, 0.f, 0.f};
    if constexpr (Epi::PRE) E.pre(cur, tid, pf0);
    bool has_next = S.next(1, nxt); if (!has_next) nxt = cur;
    acc_t acc[2][2][4][2];
#pragma unroll
    for (int a = 0; a < 2; ++a)
#pragma unroll
        for (int b = 0; b < 2; ++b)
#pragma unroll
            for (int m = 0; m < 4; ++m)
#pragma unroll
                for (int n = 0; n < 2; ++n) acc[a][b][m][n] = acc_t{};
    bf16x8 At[4][2], B0[2][2], B1[2][2];
    unsigned oa[2][2], na[2][2]; int rt2[2][2];
    PG8_ARAW(rt2, cur); PG8_AOFFS(oa, rt2); PG8_ARAW(rt2, nxt); PG8_AOFFS(na, rt2);
    const char* cA = (const char*)g.A + (GATHER ? (size_t)0 : (size_t)cur.ph * tstep);
    const char* cB = (const char*)g.Bt + ((size_t)cur.e * g.estride) * 2 + (size_t)cur.pn * tstep;
    PG8_STAGE(PG8_SB(0, 0), cB, voffB); PG8_STAGE(PG8_SB(0, 1), cB + hstep, voffB); PG8_STAGEA(PG8_SA(0, 0), cA, oa, 0, 0); PG8_STAGEA(PG8_SA(0, 1), cA, oa, 1, 0);
    if (wr == 1) PG8_BAR;
    PG8_WAIT_V(2); PG8_BAR;
    if constexpr (Epi::PRE) E.post(tid, pf0, 0);
    PG8_STAGE(PG8_SB(1, 0), cB + kstep, voffB); PG8_STAGEA(PG8_SA(1, 0), cA, oa, 0, kstep); PG8_STAGE(PG8_SB(1, 1), cB + hstep + kstep, voffB);
    PG8_WAIT_V(6); PG8_BAR;
    for (;;) {
        const char* nA = (const char*)g.A + (GATHER ? (size_t)0 : (size_t)nxt.ph * tstep);
        const char* nB = (const char*)g.Bt + ((size_t)nxt.e * g.estride) * 2 + (size_t)nxt.pn * tstep;
        for (int t = 0; t < nt; t += 2) {
            const bool last = (t == nt - 2);
            const unsigned k1 = (unsigned)(t + 1) * kstep, k2 = last ? 0u : (unsigned)(t + 2) * kstep, k3 = k2 + kstep;
            const char* a2 = last ? nA : cA;
            const char* b2 = last ? nB : cB + (size_t)(t + 2) * kstep; const char* b3 = b2 + kstep;
            PG8_LDB(B0, 0, 0); PG8_LDB(B1, 0, 1); PG8_SCHED; PG8_LDA(At, 0, 0); PG8_STAGEA(PG8_SA(1, 1), cA, oa, 1, k1);
            if constexpr (GATHER) { if (last) {
#pragma unroll
                for (int h = 0; h < 2; ++h)
#pragma unroll
                    for (int i = 0; i < 2; ++i) oa[h][i] = na[h][i]; } }
            PG8_WAIT_V(8); PG8_WAIT_L(0); PG8_BAR; PG8_MMA(0, 0, At, B0); PG8_MMA(0, 1, At, B1); PG8_BAR; PG8_SCHED;
            PG8_LDA(At, 0, 1); PG8_STAGE(PG8_SB(0, 0), b2, voffB); PG8_STAGE(PG8_SB(0, 1), b2 + hstep, voffB); PG8_STAGEA(PG8_SA(0, 0), a2, oa, 0, k2);
            PG8_WAIT_V(8); PG8_WAIT_L(0); PG8_BAR; PG8_MMA(1, 0, At, B0); PG8_MMA(1, 1, At, B1); PG8_BAR; PG8_SCHED;
            PG8_LDB(B0, 1, 0); PG8_LDB(B1, 1, 1); PG8_SCHED; PG8_LDA(At, 1, 0); PG8_STAGEA(PG8_SA(0, 1), a2, oa, 1, k2);
            PG8_WAIT_V(8); PG8_WAIT_L(0); PG8_BAR; PG8_MMA(0, 0, At, B0); PG8_MMA(0, 1, At, B1); PG8_BAR; PG8_SCHED;
            PG8_LDA(At, 1, 1); PG8_STAGE(PG8_SB(1, 0), b3, voffB); PG8_STAGE(PG8_SB(1, 1), b3 + hstep, voffB); PG8_STAGEA(PG8_SA(1, 0), a2, oa, 0, k3);
            PG8_WAIT_V(8); PG8_WAIT_L(0); PG8_BAR; PG8_MMA(1, 0, At, B0); PG8_MMA(1, 1, At, B1); PG8_BAR; PG8_SCHED;
        }
        if (wr == 0) PG8_BAR;
        bool has_nn = has_next && S.next(ui + 2, nn); if (!has_nn) nn = nxt;
        PG8_ARAW(rt2, nn);
        f32x4 pf = (f32x4){0.f, 0.f, 0.f, 0.f};
        if constexpr (Epi::PRE) { if (has_next) E.pre(nxt, wid * 64 + lane_asm(), pf); }
        E.done(cur, wid * 64 + lane_asm());
        { const int l2 = lane_asm(); int wr_ = wr, wc_ = wc; asm volatile("" : "+s"(wr_), "+s"(wc_));
          E(acc, cur, wr_, wc_, l2 & 15, l2 >> 4, ui & 1, pf, (ui + 1) & 1); }
        if (!has_next) break;
        PG8_AOFFS(na, rt2);
#pragma unroll
        for (int a = 0; a < 2; ++a)
#pragma unroll
            for (int b = 0; b < 2; ++b)
#pragma unroll
                for (int m = 0; m < 4; ++m)
#pragma unroll
                    for (int n = 0; n < 2; ++n) acc[a][b][m][n] = acc_t{};
        cur = nxt; cA = nA; cB = nB; nxt = nn; has_next = has_nn; ++ui;
        if (wr == 1) PG8_BAR;
    }
    PG8_WAIT_V(0);
    PG8_BAR;
#undef PG8_SA
#undef PG8_SB
#undef PG8_STAGE
#undef PG8_STAGEA
#undef PG8_LDA
#undef PG8_LDB
#undef PG8_MMA
#undef PG8_CAT
#undef PG8_WAIT_V
#undef PG8_WAIT_L
#undef PG8_BAR
#undef PG8_SCHED
#undef PG8_ARAW
#undef PG8_AOFFS
}
}

#define XB_TMO      128
#define XB_XCNT(j)  (256  + 64 * (j))
#define XB_XSUB(j)  (1280 + 64 * (j))
#define XB_XGEN(j)  (2304 + 64 * (j))
#define XB_TOP      3328
#define XB_TOPGEN   3392
#define XCD_BAR_WORDS 3456
#define XB_SPIN_CAP (1u << 18)
__device__ __forceinline__ unsigned xb_ld(unsigned* p)              { return __hip_atomic_load(p, __ATOMIC_RELAXED, __HIP_MEMORY_SCOPE_AGENT); }
__device__ __forceinline__ unsigned xb_add(unsigned* p, unsigned v) { return __hip_atomic_fetch_add(p, v, __ATOMIC_RELAXED, __HIP_MEMORY_SCOPE_AGENT); }
__device__ __forceinline__ unsigned xb_xcc_id() { return (unsigned)__builtin_amdgcn_s_getreg((3 << 11) | 20) & 0xFu; }
#define XB_SPIN(cond, bar) do { unsigned _sp = 0; while (cond) { __builtin_amdgcn_s_sleep(1); \
    if ((++_sp & 255u) == 0u) { if (xb_ld(&(bar)[XB_TMO])) break; if (_sp > XB_SPIN_CAP) { atomicAdd(&(bar)[XB_TMO], 1u); break; } } } } while (0)
struct XcdBarrier { unsigned* bar; unsigned x; volatile LAS unsigned* st; int wv; };
__device__ __forceinline__ XcdBarrier xcd_barrier_post(unsigned* bar, volatile LAS unsigned* st, int wv) {
    XcdBarrier b; b.bar = bar; b.x = xb_xcc_id(); b.st = st; b.wv = wv;
    if (wv == 0 && lane_asm() == 0) (void)xb_add(&bar[XB_XCNT(b.x)], 1u);
    return b;
}
__device__ __forceinline__ void xcd_barrier_complete(unsigned* bar, unsigned x, unsigned& nloc, unsigned& nx) {
    const unsigned G = gridDim.x * gridDim.y * gridDim.z;
    unsigned sum, cnt, mine, sp = 0u;
    for (;;) {
        sum = 0u; cnt = 0u; mine = 0u;
#pragma unroll
        for (unsigned j = 0; j < 16; ++j) { const unsigned c = xb_ld(&bar[XB_XCNT(j)]); sum += c; cnt += (c > 0u) ? 1u : 0u; mine = (j == x) ? c : mine; }
        if (sum == G) break;
        __builtin_amdgcn_s_sleep(1);
        if ((++sp & 255u) == 0u) { if (xb_ld(&bar[XB_TMO])) break; if (sp > XB_SPIN_CAP) { atomicAdd(&bar[XB_TMO], 1u); break; } }
    }
    nloc = mine > 0u ? mine : 1u; nx = cnt > 0u ? cnt : 1u;
}
__device__ __forceinline__ void xcd_barrier(const XcdBarrier& b) {
    asm volatile("s_waitcnt vmcnt(0)" ::: "memory");
    __syncthreads();
    if (b.wv == 0 && lane_asm() == 0) {
        unsigned* bar = b.bar;
        __builtin_amdgcn_s_waitcnt(0);
        unsigned nloc = b.st[0], nx = b.st[1];
        if (nloc == 0u) { xcd_barrier_complete(bar, b.x, nloc, nx); b.st[0] = nloc; b.st[1] = nx; }
        const unsigned old = xb_add(&bar[XB_XSUB(b.x)], 1u);
        const unsigned gen = old / nloc;
        if (old + 1u == (gen + 1u) * nloc) {
            __builtin_amdgcn_fence(__ATOMIC_RELEASE, "agent");
            asm volatile("s_waitcnt vmcnt(0)" ::: "memory");
            const unsigned og = xb_add(&bar[XB_TOP], 1u);
            const unsigned tg = og / nx;
            if (og + 1u == (tg + 1u) * nx) xb_add(&bar[XB_TOPGEN], 1u);
            else XB_SPIN(xb_ld(&bar[XB_TOPGEN]) == tg, bar);
            __builtin_amdgcn_fence(__ATOMIC_ACQUIRE, "agent");
            xb_add(&bar[XB_XGEN(b.x)], 1u);
            asm volatile("s_waitcnt vmcnt(0)" ::: "memory");
        } else {
            XB_SPIN(xb_ld(&bar[XB_XGEN(b.x)]) == gen, bar);
            __builtin_amdgcn_fence(__ATOMIC_ACQUIRE, "agent");
            asm volatile("s_waitcnt vmcnt(0)" ::: "memory");
        }
    }
    __syncthreads();
}

struct Frame {
    LAS unsigned char* lds;
    int tid, lane, wave, vcu, G;
    unsigned char* ws;
};
struct Args { const float* in[26]; float* out; unsigned char* ws; int ph_lo, ph_hi; };
enum { I_X = 0, I_MIXG, I_WIN, I_CONVW, I_CONVB, I_WQ, I_WK, I_WV, I_WIF, I_BIF, I_SKIP, I_MHG, I_GMVG, I_WSP, I_BSP, I_GMOG, I_WOUT, I_FFNG,
       I_DW1, I_DW3, I_DW2, I_ROUTER, I_MW1, I_MW3, I_MW2, I_FING };

DI float rs_from(const f32x4 p) { return __builtin_amdgcn_rsqf(((p.x + p.y) + (p.z + p.w)) * (1.0f / D) + EPS); }
constexpr int L_PF = RING_BYTES + 4096;
constexpr int L_SSL = RING_BYTES;

struct EpiIn {
    static constexpr bool PERM = true, PRE = true;
    bf16* O; const float* ssq; LAS unsigned char* lds; float* vst; bool scaled;
    DI void done(const pg8::Unit&, int) const {}
    DI void pre(const pg8::Unit& u, int tid, f32x4& pf) const { pf = *(const f32x4*)(ssq + (size_t)(u.pm * 256 + (tid & 255)) * 4); }
    DI void post(int tid, const f32x4& pf, int slot) const { ((LAS float*)(lds + L_PF))[slot * 512 + (tid & 255)] = scaled ? 1.0f : rs_from(pf); }
    DI void operator()(const f32x4 (&acc)[2][2][4][2], const pg8::Unit& u, int wr, int wc, int fr, int fq, int slot, const f32x4& pf, int nslot) const {
        const int row0 = u.pm * 256 + wr * 64 + fr, col0 = u.pn * 256 + wc * 32 + 8 * fq, act = u.pn >> 1;
        f32x4 pp[2][4];
#pragma unroll
        for (int ai = 0; ai < 2; ++ai)
#pragma unroll
            for (int m = 0; m < 4; ++m) pp[ai][m] = (f32x4){((const LAS float*)(lds + L_PF))[slot * 512 + ai * 128 + wr * 64 + m * 16 + fr], 0.f, 0.f, 0.f};
#pragma unroll
        for (int ai = 0; ai < 2; ++ai)
#pragma unroll
            for (int m = 0; m < 4; ++m) { if (ai == 0 && m == 2) post(wc * 64 + fq * 16 + fr, pf, nslot);
                const int row = row0 + ai * 128 + m * 16; const float r = pp[ai][m].x; bf16* rowp = O + (size_t)row * DIN + col0; float s1 = 0.f, s2 = 0.f;
#pragma unroll
                for (int bj = 0; bj < 2; ++bj) { float v[8];
#pragma unroll
                    for (int j = 0; j < 4; ++j) { v[j] = acc[ai][bj][m][0][j] * r; v[4 + j] = acc[ai][bj][m][1][j] * r; }
                    if (act == 1) {
#pragma unroll
                        for (int j = 0; j < 8; ++j) v[j] = sigmoidf(v[j]); }
                    else if (act >= 2) {
#pragma unroll
                        for (int j = 0; j < 8; ++j) v[j] = geluf(v[j]); }
                    u32x4 w; w.x = pg8::cvt_pk_bf16(v[0], v[1]); w.y = pg8::cvt_pk_bf16(v[2], v[3]); w.z = pg8::cvt_pk_bf16(v[4], v[5]); w.w = pg8::cvt_pk_bf16(v[6], v[7]);
                    *(u32x4*)(rowp + bj * 128) = w;
                    if (act == 3) { s1 += ((v[0] + v[1]) + (v[2] + v[3])) + ((v[4] + v[5]) + (v[6] + v[7])); s2 += ((v[0] * v[0] + v[1] * v[1]) + (v[2] * v[2] + v[3] * v[3])) + ((v[4] * v[4] + v[5] * v[5]) + (v[6] * v[6] + v[7] * v[7])); } }
                if (act == 3) { s1 += __shfl_xor(s1, 16); s1 += __shfl_xor(s1, 32); s2 += __shfl_xor(s2, 16); s2 += __shfl_xor(s2, 32);
                    if (fq == 0) *(f32x2*)(vst + ((size_t)row * 8 + (u.pn - 6) * 4 + wc) * 2) = (f32x2){s1, s2}; } }
    }
};
template <bool BF> struct EpiResT {
    static constexpr bool PERM = true, PRE = false;
    const float* base; bf16* xb; float* ssq; LAS unsigned char* lds;
    DI void done(const pg8::Unit&, int) const {}
    DI void operator()(const f32x4 (&acc)[2][2][4][2], const pg8::Unit& u, int wr, int wc, int fr, int fq, int slot, const f32x4&, int) const {
        const int row0 = u.pm * 256 + wr * 64 + fr, col0 = u.pn * 256 + wc * 32 + 8 * fq;
        LAS float* SSL = (LAS float*)(lds + L_SSL);
#pragma unroll
        for (int ai = 0; ai < 2; ++ai) {
            f32x4 bs[4][2][2]; u32x4 bb[4][2];
#pragma unroll
            for (int m = 0; m < 4; ++m)
#pragma unroll
                for (int bj = 0; bj < 2; ++bj) { const size_t o_ = (size_t)(row0 + ai * 128 + m * 16) * D + col0 + bj * 128;
                    if constexpr (BF) bb[m][bj] = *(const u32x4*)(xb + o_); else { bs[m][bj][0] = *(const f32x4*)(base + o_); bs[m][bj][1] = *(const f32x4*)(base + o_ + 4); } }
#pragma unroll
            for (int m = 0; m < 4; ++m) { const int row = row0 + ai * 128 + m * 16; const size_t off = (size_t)row * D + col0; float ss = 0.f;
#pragma unroll
                for (int bj = 0; bj < 2; ++bj) { f32x4 b0, b1;
                    if constexpr (BF) { b0 = (f32x4){bflo(bb[m][bj].x), bfhi(bb[m][bj].x), bflo(bb[m][bj].y), bfhi(bb[m][bj].y)}; b1 = (f32x4){bflo(bb[m][bj].z), bfhi(bb[m][bj].z), bflo(bb[m][bj].w), bfhi(bb[m][bj].w)}; }
                    else { b0 = bs[m][bj][0]; b1 = bs[m][bj][1]; }
                    const f32x4 o0 = b0 + acc[ai][bj][m][0], o1 = b1 + acc[ai][bj][m][1];
                    ss += ((o0.x * o0.x + o0.y * o0.y) + (o0.z * o0.z + o0.w * o0.w)) + ((o1.x * o1.x + o1.y * o1.y) + (o1.z * o1.z + o1.w * o1.w));
                    u32x4 w; w.x = pg8::cvt_pk_bf16(o0.x, o0.y); w.y = pg8::cvt_pk_bf16(o0.z, o0.w); w.z = pg8::cvt_pk_bf16(o1.x, o1.y); w.w = pg8::cvt_pk_bf16(o1.z, o1.w);
                    *(u32x4*)(xb + off + bj * 128) = w; }
                ss += __shfl_xor(ss, 16); ss += __shfl_xor(ss, 32);
                if (fq == 0) SSL[(ai * 128 + wr * 64 + m * 16 + fr) * 4 + wc] = ss; }
            asm volatile("" ::: "memory"); }
        LDS_WAIT(); __builtin_amdgcn_s_barrier(); asm volatile("" ::: "memory");
        const int tix = (wr * 4 + wc) * 64 + fq * 16 + fr;
        if (tix < 256) { const f32x4 p = *(const LAS f32x4*)(SSL + tix * 4); ssq[(size_t)(u.pm * 256 + tix) * 4 + u.pn] = (p.x + p.y) + (p.z + p.w); }
    }
};
template <bool MOE> struct EpiGlu {
    static constexpr bool PERM = true, PRE = false;
    bf16* O; int ld; const float* ssq; const int* rowtok; unsigned* hidcnt; unsigned need;
    DI void done(const pg8::Unit&, int) const {}
    DI void operator()(const f32x4 (&acc)[2][2][4][2], const pg8::Unit& u, int wr, int wc, int fr, int fq, int slot, const f32x4&, int) const {
        const int row0 = u.pm * 256 + wr * 64 + fr, orow0 = u.ph * 256 + wr * 64 + fr, col0 = u.pn * 128 + wc * 32 + 8 * fq;
        f32x4 pp[2][4];
#pragma unroll
        for (int ai = 0; ai < 2; ++ai)
#pragma unroll
            for (int m = 0; m < 4; ++m) { pp[ai][m] = (f32x4){0.f, 0.f, 0.f, 0.f}; if (!MOE) pp[ai][m] = *(const f32x4*)(ssq + (size_t)(row0 + ai * 128 + m * 16) * 4); }
        if (MOE) { if (need) { unsigned sp = 0; while ((unsigned)__builtin_amdgcn_readfirstlane(__hip_atomic_load(hidcnt + 64 * u.ph, __ATOMIC_RELAXED, __HIP_MEMORY_SCOPE_AGENT)) < need) { __builtin_amdgcn_s_sleep(2); if (++sp > (1u << 22)) break; } } }
#pragma unroll
        for (int ai = 0; ai < 2; ++ai)
#pragma unroll
            for (int m = 0; m < 4; ++m) { const float r = MOE ? 1.0f : rs_from(pp[ai][m]); float v[8];
#pragma unroll
                for (int j = 0; j < 4; ++j) { v[j] = siluf(acc[ai][0][m][0][j] * r) * (acc[ai][1][m][0][j] * r); v[4 + j] = siluf(acc[ai][0][m][1][j] * r) * (acc[ai][1][m][1][j] * r); }
                u32x4 w; w.x = pg8::cvt_pk_bf16(v[0], v[1]); w.y = pg8::cvt_pk_bf16(v[2], v[3]); w.z = pg8::cvt_pk_bf16(v[4], v[5]); w.w = pg8::cvt_pk_bf16(v[6], v[7]);
                *(u32x4*)(O + (size_t)(orow0 + ai * 128 + m * 16) * ld + col0) = w; }
    }
};
template <bool F8> struct EpiGluI8T {
    static constexpr bool PERM = true, PRE = true;
    bf16* O; int ld; const float* rowsa; const float* sw13; unsigned* hidcnt; unsigned need; LAS unsigned char* lds;
    DI void done(const pg8::Unit&, int) const {}
    DI void pre(const pg8::Unit& u, int tid, f32x4& pf) const { const int t = tid & 255; pf.x = rowsa[u.pm * 256 + t]; pf.y = sw13[(size_t)u.e * (2 * DFE) + u.pn * 256 + t]; }
    DI void post(int tid, const f32x4& pf, int slot) const { LAS float* p = (LAS float*)(lds + L_PF) + slot * 512 + (tid & 255); p[0] = pf.x; p[256] = pf.y; }
    DI void operator()(const i32x4 (&acc)[2][2][4][2], const pg8::Unit& u, int wr, int wc, int fr, int fq, int slot, const f32x4& pf, int nslot) const {
        const int row0 = u.pm * 256 + wr * 64 + fr, orow0 = u.ph * 256 + wr * 64 + fr, col0 = u.pn * 128 + wc * 32 + 8 * fq;
        const LAS float* SL = (const LAS float*)(lds + L_PF) + slot * 512;
        float sa[2][4];
#pragma unroll
        for (int ai = 0; ai < 2; ++ai)
#pragma unroll
            for (int m = 0; m < 4; ++m) sa[ai][m] = SL[ai * 128 + wr * 64 + m * 16 + fr];
        const LAS float* swp = SL + 256 + wc * 32 + 8 * fq;
        const f32x4 sg0 = *(const LAS f32x4*)(swp), sg1 = *(const LAS f32x4*)(swp + 4), su0 = *(const LAS f32x4*)(swp + 128), su1 = *(const LAS f32x4*)(swp + 132);
        if (need) { unsigned sp = 0; while ((unsigned)__builtin_amdgcn_readfirstlane(__hip_atomic_load(hidcnt + 64 * u.ph, __ATOMIC_RELAXED, __HIP_MEMORY_SCOPE_AGENT)) < need) { __builtin_amdgcn_s_sleep(2); if (++sp > (1u << 22)) break; } }
        const float sg[8] = {sg0.x, sg0.y, sg0.z, sg0.w, sg1.x, sg1.y, sg1.z, sg1.w}, su[8] = {su0.x, su0.y, su0.z, su0.w, su1.x, su1.y, su1.z, su1.w};
#pragma unroll
        for (int ai = 0; ai < 2; ++ai)
#pragma unroll
            for (int m = 0; m < 4; ++m) { if (ai == 1 && m == 0) post(wc * 64 + fq * 16 + fr, pf, nslot);
                const float r = sa[ai][m] * (1.0f / 127.0f); float v[8];
#pragma unroll
                for (int j = 0; j < 4; ++j) { v[j] = siluf((float)acc[ai][0][m][0][j] * (r * sg[j])) * ((float)acc[ai][1][m][0][j] * (r * su[j]));
                    v[4 + j] = siluf((float)acc[ai][0][m][1][j] * (r * sg[4 + j])) * ((float)acc[ai][1][m][1][j] * (r * su[4 + j])); }
                if constexpr (F8) { int w0 = __builtin_amdgcn_cvt_pk_fp8_f32(v[0], v[1], 0, false); w0 = __builtin_amdgcn_cvt_pk_fp8_f32(v[2], v[3], w0, true);
                    int w1 = __builtin_amdgcn_cvt_pk_fp8_f32(v[4], v[5], 0, false); w1 = __builtin_amdgcn_cvt_pk_fp8_f32(v[6], v[7], w1, true);
                    *(u32x2*)((unsigned char*)O + (size_t)(orow0 + ai * 128 + m * 16) * ld + col0) = (u32x2){(unsigned)w0, (unsigned)w1}; }
                else { u32x4 w; w.x = pg8::cvt_pk_bf16(v[0], v[1]); w.y = pg8::cvt_pk_bf16(v[2], v[3]); w.z = pg8::cvt_pk_bf16(v[4], v[5]); w.w = pg8::cvt_pk_bf16(v[6], v[7]);
                    *(u32x4*)(O + (size_t)(orow0 + ai * 128 + m * 16) * ld + col0) = w; } }
    }
};
typedef EpiGluI8T<false> EpiGluI8;
struct EpiGluF8 {
    static constexpr bool PERM = true, PRE = false;
    unsigned char* O; int ld; unsigned* hidcnt; unsigned need;
    DI void done(const pg8::Unit&, int) const {}
    DI void operator()(const f32x4 (&acc)[2][2][4][2], const pg8::Unit& u, int wr, int wc, int fr, int fq, int slot, const f32x4&, int) const {
        const int orow0 = u.ph * 256 + wr * 64 + fr, col0 = u.pn * 128 + wc * 32 + 8 * fq;
        if (need) { unsigned sp = 0; while ((unsigned)__builtin_amdgcn_readfirstlane(__hip_atomic_load(hidcnt + 64 * u.ph, __ATOMIC_RELAXED, __HIP_MEMORY_SCOPE_AGENT)) < need) { __builtin_amdgcn_s_sleep(2); if (++sp > (1u << 22)) break; } }
#pragma unroll
        for (int ai = 0; ai < 2; ++ai)
#pragma unroll
            for (int m = 0; m < 4; ++m) { float v[8];
#pragma unroll
                for (int n = 0; n < 2; ++n)
#pragma unroll
                    for (int j = 0; j < 4; ++j) { const float t = acc[ai][0][m][n][j]; v[4 * n + j] = (t * acc[ai][1][m][n][j]) * __builtin_amdgcn_rcpf(1.0f + __builtin_amdgcn_exp2f(t)); }
                int w0 = __builtin_amdgcn_cvt_pk_fp8_f32(v[0], v[1], 0, false); w0 = __builtin_amdgcn_cvt_pk_fp8_f32(v[2], v[3], w0, true);
                int w1 = __builtin_amdgcn_cvt_pk_fp8_f32(v[4], v[5], 0, false); w1 = __builtin_amdgcn_cvt_pk_fp8_f32(v[6], v[7], w1, true);
                *(u32x2*)(O + (size_t)(orow0 + ai * 128 + m * 16) * ld + col0) = (u32x2){(unsigned)w0, (unsigned)w1}; }
    }
};
struct EpiMoe2 {
    static constexpr bool PERM = true, PRE = true;
    bf16* xb; const int* rowtok; const float* rowgate; unsigned* hidcnt; LAS unsigned char* lds;
    DI void pre(const pg8::Unit& u, int tid, f32x4& pf) const { const int t = tid & 255; pf.x = __builtin_bit_cast(float, rowtok[u.pm * 256 + t]); pf.y = rowgate[u.pm * 256 + t]; }
    DI void post(int tid, const f32x4& pf, int slot) const { LAS float* p = (LAS float*)(lds + L_PF) + slot * 512 + (tid & 255); p[0] = pf.x; p[256] = pf.y; }
    DI void done(const pg8::Unit& u, int tid) const { if (tid == 0) __hip_atomic_fetch_add(hidcnt + 64 * u.ph, 1u, __ATOMIC_RELAXED, __HIP_MEMORY_SCOPE_AGENT); }
    DI void operator()(const f32x4 (&acc)[2][2][4][2], const pg8::Unit& u, int wr, int wc, int fr, int fq, int slot, const f32x4& pf, int nslot) const {
        const int row0 = u.pm * 256 + wr * 64 + fr, col0 = u.pn * 256 + wc * 32 + 8 * fq;
        int tok[2][4]; float gt[2][4];
#pragma unroll
        for (int ai = 0; ai < 2; ++ai)
#pragma unroll
            for (int m = 0; m < 4; ++m) { const LAS float* p = (const LAS float*)(lds + L_PF) + slot * 512 + ai * 128 + wr * 64 + m * 16 + fr; tok[ai][m] = __builtin_bit_cast(int, p[0]); gt[ai][m] = p[256]; }
        u32x4 bb[2][4][2];
#pragma unroll
        for (int ai = 0; ai < 2; ++ai)
#pragma unroll
            for (int m = 0; m < 4; ++m) { const size_t off = (size_t)(tok[ai][m] < 0 ? 0 : tok[ai][m]) * D + col0;
#pragma unroll
                for (int bj = 0; bj < 2; ++bj) bb[ai][m][bj] = *(const u32x4*)(xb + off + bj * 128); }
        post(wc * 64 + fq * 16 + fr, pf, nslot);
#pragma unroll
        for (int ai = 0; ai < 2; ++ai)
#pragma unroll
            for (int m = 0; m < 4; ++m) {
#pragma unroll
                for (int bj = 0; bj < 2; ++bj) asm volatile("" : "+v"(bb[ai][m][bj]));
                if (tok[ai][m] >= 0) { const size_t off = (size_t)tok[ai][m] * D + col0;
#pragma unroll
                for (int bj = 0; bj < 2; ++bj) { const u32x4 b = bb[ai][m][bj];
                    const f32x4 o0 = (f32x4){bflo(b.x), bfhi(b.x), bflo(b.y), bfhi(b.y)} + gt[ai][m] * acc[ai][bj][m][0], o1 = (f32x4){bflo(b.z), bfhi(b.z), bflo(b.w), bfhi(b.w)} + gt[ai][m] * acc[ai][bj][m][1];
                    u32x4 w; w.x = pg8::cvt_pk_bf16(o0.x, o0.y); w.y = pg8::cvt_pk_bf16(o0.z, o0.w); w.z = pg8::cvt_pk_bf16(o1.x, o1.y); w.w = pg8::cvt_pk_bf16(o1.z, o1.w);
                    *(u32x4*)(xb + off + bj * 128) = w; } } }
    }
};

DI void tr_item(const float* W, int N, const float* kscale, bf16* WT, int ldk, int mode, int add, int item, LAS float* scr, int lane) {
    const int nblk = N / 64, kb = item / nblk, nb = item % nblk, k0 = 64 * kb, n0 = 64 * nb;
    const int drow0 = mode ? (((n0 >> 7) << 8) + (n0 & 127) + add) : n0;
    const int kr = lane >> 4, nc = (lane & 15) * 4;
    f32x4 v[16];
#pragma unroll
    for (int i = 0; i < 16; ++i) v[i] = __builtin_nontemporal_load((const f32x4*)(W + (size_t)(k0 + 4 * i + kr) * N + n0 + nc));
#pragma unroll
    for (int i = 0; i < 16; ++i) { const int kk = 4 * i + kr; f32x4 x = v[i]; if (kscale) x = x * kscale[k0 + kk];
        LAS float* d = scr + kk * 65 + nc; d[0] = x.x; d[1] = x.y; d[2] = x.z; d[3] = x.w; }
    LDS_WAIT(); asm volatile("" ::: "memory");
    const int c = lane & 7;
#pragma unroll
    for (int j = 0; j < 8; ++j) { const int n = (lane >> 3) + 8 * j; const LAS float* sp = scr + (8 * c) * 65 + n;
        u32x4 o; o.x = pk2(sp[0 * 65], sp[1 * 65]); o.y = pk2(sp[2 * 65], sp[3 * 65]); o.z = pk2(sp[4 * 65], sp[5 * 65]); o.w = pk2(sp[6 * 65], sp[7 * 65]);
        *(u32x4*)(WT + (size_t)(drow0 + n) * ldk + k0 + 8 * c) = o; }
    LDS_WAIT(); asm volatile("" ::: "memory");
}
DI void absmax_item(const float* W, int N, const float* ks, unsigned* sw, int add, int item, int lane);
DI void f8_item(const float* W, int N, const float* ks, float mul, unsigned char* dst, int ldk, bool il, int add, int item, LAS float* scr, int lane);
DI void p0_prologue(const Frame& F, const Args& a) {
    LAS float* scr = (LAS float*)(F.lds + F.wave * 16896);
    const int gw = F.vcu * 8 + F.wave, NGW = F.G * 8, lane = F.lane;
    unsigned char* ws = F.ws;
    constexpr int I_IN = 16 * 32, I_OUT = 16 * 16, I_W1 = 16 * 43, I_W2 = 43 * 16, I_QKV = 2 * 2;
    constexpr int NITEMS = 2 * I_IN + 2 * I_OUT + 2 * I_W1 + 24 * I_QKV;
    for (int it = gw; it < NITEMS; it += NGW) {
        int r = it;
        if (r < 2 * I_IN) { const int l = r / I_IN; tr_item(a.in[I_WIN] + (size_t)l * D * DIN, DIN, a.in[I_MIXG] + l * D, (bf16*)(ws + WS_WIN) + (size_t)l * DIN * D, D, 0, 0, r % I_IN, scr, lane); continue; } r -= 2 * I_IN;
        if (r < 2 * I_OUT) { const int l = r / I_OUT; tr_item(a.in[I_WOUT] + (size_t)l * D * D, D, nullptr, (bf16*)(ws + WS_WOUT) + (size_t)l * D * D, D, 0, 0, r % I_OUT, scr, lane); continue; } r -= 2 * I_OUT;
        if (r < I_W1) { absmax_item(a.in[I_DW1], DFF, a.in[I_FFNG], (unsigned*)(ws + WS_SWD), 0, r, lane); continue; } r -= I_W1;
        if (r < I_W1) { absmax_item(a.in[I_DW3], DFF, a.in[I_FFNG], (unsigned*)(ws + WS_SWD), 128, r, lane); continue; } r -= I_W1;
        { const int mtx = r / I_QKV, m = mtx / 8, lh = mtx % 8;
          tr_item(a.in[I_WQ + m] + (size_t)lh * 128 * 128, 128, nullptr, (bf16*)(ws + WS_WQ) + (size_t)mtx * 128 * 128, 128, 0, 0, r % I_QKV, scr, lane); }
    }
    { const int gt = gw * 64 + lane, NGT = NGW * 64; const u32x4 z = (u32x4){0u, 0u, 0u, 0u};
      for (int i = gt; i < 128 * (D / 16); i += NGT) { const int rr = i / (D / 16), c16 = i % (D / 16); const int row = 21 * 256 + (rr < 64 ? 64 + rr : 192 + (rr - 64)); *(u32x4*)((signed char*)(ws + WS_W13) + (size_t)row * D + c16 * 16) = z; }
      for (int i = gt; i < D * 4; i += NGT) { const int row = i / 4, c4 = i % 4; *(u32x4*)(ws + WS_W2 + (size_t)row * DFFP + DFF + c4 * 16) = z; } }
    for (int m0 = gw * 4; m0 < T; m0 += NGW * 4) {
        f32x4 v[4][4];
#pragma unroll
        for (int r = 0; r < 4; ++r) { const f32x4* xr = (const f32x4*)(a.in[I_X] + (size_t)(m0 + r) * D) + lane;
#pragma unroll
            for (int j = 0; j < 4; ++j) v[r][j] = __builtin_nontemporal_load(xr + 64 * j); }
#pragma unroll
        for (int r = 0; r < 4; ++r) { float s_ = 0.f;
#pragma unroll
            for (int j = 0; j < 4; ++j) s_ += (v[r][j].x * v[r][j].x + v[r][j].y * v[r][j].y) + (v[r][j].z * v[r][j].z + v[r][j].w * v[r][j].w);
            s_ = wave_sum(s_);
            u32x2* o8 = (u32x2*)((bf16*)(ws + WS_XB) + (size_t)(m0 + r) * D) + lane;
#pragma unroll
            for (int j = 0; j < 4; ++j) { u32x2 w; w.x = pk2(v[r][j].x, v[r][j].y); w.y = pk2(v[r][j].z, v[r][j].w); o8[64 * j] = w; }
            if (lane < 4) ((float*)(ws + WS_SSQ))[(size_t)(m0 + r) * 4 + lane] = lane == 0 ? s_ : 0.f; }
    }
    for (int it = gw; it < 2 * 16; it += NGW) {
        const int l = it / 16, c = (it % 16) * 64 + lane, part = c >> 9, cc = c & 511, h = cc >> 7, d = cc & 127;
        const float* wif = a.in[I_WIF] + (size_t)l * 1536 * 8;
        float accj[8];
#pragma unroll
        for (int j = 0; j < 8; ++j) accj[j] = 0.f;
        if (part == 0) {
            const float* wq = a.in[I_WQ] + ((size_t)(l * 4 + h) * 128 + d) * 128; const float* wk = a.in[I_WK] + ((size_t)(l * 4 + h) * 128 + d) * 128;
            for (int e = 0; e < 128; ++e) { const float q = wq[e], k = wk[e]; const float* fq_ = wif + (size_t)(128 * h + e) * 8; const float* fk_ = wif + (size_t)(512 + 128 * h + e) * 8;
#pragma unroll
                for (int j = 0; j < 8; ++j) accj[j] += q * fq_[j] + k * fk_[j]; }
        } else {
            const float* wv = a.in[I_WV] + ((size_t)(l * 4 + h) * 128 + d) * 128;
            for (int e = 0; e < 128; ++e) { const float v = wv[e]; const float* fv_ = wif + (size_t)(1024 + 128 * h + e) * 8;
#pragma unroll
                for (int j = 0; j < 8; ++j) accj[j] += v * fv_[j]; }
        }
        bf16* wg = (bf16*)(ws + WS_WG) + (size_t)l * 16 * 1024;
#pragma unroll
        for (int j = 0; j < 8; ++j) { wg[j * 1024 + c] = (bf16)f2bf(accj[j]); wg[(8 + j) * 1024 + c] = 0; }
    }
    { const int gt = gw * 64 + lane, NGT = NGW * 64;
      for (int i = gt; i < 2 * 4 * 128 * 128; i += NGT) { const int ii = (i >> 7) & 127, jj = i & 127; const float v = ((ii >> 6) >= (jj >> 6)) ? a.in[I_WSP][i] : 0.f; ((bf16*)(ws + WS_WSP))[i] = (bf16)f2bf(v); } }
}
DI void absmax_item(const float* W, int N, const float* ks, unsigned* sw, int add, int item, int lane) {
    const int nblk = N / 64, kb = item / nblk, nb = item % nblk, k0 = 64 * kb, n0 = 64 * nb, kr = lane >> 4, nc = (lane & 15) * 4;
    f32x4 v[16];
#pragma unroll
    for (int i = 0; i < 16; ++i) v[i] = __builtin_nontemporal_load((const f32x4*)(W + (size_t)(k0 + 4 * i + kr) * N + n0 + nc));
    f32x4 mx = (f32x4){0.f, 0.f, 0.f, 0.f};
#pragma unroll
    for (int i = 0; i < 16; ++i) { const f32x4 x = v[i] * ks[k0 + 4 * i + kr]; mx.x = fmaxf(mx.x, fabsf(x.x)); mx.y = fmaxf(mx.y, fabsf(x.y)); mx.z = fmaxf(mx.z, fabsf(x.z)); mx.w = fmaxf(mx.w, fabsf(x.w)); }
#pragma unroll
    for (int c = 0; c < 4; ++c) { mx[c] = fmaxf(mx[c], __shfl_xor(mx[c], 16)); mx[c] = fmaxf(mx[c], __shfl_xor(mx[c], 32)); }
    if (kr == 0) { unsigned* p = sw + ((n0 >> 7) << 8) + (n0 & 127) + add + nc;
#pragma unroll
        for (int c = 0; c < 4; ++c) atomicMax(p + c, __builtin_bit_cast(unsigned, mx[c])); }
}
DI void quant_item(const float* W, int N, const float* ks, const float* sw, signed char* dst, int add, int item, LAS float* scr, int lane) {
    const int nblk = N / 64, kb = item / nblk, nb = item % nblk, k0 = 64 * kb, n0 = 64 * nb, kr = lane >> 4, nc = (lane & 15) * 4;
    const int drow0 = ((n0 >> 7) << 8) + (n0 & 127) + add;
    f32x4 v[16];
#pragma unroll
    for (int i = 0; i < 16; ++i) v[i] = __builtin_nontemporal_load((const f32x4*)(W + (size_t)(k0 + 4 * i + kr) * N + n0 + nc));
    const int kq = lane & 3, nl = lane >> 2;
    float inv[4];
#pragma unroll
    for (int j = 0; j < 4; ++j) { const float amax = sw[drow0 + nl + 16 * j]; inv[j] = amax > 0.f ? 127.0f / amax : 0.f; }
#pragma unroll
    for (int i = 0; i < 16; ++i) { const int kk = 4 * i + kr; const f32x4 x = v[i] * ks[k0 + kk]; LAS float* p = scr + kk * 65 + nc; p[0] = x.x; p[1] = x.y; p[2] = x.z; p[3] = x.w; }
    LDS_WAIT(); asm volatile("" ::: "memory");
#pragma unroll
    for (int j = 0; j < 4; ++j) { const int n = nl + 16 * j; u32x4 o;
#pragma unroll
        for (int d = 0; d < 4; ++d) { unsigned wd = 0;
#pragma unroll
            for (int b = 0; b < 4; ++b) { const float q = rintf(scr[(16 * kq + 4 * d + b) * 65 + n] * inv[j]); const int qi = (int)fminf(fmaxf(q, -127.f), 127.f); wd |= ((unsigned)qi & 0xffu) << (8 * b); }
            o[d] = wd; }
        *(u32x4*)(dst + (size_t)(drow0 + n) * D + k0 + 16 * kq) = o; }
    LDS_WAIT(); asm volatile("" ::: "memory");
}
DI void f8_item(const float* W, int N, const float* ks, float mul, unsigned char* dst, int ldk, bool il, int add, int item, LAS float* scr, int lane) {
    const int nblk = N / 64, kb = item / nblk, nb = item % nblk, k0 = 64 * kb, n0 = 64 * nb, kr = lane >> 4, nc = (lane & 15) * 4;
    const int drow0 = il ? ((n0 >> 7) << 8) + (n0 & 127) + add : n0;
    f32x4 v[16];
#pragma unroll
    for (int i = 0; i < 16; ++i) v[i] = __builtin_nontemporal_load((const f32x4*)(W + (size_t)(k0 + 4 * i + kr) * N + n0 + nc));
    const int kq = lane & 3, nl = lane >> 2;
#pragma unroll
    for (int i = 0; i < 16; ++i) { const int kk = 4 * i + kr; const f32x4 x = v[i] * (ks ? ks[k0 + kk] * mul : mul); LAS float* p = scr + kk * 65 + nc; p[0] = x.x; p[1] = x.y; p[2] = x.z; p[3] = x.w; }
    LDS_WAIT(); asm volatile("" ::: "memory");
#pragma unroll
    for (int j = 0; j < 4; ++j) { const int n = nl + 16 * j; u32x4 o;
#pragma unroll
        for (int d = 0; d < 4; ++d) { const LAS float* q = scr + (16 * kq + 4 * d) * 65 + n;
            int wd = __builtin_amdgcn_cvt_pk_fp8_f32(q[0], q[65], 0, false); wd = __builtin_amdgcn_cvt_pk_fp8_f32(q[130], q[195], wd, true); o[d] = (unsigned)wd; }
        *(u32x4*)(dst + (size_t)(drow0 + n) * ldk + k0 + 16 * kq) = o; }
    LDS_WAIT(); asm volatile("" ::: "memory");
}
DI void moe_weights(const Frame& F, const Args& a, int wgi, int nwg) {
    LAS float* scr = (LAS float*)(F.lds + F.wave * 16896);
    const int gw = wgi * 8 + F.wave, NGW = nwg * 8, lane = F.lane;
    constexpr int I_1 = 16 * 56, I_2 = 56 * 16;
    constexpr int NITEMS = 16 * I_1 + 8 * I_2;
    for (int it = gw; it < NITEMS; it += NGW) {
        int r = it;
        if (r < 16 * I_1) { const int m = r / I_1, e = m >> 1, w3 = m & 1;
            f8_item(a.in[w3 ? I_MW3 : I_MW1] + (size_t)e * D * DFE, DFE, a.in[I_FFNG] + D, w3 ? -64.0f * 0.69314718056f : -64.0f * 1.44269504089f, F.ws + WS_MW13 + (size_t)e * (2 * DFE) * D, D, true, w3 ? 128 : 0, r % I_1, scr, lane); continue; }
        r -= 16 * I_1;
        { const int e = r / I_2; f8_item(a.in[I_MW2] + (size_t)e * DFE * D, D, nullptr, 64.0f, F.ws + WS_MW2 + (size_t)e * D * DFE, DFE, false, 0, r % I_2, scr, lane); }
    }
}
DI void dense_quant(const Frame& F, const Args& a) {
    LAS float* scr = (LAS float*)(F.lds + F.wave * 16896);
    const int gw = F.vcu * 8 + F.wave, NGW = F.G * 8, lane = F.lane;
    constexpr int I_1 = 16 * 43, I_W2 = 43 * 16;
    for (int it = gw; it < 2 * I_1 + I_W2; it += NGW) { const int w3 = it / I_1;
        if (it >= 2 * I_1) { f8_item(a.in[I_DW2], D, nullptr, 64.0f, F.ws + WS_W2, DFFP, false, 0, it - 2 * I_1, scr, lane); continue; }
        quant_item(a.in[w3 ? I_DW3 : I_DW1], DFF, a.in[I_FFNG], (const float*)(F.ws + WS_SWD), (signed char*)(F.ws + WS_W13), w3 ? 128 : 0, it % I_1, scr, lane); }
}
DI void rows_to_int8(const Frame& F) {
    unsigned char* ws = F.ws; const int gw = F.vcu * 8 + F.wave, NGW = F.G * 8, lane = F.lane;
    const bf16* xb = (const bf16*)(ws + WS_XB); const float* ssq = (const float*)(ws + WS_SSQ);
    u32x4 va[4], vb[4], na[4], nb[4];
#define RQ_LOAD(A_, B_, mbase) do { _Pragma("unroll") for (int r = 0; r < 4; ++r) { const u32x4* p_ = (const u32x4*)(xb + (size_t)((mbase) + r) * D) + lane; A_[r] = p_[0]; B_[r] = p_[64]; } } while (0)
    int m0 = gw * 4; if (m0 >= T) return;
    RQ_LOAD(va, vb, m0);
#pragma unroll 1
    for (;;) { const int mn = m0 + NGW * 4; const bool more = mn < T;
        if (more) RQ_LOAD(na, nb, mn);
#pragma unroll
        for (int r = 0; r < 4; ++r) { const int m = m0 + r; const float rs = rs_from(*(const f32x4*)(ssq + (size_t)m * 4));
            const unsigned wv[8] = {va[r].x, va[r].y, va[r].z, va[r].w, vb[r].x, vb[r].y, vb[r].z, vb[r].w};
            float am = 0.f;
#pragma unroll
            for (int i = 0; i < 8; ++i) am = fmaxf(am, fmaxf(fabsf(bflo(wv[i])), fabsf(bfhi(wv[i]))));
            am = wave_max(am) * rs; const float inv = am > 0.f ? 127.0f / am : 0.f, qs = rs * inv;
            unsigned o[4];
#pragma unroll
            for (int i = 0; i < 4; ++i) { const int q0 = (int)rintf(bflo(wv[2 * i]) * qs), q1 = (int)rintf(bfhi(wv[2 * i]) * qs), q2 = (int)rintf(bflo(wv[2 * i + 1]) * qs), q3 = (int)rintf(bfhi(wv[2 * i + 1]) * qs);
                o[i] = ((unsigned)q0 & 0xffu) | (((unsigned)q1 & 0xffu) << 8) | (((unsigned)q2 & 0xffu) << 16) | (((unsigned)q3 & 0xffu) << 24); }
            u32x2* d8 = (u32x2*)((signed char*)(ws + WS_XB8D) + (size_t)m * D) + lane;
            d8[0] = (u32x2){o[0], o[1]}; d8[64] = (u32x2){o[2], o[3]};
            if (lane == 0) ((float*)(ws + WS_SA))[m] = am * (1.0f / 127.0f); }
        if (!more) break;
        m0 = mn;
#pragma unroll
        for (int r = 0; r < 4; ++r) { va[r] = na[r]; vb[r] = nb[r]; } }
#undef RQ_LOAD
}

struct Mix { int l; const bf16* proj; const float *convw, *convb, *bif, *skip, *mhg, *gmvg, *bsp, *gmog; const bf16 *wg, *wq, *wk, *wv, *wsp; };
constexpr int L_XM = 0, L_XC = 18432, L_Q = 35840, L_K = 53248, L_KTW = 70656, L_VT = 89088, L_SM = 110592;
constexpr int L_RED = L_Q;
constexpr int S128 = 272, S64 = 144;
DI bf16x8 ldf(const LAS unsigned char* p) { return *(const LAS bf16x8*)p; }

DI void load_xm_conv(const Frame& F, const Mix& M, int t0, bool first, int h) {
    LAS unsigned char* lds = F.lds; const int tid = F.tid;
#pragma unroll
    for (int it = 0; it < 3; ++it) { const int p = tid + 512 * it; if (p < 67 * 16) { const int row = p >> 4, c16 = p & 15; u32x4 v = (u32x4){0u, 0u, 0u, 0u};
        if (!(first && row < 3)) v = *(const u32x4*)(M.proj + (size_t)(t0 - 3 + row) * DIN + h * 128 + c16 * 8);
        *(LAS u32x4*)(lds + L_XM + row * S128 + c16 * 16) = v; } }
    const int cg = tid & 15, ch = h * 128 + cg * 8;
    float cw[4][8], cb[8];
#pragma unroll
    for (int j = 0; j < 4; ++j) { const f32x4 a = *(const f32x4*)(M.convw + j * 512 + ch), b = *(const f32x4*)(M.convw + j * 512 + ch + 4);
        cw[j][0] = a.x; cw[j][1] = a.y; cw[j][2] = a.z; cw[j][3] = a.w; cw[j][4] = b.x; cw[j][5] = b.y; cw[j][6] = b.z; cw[j][7] = b.w; }
    { const f32x4 a = *(const f32x4*)(M.convb + ch), b = *(const f32x4*)(M.convb + ch + 4); cb[0] = a.x; cb[1] = a.y; cb[2] = a.z; cb[3] = a.w; cb[4] = b.x; cb[5] = b.y; cb[6] = b.z; cb[7] = b.w; }
    __syncthreads();
#pragma unroll
    for (int it = 0; it < 2; ++it) { const int t = (tid >> 4) + 32 * it; float y[8];
#pragma unroll
        for (int c = 0; c < 8; ++c) y[c] = cb[c];
#pragma unroll
        for (int j = 0; j < 4; ++j) { const u32x4 x = *(const LAS u32x4*)(lds + L_XM + (t + j) * S128 + cg * 16);
            y[0] += cw[j][0] * bflo(x.x); y[1] += cw[j][1] * bfhi(x.x); y[2] += cw[j][2] * bflo(x.y); y[3] += cw[j][3] * bfhi(x.y);
            y[4] += cw[j][4] * bflo(x.z); y[5] += cw[j][5] * bfhi(x.z); y[6] += cw[j][6] * bflo(x.w); y[7] += cw[j][7] * bfhi(x.w); }
        u32x4 o; o.x = pk2(siluf(y[0]), siluf(y[1])); o.y = pk2(siluf(y[2]), siluf(y[3])); o.z = pk2(siluf(y[4]), siluf(y[5])); o.w = pk2(siluf(y[6]), siluf(y[7]));
        *(LAS u32x4*)(lds + L_XC + t * S128 + cg * 16) = o; }
    __syncthreads();
}

DI void mlstm_local_unit(const Frame& F, const Mix& M, int u) {
    LAS unsigned char* lds = F.lds; const int tid = F.tid, lane = F.lane, w = F.wave, fr = lane & 15, fq = lane >> 4;
    const int t0 = u * CH; const bool first = (u % NCH) == 0; const int bb = u / NCH, cc = u % NCH;
    LAS float* IG = (LAS float*)(lds + L_SM); LAS float* BBs = IG + 256; LAS float* WSC = IG + 512;
    unsigned char* ws = F.ws;
    if (tid < 16 * 8) { const int row = 128 + (tid >> 3), c = tid & 7; const unsigned v = (row == 128) ? 0x3f803f80u : 0u; *(LAS u32x4*)(lds + L_VT + row * S64 + c * 16) = (u32x4){v, v, v, v}; }
    f32x4 accg[4];
#pragma unroll
    for (int tt = 0; tt < 4; ++tt) accg[tt] = (f32x4){0.f, 0.f, 0.f, 0.f};
    for (int h = 0; h < 4; ++h) {
        load_xm_conv(F, M, t0, first, h);
        const int cbase = (w < 4) ? (h * 128 + 32 * w) : (512 + h * 128 + 32 * (w - 4));
        const bf16x8 a = *(const bf16x8*)(M.wg + (size_t)fr * 1024 + cbase + 8 * fq);
#pragma unroll
        for (int tt = 0; tt < 4; ++tt) { const int t = 16 * tt + fr;
            const bf16x8 b = (w < 4) ? ldf(lds + L_XC + t * S128 + (32 * w + 8 * fq) * 2) : ldf(lds + L_XM + (t + 3) * S128 + (32 * (w - 4) + 8 * fq) * 2);
            accg[tt] = MFMA16(a, b, accg[tt]); }
        __syncthreads();
    }
    if (fq < 2) {
#pragma unroll
        for (int tt = 0; tt < 4; ++tt)
#pragma unroll
            for (int r = 0; r < 4; ++r) *(LAS float*)(lds + L_RED + ((w * 8 + 4 * fq + r) * 64 + 16 * tt + fr) * 4) = accg[tt][r];
    }
    __syncthreads();
    { float pre = M.bif[w];
#pragma unroll
      for (int ww = 0; ww < 8; ++ww) pre += *(const LAS float*)(lds + L_RED + ((ww * 8 + w) * 64 + lane) * 4);
      if (w < 4) IG[w * 64 + lane] = pre;
      else { float lf = fminf(pre, 0.f) - softplus_neg(fabsf(pre));
#pragma unroll
          for (int o = 1; o < 64; o <<= 1) { const float v = __shfl_up(lf, o); if (lane >= o) lf += v; }
          BBs[(w - 4) * 64 + lane] = lf; } }
    __syncthreads();
    if (w < 4) { const float bt = BBs[w * 64 + lane], g = IG[w * 64 + lane] - bt, gmax = wave_max(g), bend = BBs[w * 64 + 63];
        WSC[w * 64 + lane] = fexp(g - gmax);
        float* gb = (float*)(ws + WS_GB) + (size_t)(u * 4 + w) * 128; gb[lane] = bt; gb[64 + lane] = g;
        if (lane == 0) { float* sc = (float*)(ws + WS_SC) + ((size_t)(bb * 4 + w) * NCH + cc) * 2; sc[0] = bend; sc[1] = bend + gmax; } }
    __syncthreads();
    for (int h = 0; h < 4; ++h) {
        load_xm_conv(F, M, t0, first, h);
        const int lh = M.l * 4 + h;
        bf16x8 aq[4], bk[4], bv[4];
#pragma unroll
        for (int ks = 0; ks < 4; ++ks) { const size_t o = ((size_t)lh * 128 + 16 * w + fr) * 128 + 32 * ks + 8 * fq;
            aq[ks] = *(const bf16x8*)(M.wq + o); bk[ks] = *(const bf16x8*)(M.wk + o); bv[ks] = *(const bf16x8*)(M.wv + o); }
#pragma unroll
        for (int tt = 0; tt < 4; ++tt) {
            bf16x8 xcf[4], xmf[4];
#pragma unroll
            for (int ks = 0; ks < 4; ++ks) { xcf[ks] = ldf(lds + L_XC + (16 * tt + fr) * S128 + (32 * ks + 8 * fq) * 2); xmf[ks] = ldf(lds + L_XM + (16 * tt + fr + 3) * S128 + (32 * ks + 8 * fq) * 2); }
            f32x4 cq = (f32x4){0.f, 0.f, 0.f, 0.f}, ck = cq, ckt = cq, cv = cq;
#pragma unroll
            for (int ks = 0; ks < 4; ++ks) { cq = MFMA16(aq[ks], xcf[ks], cq); ck = MFMA16(bk[ks], xcf[ks], ck); ckt = MFMA16(xcf[ks], bk[ks], ckt); cv = MFMA16(xmf[ks], bv[ks], cv); }
            { const int t = 16 * tt + fr, e = 16 * w + 4 * fq;
              u32x2 o; o.x = pk2(cq[0] * 0.08838834764831845f, cq[1] * 0.08838834764831845f); o.y = pk2(cq[2] * 0.08838834764831845f, cq[3] * 0.08838834764831845f);
              *(LAS u32x2*)(lds + L_Q + t * S128 + e * 2) = o;
              o.x = pk2(ck[0], ck[1]); o.y = pk2(ck[2], ck[3]); *(LAS u32x2*)(lds + L_K + t * S128 + e * 2) = o; }
            { const int s = 16 * tt + 4 * fq, e = 16 * w + fr;
              const f32x4 wv = *(const LAS f32x4*)(WSC + h * 64 + s);
              u32x2 o; o.x = pk2(ckt[0] * wv.x, ckt[1] * wv.y); o.y = pk2(ckt[2] * wv.z, ckt[3] * wv.w); *(LAS u32x2*)(lds + L_KTW + e * S64 + s * 2) = o;
              o.x = pk2(cv[0], cv[1]); o.y = pk2(cv[2], cv[3]); *(LAS u32x2*)(lds + L_VT + e * S64 + s * 2) = o; }
        }
        __syncthreads();
        { bf16* qg = (bf16*)(ws + WS_QG) + (size_t)(u * 4 + h) * 8192; bf16* kg = (bf16*)(ws + WS_KG) + (size_t)(u * 4 + h) * 8192; bf16* vg = (bf16*)(ws + WS_VG) + (size_t)(u * 4 + h) * 8192;
#pragma unroll
          for (int i = 0; i < 2; ++i) { const int p = tid + 512 * i; { const int row = p >> 4, c16 = p & 15;
              *(u32x4*)(qg + row * 128 + c16 * 8) = *(const LAS u32x4*)(lds + L_Q + row * S128 + c16 * 16); *(u32x4*)(kg + row * 128 + c16 * 8) = *(const LAS u32x4*)(lds + L_K + row * S128 + c16 * 16); }
              { const int row = p >> 3, c8 = p & 7; *(u32x4*)(vg + row * 64 + c8 * 8) = *(const LAS u32x4*)(lds + L_VT + row * S64 + c8 * 16); } } }
        { bf16x8 ak[2];
#pragma unroll
          for (int ks = 0; ks < 2; ++ks) ak[ks] = ldf(lds + L_KTW + (16 * w + fr) * S64 + (32 * ks + 8 * fq) * 2);
          bf16* st = (bf16*)(ws + WS_ST) + (size_t)(u * 4 + h) * 144 * 128;
#pragma unroll
          for (int vt = 0; vt < 9; ++vt) { f32x4 c = (f32x4){0.f, 0.f, 0.f, 0.f};
#pragma unroll
              for (int ks = 0; ks < 2; ++ks) c = MFMA16(ak[ks], ldf(lds + L_VT + (16 * vt + fr) * S64 + (32 * ks + 8 * fq) * 2), c);
              u32x2 o; o.x = pk2(c[0], c[1]); o.y = pk2(c[2], c[3]); *(u32x2*)(st + (size_t)(16 * vt + fr) * 128 + 16 * w + 4 * fq) = o; } }
        __syncthreads();
    }
}

DI bf16x8 cat2(u32x2 a, u32x2 b) { u32x4 o; o.x = a.x; o.y = a.y; o.z = b.x; o.w = b.y; return __builtin_bit_cast(bf16x8, o); }
constexpr int L3_XC = 0, S3_XC = 1040;
constexpr int L3_XM = 66560;
constexpr int L3_VT = 85504, L3_VT2 = 106496;
constexpr int L3_SM = 127232;
constexpr int L3_CW = 130304;
#ifndef PROBE_P1
#define PROBE_P1 0
#endif
#ifndef PROBE_ST
#define PROBE_ST 0
#endif
#ifndef PROBE_A
#define PROBE_A 0
#endif
#ifndef PROBE_B
#define PROBE_B 0
#endif
#ifndef PROBE_P2
#define PROBE_P2 0
#endif
DI void mlstm_local3(const Frame& F, const Mix& M, int u) {
    LAS unsigned char* lds = F.lds; const int tid = F.tid, lane = F.lane, w = F.wave, fr = lane & 15, fq = lane >> 4;
    const int t0 = u * CH; const bool first = (u % NCH) == 0; const int bb = u / NCH, cc = u % NCH;
    LAS float* IG = (LAS float*)(lds + L3_SM); LAS float* BBs = IG + 256; LAS float* WSC = IG + 512;
    unsigned char* ws = F.ws;
    { const int b = tid >> 8, i = tid & 255, row = 128 + (i >> 4), c = i & 15; const unsigned v = (row == 128) ? 0x3f803f80u : 0u; LAS unsigned* p = (LAS unsigned*)(lds + (b ? L3_VT2 : L3_VT) + row * S64 + c * 8); p[0] = v; p[1] = v; }
    u32x4 xq[3];
#define L3_LOADX(hh) do { _Pragma("unroll") for (int it = 0; it < 3; ++it) { const int p = tid + 512 * it; xq[it] = (u32x4){0u, 0u, 0u, 0u}; if (p < 67 * 16) { const int row = p >> 4, c16 = p & 15; \
        if (!(first && row < 3)) xq[it] = *(const u32x4*)(M.proj + (size_t)(t0 - 3 + row) * DIN + (hh) * 128 + c16 * 8); } } } while (0)
#define L3_STOREX() do { _Pragma("unroll") for (int it = 0; it < 3; ++it) { const int p = tid + 512 * it; if (p < 67 * 16) { const int row = p >> 4, c16 = p & 15; *(LAS u32x4*)(lds + L3_XM + row * S128 + c16 * 16) = xq[it]; } } } while (0)
    f32x4 accg[4];
#pragma unroll 1
    for (int rp1 = 0; rp1 < 1 + PROBE_P1; ++rp1) {
    L3_LOADX(0);
#pragma unroll
    for (int tt = 0; tt < 4; ++tt) accg[tt] = (f32x4){0.f, 0.f, 0.f, 0.f};
#pragma unroll 1
    for (int h = 0; h < 4; ++h) {
        L3_STOREX();
        const int cg = tid & 15, ch = h * 128 + cg * 8;
        float cw[4][8], cb[8];
        { const LAS float* CWL = (const LAS float*)(lds + L3_CW);
#pragma unroll
          for (int j = 0; j < 4; ++j) { const f32x4 a = *(const LAS f32x4*)(CWL + j * 512 + ch), b = *(const LAS f32x4*)(CWL + j * 512 + ch + 4);
              cw[j][0] = a.x; cw[j][1] = a.y; cw[j][2] = a.z; cw[j][3] = a.w; cw[j][4] = b.x; cw[j][5] = b.y; cw[j][6] = b.z; cw[j][7] = b.w; }
          { const f32x4 a = *(const LAS f32x4*)(CWL + 2048 + ch), b = *(const LAS f32x4*)(CWL + 2048 + ch + 4); cb[0] = a.x; cb[1] = a.y; cb[2] = a.z; cb[3] = a.w; cb[4] = b.x; cb[5] = b.y; cb[6] = b.z; cb[7] = b.w; } }
        __syncthreads();
        if (h < 3) L3_LOADX(h + 1);
        bf16* xcg = (bf16*)(ws + WS_XCG) + ((size_t)u * 4 + h) * 8192;
#pragma unroll 1
        for (int it = 0; it < 2; ++it) { const int t = (tid >> 4) + 32 * it; float y[8];
#pragma unroll
            for (int c = 0; c < 8; ++c) y[c] = cb[c];
#pragma unroll
            for (int j = 0; j < 4; ++j) { const u32x4 x = *(const LAS u32x4*)(lds + L3_XM + (t + j) * S128 + cg * 16);
                y[0] += cw[j][0] * bflo(x.x); y[1] += cw[j][1] * bfhi(x.x); y[2] += cw[j][2] * bflo(x.y); y[3] += cw[j][3] * bfhi(x.y);
                y[4] += cw[j][4] * bflo(x.z); y[5] += cw[j][5] * bfhi(x.z); y[6] += cw[j][6] * bflo(x.w); y[7] += cw[j][7] * bfhi(x.w); }
            u32x4 o; o.x = pk2(siluf(y[0]), siluf(y[1])); o.y = pk2(siluf(y[2]), siluf(y[3])); o.z = pk2(siluf(y[4]), siluf(y[5])); o.w = pk2(siluf(y[6]), siluf(y[7]));
            *(LAS u32x4*)(lds + L3_XC + t * S3_XC + (h * 128 + cg * 8) * 2) = o;
            *(u32x4*)(xcg + (size_t)t * 128 + cg * 8) = o; }
        const int cbase = (w < 4) ? (h * 128 + 32 * w) : (512 + h * 128 + 32 * (w - 4));
        const bf16x8 ag = *(const bf16x8*)(M.wg + (size_t)fr * 1024 + cbase + 8 * fq);
        __syncthreads();
#pragma unroll
        for (int tt = 0; tt < 4; ++tt) { const int t = 16 * tt + fr;
            const bf16x8 b = (w < 4) ? ldf(lds + L3_XC + t * S3_XC + (h * 128 + 32 * w + 8 * fq) * 2) : ldf(lds + L3_XM + (t + 3) * S128 + (32 * (w - 4) + 8 * fq) * 2);
            accg[tt] = MFMA16(ag, b, accg[tt]); }
        __syncthreads();
    }
    }
    if (fq < 2) {
#pragma unroll
        for (int tt = 0; tt < 4; ++tt)
#pragma unroll
            for (int r = 0; r < 4; ++r) *(LAS float*)(lds + L3_VT2 + ((w * 8 + 4 * fq + r) * 64 + 16 * tt + fr) * 4) = accg[tt][r];
    }
    __syncthreads();
    { float pre = M.bif[w];
#pragma unroll
      for (int ww = 0; ww < 8; ++ww) pre += *(const LAS float*)(lds + L3_VT2 + ((ww * 8 + w) * 64 + lane) * 4);
      if (w < 4) IG[w * 64 + lane] = pre;
      else { float lf = fminf(pre, 0.f) - softplus_neg(fabsf(pre));
#pragma unroll
          for (int o = 1; o < 64; o <<= 1) { const float v = __shfl_up(lf, o); if (lane >= o) lf += v; }
          BBs[(w - 4) * 64 + lane] = lf; } }
    __syncthreads();
    if (w < 4) { const float bt = BBs[w * 64 + lane], g = IG[w * 64 + lane] - bt, gmax = wave_max(g), bend = BBs[w * 64 + 63];
        WSC[w * 64 + lane] = fexp(g - gmax);
        float* gb = (float*)(ws + WS_GB) + (size_t)(u * 4 + w) * 128; gb[lane] = bt; gb[64 + lane] = g;
        if (lane == 0) { float* sc = (float*)(ws + WS_SC) + ((size_t)(bb * 4 + w) * NCH + cc) * 2; sc[0] = bend; sc[1] = bend + gmax; } }
    __syncthreads();
    bf16x8 aq[4], bk[4], bv[4], nq[4], nk[4], nv[4];
#define L3_LOADW(hh, Q_, K_, V_) do { _Pragma("unroll") for (int ks = 0; ks < 4; ++ks) { const size_t o_ = ((size_t)(M.l * 4 + (hh)) * 128 + 16 * w + fr) * 128 + 32 * ks + 8 * fq; \
        Q_[ks] = *(const bf16x8*)(M.wq + o_); K_[ks] = *(const bf16x8*)(M.wk + o_); V_[ks] = *(const bf16x8*)(M.wv + o_); } } while (0)
    L3_LOADW(0, aq, bk, bv);
    L3_LOADX(0);
#pragma unroll 1
    for (int h = 0; h < 4; ++h) {
        L3_STOREX(); __syncthreads();
        const size_t uh = (size_t)u * 4 + h;
        LAS unsigned char* VT = lds + ((h & 1) ? L3_VT2 : L3_VT);
        bf16* qg = (bf16*)(ws + WS_QG) + uh * 8192; bf16* kg = (bf16*)(ws + WS_KG) + uh * 8192; bf16* vg = (bf16*)(ws + WS_VG) + uh * 8192; bf16* st = (bf16*)(ws + WS_ST) + uh * 144 * 128;
        u32x2 KP[4], QO[4], KO[4], VO[4];
#pragma unroll 1
        for (int _pa = 0; _pa < 1 + PROBE_A; ++_pa) {
#pragma unroll
        for (int tt = 0; tt < 4; ++tt) {
            bf16x8 xcf[4], xmf[4];
#pragma unroll
            for (int ks = 0; ks < 4; ++ks) { xcf[ks] = ldf(lds + L3_XC + (16 * tt + fr) * S3_XC + (h * 128 + 32 * ks + 8 * fq) * 2); xmf[ks] = ldf(lds + L3_XM + (16 * tt + fr + 3) * S128 + (32 * ks + 8 * fq) * 2); }
            f32x4 cq = (f32x4){0.f, 0.f, 0.f, 0.f}, ck = cq, ckt = cq, cv = cq;
#pragma unroll
            for (int ks = 0; ks < 4; ++ks) { cq = MFMA16(aq[ks], xcf[ks], cq); ck = MFMA16(bk[ks], xcf[ks], ck); ckt = MFMA16(xcf[ks], bk[ks], ckt); cv = MFMA16(xmf[ks], bv[ks], cv); }
            QO[tt].x = pk2(cq[0] * 0.08838834764831845f, cq[1] * 0.08838834764831845f); QO[tt].y = pk2(cq[2] * 0.08838834764831845f, cq[3] * 0.08838834764831845f);
            KO[tt].x = pk2(ck[0], ck[1]); KO[tt].y = pk2(ck[2], ck[3]);
            { const int s = 16 * tt + 4 * fq, e = 16 * w + fr;
              const f32x4 wv = *(const LAS f32x4*)(WSC + h * 64 + s);
              KP[tt].x = pk2(ckt[0] * wv.x, ckt[1] * wv.y); KP[tt].y = pk2(ckt[2] * wv.z, ckt[3] * wv.w);
              VO[tt].x = pk2(cv[0], cv[1]); VO[tt].y = pk2(cv[2], cv[3]); *(LAS u32x2*)(VT + e * S64 + s * 2) = VO[tt]; }
        }
        }
        if (h < 3) { L3_LOADX(h + 1); L3_LOADW(h + 1, nq, nk, nv); }
#pragma unroll
        for (int tt = 0; tt < 4; ++tt) { const size_t off = (size_t)((tt * 8 + w) * 256 + fr * 16 + 4 * fq);
            for (int _r = 0; _r < 1 + PROBE_ST; ++_r) { *(u32x2*)(qg + off) = QO[tt]; *(u32x2*)(kg + off) = KO[tt]; *(u32x2*)(vg + (size_t)((w * 4 + tt) * 256 + fr * 16 + 4 * fq)) = VO[tt]; asm volatile("" ::: "memory"); } }
        __syncthreads();
#pragma unroll 1
        for (int _pb = 0; _pb < 1 + PROBE_B; ++_pb)
        { const bf16x8 ak0 = cat2(KP[0], KP[1]), ak1 = cat2(KP[2], KP[3]);
#pragma unroll
          for (int vt = 0; vt < 9; ++vt) { const LAS unsigned char* vr = VT + (16 * vt + fr) * S64 + 8 * fq;
              const u32x2 v0 = *(const LAS u32x2*)(vr), v1 = *(const LAS u32x2*)(vr + 32), v2 = *(const LAS u32x2*)(vr + 64), v3 = *(const LAS u32x2*)(vr + 96);
              f32x4 c = (f32x4){0.f, 0.f, 0.f, 0.f}; c = MFMA16(ak0, cat2(v0, v1), c); c = MFMA16(ak1, cat2(v2, v3), c);
              u32x2 o; o.x = pk2(c[0], c[1]); o.y = pk2(c[2], c[3]); for (int _r = 0; _r < 1 + PROBE_ST; ++_r) { *(u32x2*)(st + (size_t)((vt * 8 + w) * 256 + fr * 16 + 4 * fq)) = o; asm volatile("" ::: "memory"); } } }
#pragma unroll
        for (int ks = 0; ks < 4; ++ks) { aq[ks] = nq[ks]; bk[ks] = nk[ks]; bv[ks] = nv[ks]; }
    }
    __syncthreads();
#undef L3_LOADW
#undef L3_LOADX
#undef L3_STOREX
}

constexpr int L_VNT = 0;
constexpr int L_MU = 36864;
DI void gmlp_unit(const Frame& F, const Mix& M, int ub) {
    LAS unsigned char* lds = F.lds; const int tid = F.tid, lane = F.lane, w = F.wave, fr = lane & 15, fq = lane >> 4;
    const int t0 = ub * 128;
    LAS float* MU = (LAS float*)(lds + L_MU); LAS float* RS = MU + 128; LAS float* GOL = MU + 256; LAS float* GVL = MU + 768;
    GOL[tid] = M.gmog[tid]; GVL[tid] = M.gmvg[tid];
    if (tid < 128) { const f32x4* p = (const f32x4*)((const float*)(F.ws + WS_VST) + (size_t)(t0 + tid) * 16); const f32x4 a = p[0], b = p[1], c = p[2], d = p[3];
        const float s1 = (a.x + a.z) + (b.x + b.z) + (c.x + c.z) + (d.x + d.z), s2 = (a.y + a.w) + (b.y + b.w) + (c.y + c.w) + (d.y + d.w);
        const float mu = s1 * (1.0f / 512.0f), var = fmaxf(s2 * (1.0f / 512.0f) - mu * mu, 0.f); MU[tid] = mu; RS[tid] = 1.0f / sqrtf(var + EPS); }
    float ss = 0.f;
    const int i_tok = 16 * w + fr;
    bf16* py = (bf16*)(F.ws + WS_Y) + (size_t)(t0 + i_tok) * D + 512 + 8 * fq;
    const int j = tid & 127, cq = tid >> 7;
    u32x4 xv[4]; bf16x8 bwn[4]; u32x4 ugn[4]; float biasn;
#define GM_ISSUE(g) do { const bf16* pv_ = M.proj + (size_t)(t0 + j) * DIN + 1536 + (g) * 128 + 32 * cq; _Pragma("unroll") for (int i = 0; i < 4; ++i) xv[i] = *(const u32x4*)(pv_ + 8 * i); \
        const bf16* pw_ = M.wsp + ((size_t)(M.l * 4 + (g)) * 128 + i_tok) * 128 + 8 * fq; _Pragma("unroll") for (int ks = 0; ks < 4; ++ks) bwn[ks] = *(const bf16x8*)(pw_ + 32 * ks); \
        biasn = M.bsp[(g) * 128 + i_tok]; const bf16* pu_ = M.proj + (size_t)(t0 + i_tok) * DIN + 1024 + (g) * 128 + 8 * fq; _Pragma("unroll") for (int p = 0; p < 4; ++p) ugn[p] = *(const u32x4*)(pu_ + 32 * p); } while (0)
    GM_ISSUE(0);
    __syncthreads();
#pragma unroll 1
    for (int g = 0; g < 4; ++g) {
        { const float mu = MU[j], rs = RS[j];
#pragma unroll
          for (int i = 0; i < 4; ++i) { const int c0 = 32 * cq + 8 * i; const u32x4 x = xv[i];
              const f32x4 ga = *(const LAS f32x4*)(GVL + g * 128 + c0), gb = *(const LAS f32x4*)(GVL + g * 128 + c0 + 4);
              const float v[8] = {(bflo(x.x) - mu) * rs * ga.x, (bfhi(x.x) - mu) * rs * ga.y, (bflo(x.y) - mu) * rs * ga.z, (bfhi(x.y) - mu) * rs * ga.w,
                                  (bflo(x.z) - mu) * rs * gb.x, (bfhi(x.z) - mu) * rs * gb.y, (bflo(x.w) - mu) * rs * gb.z, (bfhi(x.w) - mu) * rs * gb.w};
#pragma unroll
              for (int c = 0; c < 8; ++c) *(LAS bf16*)(lds + L_VNT + (32 * cq + 16 * (c >> 2) + 4 * i + (c & 3)) * S128 + j * 2) = (bf16)f2bf(v[c]); } }
        bf16x8 bw[4]; u32x4 ugv[4]; const float bias = biasn;
#pragma unroll
        for (int ks = 0; ks < 4; ++ks) bw[ks] = bwn[ks];
#pragma unroll
        for (int p = 0; p < 4; ++p) ugv[p] = ugn[p];
        __syncthreads();
        if (g < 3) GM_ISSUE(g + 1);
#pragma unroll
        for (int p = 0; p < 4; ++p) { f32x4 ce = (f32x4){0.f, 0.f, 0.f, 0.f}, co = ce;
#pragma unroll
            for (int ks = 0; ks < 4; ++ks) { ce = MFMA16(ldf(lds + L_VNT + (32 * p + fr) * S128 + (32 * ks + 8 * fq) * 2), bw[ks], ce); co = MFMA16(ldf(lds + L_VNT + (32 * p + 16 + fr) * S128 + (32 * ks + 8 * fq) * 2), bw[ks], co); }
            const u32x4 ug = ugv[p];
            u32x4 o; o.x = pk2(bflo(ug.x) * (ce[0] + bias), bfhi(ug.x) * (ce[1] + bias)); o.y = pk2(bflo(ug.y) * (ce[2] + bias), bfhi(ug.y) * (ce[3] + bias));
            o.z = pk2(bflo(ug.z) * (co[0] + bias), bfhi(ug.z) * (co[1] + bias)); o.w = pk2(bflo(ug.w) * (co[2] + bias), bfhi(ug.w) * (co[3] + bias));
#pragma unroll
            for (int q = 0; q < 4; ++q) { const float z0 = bflo(o[q]), z1 = bfhi(o[q]); ss += z0 * z0 + z1 * z1; }
            *(u32x4*)(py + g * 128 + 32 * p) = o; }
        __syncthreads();
    }
#undef GM_ISSUE
    ss += __shfl_xor(ss, 16); ss += __shfl_xor(ss, 32);
    const float r = 1.0f / sqrtf(ss * (1.0f / 512.0f) + EPS);
    VM_WAIT();
    u32x4 yv[4][4];
#pragma unroll
    for (int g = 0; g < 4; ++g)
#pragma unroll
        for (int p = 0; p < 4; ++p) yv[g][p] = *(const u32x4*)(py + g * 128 + 32 * p);
#pragma unroll
    for (int g = 0; g < 4; ++g)
#pragma unroll
        for (int p = 0; p < 4; ++p) { const f32x4 g0 = *(const LAS f32x4*)(GOL + g * 128 + 32 * p + 8 * fq), g1 = *(const LAS f32x4*)(GOL + g * 128 + 32 * p + 8 * fq + 4); const u32x4 x = yv[g][p];
            u32x4 o; o.x = pk2(bflo(x.x) * r * g0.x, bfhi(x.x) * r * g0.y); o.y = pk2(bflo(x.y) * r * g0.z, bfhi(x.y) * r * g0.w); o.z = pk2(bflo(x.z) * r * g1.x, bfhi(x.z) * r * g1.y); o.w = pk2(bflo(x.w) * r * g1.z, bfhi(x.w) * r * g1.w);
            *(u32x4*)(py + g * 128 + 32 * p) = o; }
}

DI void mlstm_scan(const Frame& F) {
    unsigned char* ws = F.ws;
    const int gt = (F.vcu * 8 + F.wave) * 64 + F.lane, NGT = F.G * 512;
    constexpr int PER_BH = 128 * 64;
    for (int it = gt; it < 16 * PER_BH; it += NGT) {
        const int bh = it / PER_BH, rem = it % PER_BH, b = bh >> 2, h = bh & 3;
        const bool extra = rem < 64;
        const int XOFF = (64 + (rem >> 3)) * 128 + (rem & 7) - rem;
        const float* sc = (const float*)(ws + WS_SC) + (size_t)bh * NCH * 2;
        unsigned* st = (unsigned*)((bf16*)(ws + WS_ST) + ((size_t)(b * NCH) * 4 + h) * 144 * 128) + rem;
        float* mp = (float*)(ws + WS_MP);
        float c0 = 0.f, c1 = 0.f, n0 = 0.f, n1 = 0.f, m = 0.f;
        unsigned x[16], y[16], xn[16], yn[16];
#pragma unroll
        for (int j = 0; j < 16; ++j) { x[j] = st[(size_t)j * 36864]; y[j] = extra ? st[(size_t)j * 36864 + XOFF] : 0u; }
#pragma unroll 1
        for (int cb = 0; cb < NCH; cb += 16) {
            const int nb = (cb + 16 < NCH) ? cb + 16 : cb;
#pragma unroll
            for (int j = 0; j < 16; ++j) { xn[j] = st[(size_t)(nb + j) * 36864]; yn[j] = extra ? st[(size_t)(nb + j) * 36864 + XOFF] : 0u; }
#pragma unroll
            for (int j = 0; j < 16; ++j) { const int c = cb + j; const float bend = sc[2 * c], mloc = sc[2 * c + 1];
                const float mn = fmaxf(bend + m, mloc), a = fexp(bend + m - mn), s = fexp(mloc - mn);
                const unsigned oc = pk2(c0, c1), on = pk2(n0, n1); const float om = m;
                c0 = a * c0 + s * bflo(x[j]); c1 = a * c1 + s * bfhi(x[j]); n0 = a * n0 + s * bflo(y[j]); n1 = a * n1 + s * bfhi(y[j]); m = mn;
                x[j] = oc; y[j] = on; if (rem == 0) mp[(size_t)(b * NCH + c) * 4 + h] = om; }
#pragma unroll
            for (int j = 0; j < 16; ++j) { st[(size_t)(cb + j) * 36864] = x[j]; if (extra) st[(size_t)(cb + j) * 36864 + XOFF] = y[j]; }
#pragma unroll
            for (int j = 0; j < 16; ++j) { x[j] = xn[j]; y[j] = yn[j]; }
        }
    }
}

constexpr int L_CP = 70656;
constexpr int L_VT_D = 109824, L_P = 0, L_SD = 9216, L_HM = L_Q;
constexpr int L_PAR = 12288;
DI void mlstm_out_stage_params(const Frame& F, const Mix& M) { LAS float* P = (LAS float*)(F.lds + L_PAR); P[F.tid] = M.mhg[F.tid]; P[512 + F.tid] = M.skip[F.tid]; }
struct OutLoads { u32x4 q[2], k[2], v[2], c[5], xc[2]; u32x2 og[4]; float bt, g, mprev; };
DI void mlstm_out_issue(const Frame& F, const Mix& M, int u, int h, OutLoads& R) {
    const int tid = F.tid, lane = F.lane, w = F.wave, fr = lane & 15, fq = lane >> 4; unsigned char* ws = F.ws;
    const size_t uh = (size_t)u * 4 + h; const int t0 = u * CH;
    const bf16* qg = (const bf16*)(ws + WS_QG) + uh * 8192; const bf16* kg = (const bf16*)(ws + WS_KG) + uh * 8192; const bf16* vg = (const bf16*)(ws + WS_VG) + uh * 8192;
    const bf16* cp = (const bf16*)(ws + WS_ST) + uh * 144 * 128;
#pragma unroll
    for (int i = 0; i < 2; ++i) { const int p = tid + 512 * i; R.q[i] = *(const u32x4*)(qg + p * 8); R.k[i] = *(const u32x4*)(kg + p * 8); R.v[i] = *(const u32x4*)(vg + p * 8); }
#pragma unroll
    for (int i = 0; i < 5; ++i) { const int p = tid + 512 * i; R.c[i] = (u32x4){0u, 0u, 0u, 0u}; if (p < 72 * 32) R.c[i] = *(const u32x4*)(cp + p * 8); }
    { const int tt = w & 3, vh = w >> 2, t = 16 * tt + fr; const bf16* og = M.proj + (size_t)(t0 + t) * DIN + 512 + h * 128 + 64 * vh + 4 * fq;
#pragma unroll
      for (int j = 0; j < 4; ++j) R.og[j] = *(const u32x2*)(og + 16 * j); }
    { const int t = tid >> 3, v0 = 16 * (tid & 7); const bf16* xcp = (const bf16*)(ws + WS_XCG) + uh * 8192 + (size_t)t * 128 + v0; R.xc[0] = *(const u32x4*)(xcp); R.xc[1] = *(const u32x4*)(xcp + 8); }
    R.bt = 0.f; R.g = 0.f; R.mprev = 0.f;
    if (w == 0) { const float* gb = (const float*)(ws + WS_GB) + uh * 128; R.bt = gb[lane]; R.g = gb[64 + lane]; R.mprev = ((const float*)(ws + WS_MP))[uh]; }
}
DI void mlstm_out_item(const Frame& F, const Mix& M, int u, int h, const OutLoads& R, bool has_next, int un, int hn, OutLoads& RN) {
    LAS unsigned char* lds = F.lds; const int tid = F.tid, lane = F.lane, w = F.wave, fr = lane & 15, fq = lane >> 4;
    const int t0 = u * CH;
    LAS float* AT = (LAS float*)(lds + L_SD); LAS float* DF = AT + 64; LAS float* EG = AT + 128; LAS float* MT = AT + 448;
    const LAS float* PAR = (const LAS float*)(lds + L_PAR);
    bf16* Y = (bf16*)(F.ws + WS_Y);
#pragma unroll
    for (int i = 0; i < 2; ++i) { const int p = tid + 512 * i, tile = p >> 5, rem = p & 31;
        { const int row = 16 * (tile >> 3) + (rem >> 1), col = 16 * (tile & 7) + 8 * (rem & 1);
          *(LAS u32x4*)(lds + L_Q + row * S128 + col * 2) = R.q[i]; *(LAS u32x4*)(lds + L_K + row * S128 + col * 2) = R.k[i]; }
        { const int row = 16 * (tile >> 2) + (rem >> 1), col = 16 * (tile & 3) + 8 * (rem & 1);
          *(LAS u32x4*)(lds + L_VT_D + row * S64 + col * 2) = R.v[i]; } }
#pragma unroll
    for (int i = 0; i < 5; ++i) { const int p = tid + 512 * i; if (p < 72 * 32) { const int tile = p >> 5, rem = p & 31, row = 16 * (tile >> 3) + (rem >> 1), col = 16 * (tile & 7) + 8 * (rem & 1);
        *(LAS u32x4*)(lds + L_CP + row * S128 + col * 2) = R.c[i]; } }
    if (tid < 16 * 8) { const int row = 128 + (tid >> 3), c = tid & 7; const unsigned v = (row == 128) ? 0x3f803f80u : 0u; LAS unsigned* p = (LAS unsigned*)(lds + L_VT_D + row * S64 + c * 16); p[0] = v; p[1] = v; p[2] = v; p[3] = v; }
    if (w == 0) { float cm = R.g;
#pragma unroll
        for (int o = 1; o < 64; o <<= 1) { const float v = __shfl_up(cm, o); if (lane >= o) cm = fmaxf(cm, v); }
        const float Mt = fmaxf(R.mprev, cm);
        MT[lane] = Mt; AT[lane] = fexp(R.mprev - Mt); DF[lane] = fexp(-(R.bt + Mt)); EG[lane] = R.g; }
    u32x2 og[4]; u32x4 xc[2];
#pragma unroll
    for (int j = 0; j < 4; ++j) og[j] = R.og[j];
    xc[0] = R.xc[0]; xc[1] = R.xc[1];
    __syncthreads();
    if (has_next) mlstm_out_issue(F, M, un, hn, RN);
    { const int tt = w & 3, t = 16 * tt + fr; const float Mt = MT[t];
      bf16x8 bq[4];
#pragma unroll
      for (int ks = 0; ks < 4; ++ks) bq[ks] = ldf(lds + L_Q + t * S128 + (32 * ks + 8 * fq) * 2);
#pragma unroll
      for (int j = 0; j < 2; ++j) { const int st = 2 * (w >> 2) + j; f32x4 c = (f32x4){0.f, 0.f, 0.f, 0.f};
          if (st <= tt) {
#pragma unroll
              for (int ks = 0; ks < 4; ++ks) c = MFMA16(ldf(lds + L_K + (16 * st + fr) * S128 + (32 * ks + 8 * fq) * 2), bq[ks], c); }
          const int s0 = 16 * st + 4 * fq; const f32x4 gs = *(const LAS f32x4*)(EG + s0);
          float p[4];
#pragma unroll
          for (int r = 0; r < 4; ++r) p[r] = (s0 + r <= t) ? c[r] * fexp(gs[r] - Mt) : 0.f;
          u32x2 o; o.x = pk2(p[0], p[1]); o.y = pk2(p[2], p[3]); *(LAS u32x2*)(lds + L_P + t * S64 + s0 * 2) = o; } }
    __syncthreads();
    { const int tt = w & 3, vh = w >> 2, t = 16 * tt + fr;
      bf16x8 bp[2], bq[4];
#pragma unroll
      for (int ks = 0; ks < 2; ++ks) bp[ks] = ldf(lds + L_P + t * S64 + (32 * ks + 8 * fq) * 2);
#pragma unroll
      for (int ks = 0; ks < 4; ++ks) bq[ks] = ldf(lds + L_Q + t * S128 + (32 * ks + 8 * fq) * 2);
      f32x4 ci[5], cx[5];
#pragma unroll
      for (int j = 0; j < 5; ++j) { const int vt = (j < 4) ? 4 * vh + j : 8; ci[j] = (f32x4){0.f, 0.f, 0.f, 0.f}; cx[j] = ci[j];
#pragma unroll
          for (int ks = 0; ks < 2; ++ks) ci[j] = MFMA16(ldf(lds + L_VT_D + (16 * vt + fr) * S64 + (32 * ks + 8 * fq) * 2), bp[ks], ci[j]);
#pragma unroll
          for (int ks = 0; ks < 4; ++ks) cx[j] = MFMA16(ldf(lds + L_CP + (16 * vt + fr) * S128 + (32 * ks + 8 * fq) * 2), bq[ks], cx[j]); }
      const float at = AT[t];
      float den = ci[4][0] + at * cx[4][0];
      den = __shfl(den, fr);
      den = fmaxf(fabsf(den), DF[t]);
      const float rden = 1.0f / den;
      __syncthreads();
#pragma unroll
      for (int j = 0; j < 4; ++j) { const float o[4] = {bflo(og[j].x), bfhi(og[j].x), bflo(og[j].y), bfhi(og[j].y)}; f32x4 x;
#pragma unroll
          for (int r = 0; r < 4; ++r) x[r] = o[r] * (ci[j][r] + at * cx[j][r]) * rden;
          *(LAS f32x4*)(lds + L_HM + (t * 132 + 64 * vh + 16 * j + 4 * fq) * 4) = x; } }
    __syncthreads();
    { const int t = tid >> 3, part = tid & 7, v0 = 16 * part;
      float s1 = 0.f, s2 = 0.f;
#pragma unroll
      for (int i = 0; i < 4; ++i) { const f32x4 x = *(const LAS f32x4*)(lds + L_HM + (t * 132 + v0 + 4 * i) * 4); s1 += (x.x + x.y) + (x.z + x.w); s2 += (x.x * x.x + x.y * x.y) + (x.z * x.z + x.w * x.w); }
      s1 += __shfl_xor(s1, 1); s1 += __shfl_xor(s1, 2); s1 += __shfl_xor(s1, 4); s2 += __shfl_xor(s2, 1); s2 += __shfl_xor(s2, 2); s2 += __shfl_xor(s2, 4);
      const float mu = s1 * (1.0f / 128.0f), var = fmaxf(s2 * (1.0f / 128.0f) - mu * mu, 0.f), rstd = __builtin_amdgcn_rsqf(var + EPS);
#pragma unroll
      for (int half = 0; half < 2; ++half) { const int c0 = h * 128 + v0 + 8 * half; const u32x4 xcv = xc[half];
          const f32x4 xa = *(const LAS f32x4*)(lds + L_HM + (t * 132 + v0 + 8 * half) * 4), xb = *(const LAS f32x4*)(lds + L_HM + (t * 132 + v0 + 8 * half + 4) * 4);
          const f32x4 ga = *(const LAS f32x4*)(PAR + c0), gb = *(const LAS f32x4*)(PAR + c0 + 4), sa = *(const LAS f32x4*)(PAR + 512 + c0), sb = *(const LAS f32x4*)(PAR + 512 + c0 + 4);
          u32x4 o; o.x = pk2((xa.x - mu) * rstd * ga.x + sa.x * bflo(xcv.x), (xa.y - mu) * rstd * ga.y + sa.y * bfhi(xcv.x));
          o.y = pk2((xa.z - mu) * rstd * ga.z + sa.z * bflo(xcv.y), (xa.w - mu) * rstd * ga.w + sa.w * bfhi(xcv.y));
          o.z = pk2((xb.x - mu) * rstd * gb.x + sb.x * bflo(xcv.z), (xb.y - mu) * rstd * gb.y + sb.y * bfhi(xcv.z));
          o.w = pk2((xb.z - mu) * rstd * gb.z + sb.z * bflo(xcv.w), (xb.w - mu) * rstd * gb.w + sb.w * bfhi(xcv.w));
          *(u32x4*)(Y + (size_t)(t0 + t) * D + c0) = o; } }
    __syncthreads();
}
DI void mlstm_out_phase(const Frame& F, const Mix& M) {
    mlstm_out_stage_params(F, M);
    int u = F.vcu, h = 0;
    if (u >= NU) return;
    OutLoads R, RN;
    mlstm_out_issue(F, M, u, h, R);
#pragma unroll 1
    for (;;) {
        int un = u, hn = h + 1; if (hn == 4) { hn = 0; un = u + F.G; } const bool hn_ok = un < NU;
        mlstm_out_item(F, M, u, h, R, hn_ok, un, hn, RN);
        if (!hn_ok) break;
        u = un; h = hn; R = RN;
    }
}

DI void route_tokens(const Frame& F, const Args& a) {
    LAS unsigned char* lds = F.lds; const int tid = F.tid, lane = F.lane, w = F.wave, ti = lane & 15, kq = lane >> 4;
    unsigned char* ws = F.ws;
    constexpr int WP = 2048 + 64;
    LAS unsigned char* WH = lds; LAS unsigned char* WL = lds + 8 * WP;
    LAS int* CNTL = (LAS int*)(lds + 16 * WP);
    const bf16* xb = (const bf16*)(ws + WS_XB);
    for (int i = tid; i < 8 * 1024; i += 512) { const int e = i >> 10, c = i & 1023; const float wv = a.in[I_ROUTER][c * 8 + e] * a.in[I_FFNG][D + c];
        const unsigned hi = f2bf(wv), lo = f2bf(wv - __builtin_bit_cast(float, hi << 16));
        *(LAS bf16*)(WH + e * WP + c * 2) = (bf16)hi; *(LAS bf16*)(WL + e * WP + c * 2) = (bf16)lo; }
    if (tid < 16) CNTL[tid] = 0;
    __syncthreads();
    const int TPW = (T + F.G - 1) / F.G, tb = F.vcu * TPW, te = (tb + TPW < T) ? tb + TPW : T;
#pragma unroll 1
    for (int t0 = tb + 16 * w; t0 < te; t0 += 128) {
        const int t = t0 + ti; const bool ok = t < te;
        u32x4 x[16][2];
#pragma unroll
        for (int u = 0; u < 16; ++u)
#pragma unroll
            for (int h = 0; h < 2; ++h) { x[u][h] = (u32x4){0u, 0u, 0u, 0u}; if (ok) x[u][h] = *(const u32x4*)(xb + (size_t)t * D + 64 * u + 16 * kq + 8 * h); }
        f32x4 acc = (f32x4){0.f, 0.f, 0.f, 0.f}; float ss = 0.f;
        const LAS unsigned char* wh = WH + (ti & 7) * WP + 32 * kq; const LAS unsigned char* wl = WL + (ti & 7) * WP + 32 * kq;
#pragma unroll
        for (int u = 0; u < 16; ++u)
#pragma unroll
            for (int h = 0; h < 2; ++h) { const bf16x8 xa = __builtin_bit_cast(bf16x8, x[u][h]);
                acc = MFMA16(ldf(wh + 128 * u + 16 * h), xa, acc); acc = MFMA16(ldf(wl + 128 * u + 16 * h), xa, acc);
#pragma unroll
                for (int c = 0; c < 4; ++c) { const float p = bflo(x[u][h][c]), q = bfhi(x[u][h][c]); ss += p * p + q * q; }
                __builtin_amdgcn_sched_barrier(0); }
        ss += __shfl_xor(ss, 16); ss += __shfl_xor(ss, 32);
        const float r = 1.0f / sqrtf(ss * (1.0f / D) + EPS);
        float lg[8];
#pragma unroll
        for (int i = 0; i < 4; ++i) { const float o = __shfl_xor(acc[i], 16); lg[i] = ((kq & 1) ? o : acc[i]) * r; lg[4 + i] = ((kq & 1) ? acc[i] : o) * r; }
        int i0 = 0; float l0 = lg[0];
#pragma unroll
        for (int e = 1; e < 8; ++e) if (lg[e] > l0) { l0 = lg[e]; i0 = e; }
        int i1 = -1; float l1 = -3.0e38f;
#pragma unroll
        for (int e = 0; e < 8; ++e) if (e != i0 && lg[e] > l1) { l1 = lg[e]; i1 = e; }
        if (i1 < 0) { i1 = i0 == 0 ? 1 : 0; l1 = lg[i0 == 0 ? 1 : 0]; }
        const float g0 = 1.0f / (1.0f + expf(l1 - l0));
        if (ok && kq == 0) { ((int*)(ws + WS_TOPI))[t * 2] = i0; ((int*)(ws + WS_TOPI))[t * 2 + 1] = i1; ((float*)(ws + WS_TOPG))[t * 2] = g0; ((float*)(ws + WS_TOPG))[t * 2 + 1] = 1.0f - g0;
            atomicAdd((int*)&CNTL[i0], 1); atomicAdd((int*)&CNTL[8 + i1], 1); }
        if (ok) {
            unsigned char* o8 = ws + WS_XR8 + (size_t)t * D + 16 * kq;
#pragma unroll
            for (int u = 0; u < 16; ++u) { u32x4 o;
#pragma unroll
                for (int h = 0; h < 2; ++h) { u32x4 xv = x[u][h]; asm volatile("" : "+v"(xv.x), "+v"(xv.y), "+v"(xv.z), "+v"(xv.w));
                    int w0 = __builtin_amdgcn_cvt_pk_fp8_f32(bflo(xv.x) * r, bfhi(xv.x) * r, 0, false); w0 = __builtin_amdgcn_cvt_pk_fp8_f32(bflo(xv.y) * r, bfhi(xv.y) * r, w0, true);
                    int w1 = __builtin_amdgcn_cvt_pk_fp8_f32(bflo(xv.z) * r, bfhi(xv.z) * r, 0, false); w1 = __builtin_amdgcn_cvt_pk_fp8_f32(bflo(xv.w) * r, bfhi(xv.w) * r, w1, true);
                    o[2 * h] = (unsigned)w0; o[2 * h + 1] = (unsigned)w1; }
                *(u32x4*)(o8 + 64 * u) = o; } }
    }
    __syncthreads();
    if (tid < 16) ((int*)(ws + WS_CNT))[F.vcu * 16 + tid] = CNTL[tid];
}
DI void route_scatter(const Frame& F) {
    LAS unsigned char* lds = F.lds; const int tid = F.tid;
    unsigned char* ws = F.ws;
    LAS int* TOT = (LAS int*)lds; LAS int* BASE = TOT + 16; LAS int* SEG = TOT + 32; LAS int* NTK = TOT + 48; LAS int* EL = TOT + 64;
    const int* cnt = (const int*)(ws + WS_CNT);
    { LAS int* PT = TOT + 64 + 1024; LAS int* PB = PT + 512;
      const int k = tid & 15, q = tid >> 4, per = (F.G + 31) / 32; int tot = 0, base = 0;
      for (int i = 0; i < per; ++i) { const int g = q * per + i; if (g < F.G) { const int c = cnt[g * 16 + k]; tot += c; if (g < F.vcu) base += c; } }
      PT[q * 16 + k] = tot; PB[q * 16 + k] = base; }
    __syncthreads();
    if (tid < 16) { LAS int* PT = TOT + 64 + 1024; LAS int* PB = PT + 512; int tot = 0, base = 0;
#pragma unroll
        for (int q = 0; q < 32; ++q) { tot += PT[q * 16 + tid]; base += PB[q * 16 + tid]; }
        TOT[tid] = tot; BASE[tid] = base; }
    __syncthreads();
    if (tid < 2) { int off = 0; for (int e = 0; e < 8; ++e) { SEG[tid * 8 + e] = off; off += (TOT[tid * 8 + e] + 255) & ~255; } NTK[tid] = off >> 8; }
    __syncthreads();
    int* rowtok = (int*)(ws + WS_ROWTOK); float* rowgate = (float*)(ws + WS_ROWGATE); int* tile = (int*)(ws + WS_TILE);
    if (F.vcu == 0) {
        for (int k = 0; k < 2; ++k) {
            if (tid == 0) tile[k * 256] = NTK[k];
            if (tid < NTK[k]) { int e = 0; for (int j = 1; j < 8; ++j) if (tid * 256 >= SEG[k * 8 + j]) e = j; tile[k * 256 + 1 + tid] = e; }
            for (int e = 0; e < 8; ++e) { const int tot = TOT[k * 8 + e], r = tot + tid; if (tid < 256 && r < ((tot + 255) & ~255)) { rowtok[k * MAXRT * 256 + SEG[k * 8 + e] + r] = -1; rowgate[k * MAXRT * 256 + SEG[k * 8 + e] + r] = 0.f; } }
        }
    }
    const int TPW = (T + F.G - 1) / F.G, tb = F.vcu * TPW, t = tb + tid; const bool act = tid < TPW && t < T;
    const int* topi = (const int*)(ws + WS_TOPI); const float* topg = (const float*)(ws + WS_TOPG);
    int e0 = -1, e1 = -1; if (act) { e0 = topi[t * 2]; e1 = topi[t * 2 + 1]; }
    EL[tid] = e0; EL[512 + tid] = e1;
    __syncthreads();
    if (act) { int r0 = 0, r1 = 0; for (int j = 0; j < tid; ++j) { r0 += (EL[j] == e0); r1 += (EL[512 + j] == e1); }
        const int p0 = SEG[e0] + BASE[e0] + r0, p1 = SEG[8 + e1] + BASE[8 + e1] + r1;
        rowtok[p0] = t; rowgate[p0] = topg[t * 2]; rowtok[MAXRT * 256 + p1] = t; rowgate[MAXRT * 256 + p1] = topg[t * 2 + 1]; }
}
DI void final_norm(const Frame& F, const Args& a) {
    const int gw = F.vcu * 8 + F.wave, NGW = F.G * 8, lane = F.lane;
    const bf16* xb = (const bf16*)(F.ws + WS_XB);
    f32x4 g[2][2];
#pragma unroll
    for (int jj = 0; jj < 2; ++jj) { g[jj][0] = *((const f32x4*)a.in[I_FING] + 128 * jj + 2 * lane); g[jj][1] = *((const f32x4*)a.in[I_FING] + 128 * jj + 2 * lane + 1); }
    for (int m0 = gw * 4; m0 < T; m0 += NGW * 4) {
        u32x4 v[4][2];
#pragma unroll
        for (int r = 0; r < 4; ++r)
#pragma unroll
            for (int jj = 0; jj < 2; ++jj) v[r][jj] = *((const u32x4*)(xb + (size_t)(m0 + r) * D) + lane + 64 * jj);
#pragma unroll
        for (int r = 0; r < 4; ++r) { float x[2][8]; float s = 0.f;
#pragma unroll
            for (int jj = 0; jj < 2; ++jj)
#pragma unroll
                for (int c = 0; c < 4; ++c) { x[jj][2 * c] = bflo(v[r][jj][c]); x[jj][2 * c + 1] = bfhi(v[r][jj][c]); }
#pragma unroll
            for (int jj = 0; jj < 2; ++jj) s += ((x[jj][0] * x[jj][0] + x[jj][1] * x[jj][1]) + (x[jj][2] * x[jj][2] + x[jj][3] * x[jj][3])) + ((x[jj][4] * x[jj][4] + x[jj][5] * x[jj][5]) + (x[jj][6] * x[jj][6] + x[jj][7] * x[jj][7]));
            s = wave_sum(s); const float rs = 1.0f / sqrtf(s * (1.0f / D) + EPS);
            f32x4* o = (f32x4*)(a.out + (size_t)(m0 + r) * D) + 2 * lane;
#pragma unroll
            for (int jj = 0; jj < 2; ++jj) { __builtin_nontemporal_store((f32x4){x[jj][0], x[jj][1], x[jj][2], x[jj][3]} * rs * g[jj][0], o + 128 * jj); __builtin_nontemporal_store((f32x4){x[jj][4], x[jj][5], x[jj][6], x[jj][7]} * rs * g[jj][1], o + 128 * jj + 1); } }
    }
}

#ifndef MK_PER_PHASE
#define MK_PER_PHASE 0
#endif
constexpr int N_PHASES = 21;
#ifndef PH_MASK
#define PH_MASK 0xFFFFFFFFu
#endif
#define PH_ON(k) && ((PH_MASK >> (k)) & 1u)
#ifndef REP_MASK
#define REP_MASK 0u
#endif
#ifndef REP_N
#define REP_N 2
#endif
#define REPS(k) for (int _rep = 0; _rep < 1 + (((REP_MASK >> (k)) & 1u) ? REP_N : 0); ++_rep)
DI int bxo() { int b = (int)blockIdx.x; asm volatile("" : "+s"(b)); return b; }
__global__ void __launch_bounds__(512, 2) trunk_fwd(Args args) {
    extern __shared__ __attribute__((aligned(16))) unsigned char lds_raw[];
    Frame F;
    F.lds = (LAS unsigned char*)lds_raw;
    const int wv0 = __builtin_amdgcn_readfirstlane((int)threadIdx.x >> 6);
    F.lane = lane_asm(); F.wave = wv0; F.tid = wv0 * 64 + F.lane;
    F.G = gridDim.x; { const int bx = blockIdx.x; F.vcu = (F.G % 8 == 0) ? (bx % 8) * (F.G / 8) + bx / 8 : bx; }
    F.ws = args.ws;
    volatile LAS unsigned* MISC = (volatile LAS unsigned*)(F.lds + MISC_OFF);
    for (int u = F.tid; u < (LDS_BYTES - MISC_OFF) / 4; u += 512) MISC[u] = 0u;
    __syncthreads();
    XcdBarrier bar; bar.bar = (unsigned*)(F.ws + WS_CTL) + CW_BAR; bar.x = 0; bar.st = nullptr; bar.wv = wv0;
    if (!MK_PER_PHASE) bar = xcd_barrier_post((unsigned*)(F.ws + WS_CTL) + CW_BAR, MISC + 8, wv0);
    const int lo = args.ph_lo, hi = args.ph_hi;
#define IN(k) (lo <= (k) && (k) < hi)
#define REFRESH() do { const int _l = lane_asm(); int _w = wv0; asm volatile("" : "+s"(_w)); F.lane = _l; F.wave = _w; F.tid = _w * 64 + _l; } while (0)
#define SEAM(k) do { if (IN(k) && IN((k) + 1)) xcd_barrier(bar); } while (0)
    unsigned char* ws = F.ws;
    bf16* xb = (bf16*)(ws + WS_XB); float* ssq = (float*)(ws + WS_SSQ);

    if (IN(0) PH_ON(0)) REPS(0) { REFRESH(); p0_prologue(F, args); __syncthreads(); }
    SEAM(0);
    for (int l = 0; l < 2; ++l) {
        const int pb = 1 + 8 * l;
        Mix M; M.l = l; M.proj = (const bf16*)(ws + WS_PROJ);
        M.convw = args.in[I_CONVW] + l * 4 * 512; M.convb = args.in[I_CONVB] + l * 512; M.bif = args.in[I_BIF] + l * 8; M.skip = args.in[I_SKIP] + l * 512; M.mhg = args.in[I_MHG] + l * 512;
        M.gmvg = args.in[I_GMVG] + l * 512; M.bsp = args.in[I_BSP] + l * 512; M.gmog = args.in[I_GMOG] + l * 512;
        M.wg = (const bf16*)(ws + WS_WG) + (size_t)l * 16 * 1024; M.wq = (const bf16*)(ws + WS_WQ); M.wk = M.wq + 8 * 128 * 128; M.wv = M.wq + 16 * 128 * 128; M.wsp = (const bf16*)(ws + WS_WSP);
        if (IN(pb) PH_ON(1)) REPS(1) { pg8::Gemm g{xb, (const bf16*)(ws + WS_WIN) + (size_t)l * DIN * D, D, 0, nullptr}; pg8::StaticOrder S; S.init(T, DIN, F.G, bxo());
            EpiIn E{(bf16*)(ws + WS_PROJ), ssq, F.lds, (float*)(ws + WS_VST), false}; pg8::gemm_phase<EpiIn, pg8::StaticOrder, false>(F.lds, g, S, E, F.wave); }
        SEAM(pb);
        if (IN(pb + 1) PH_ON(2)) REPS(2) { REFRESH(); __syncthreads(); if (l == 0) { dense_quant(F, args); __syncthreads(); } { LAS float* CWL = (LAS float*)(F.lds + L3_CW); for (int i = F.tid; i < 2560; i += 512) CWL[i] = i < 2048 ? M.convw[i] : M.convb[i - 2048]; } __syncthreads();
            REPS(21) for (int u = F.vcu; u < NU; u += F.G) mlstm_local3(F, M, u);
            REFRESH();
            REPS(20) for (int ub = F.vcu; ub < T / 128; ub += F.G) { __syncthreads(); gmlp_unit(F, M, ub); } }
        SEAM(pb + 1);
        if (IN(pb + 2) PH_ON(3)) { REFRESH(); mlstm_scan(F); }
        SEAM(pb + 2);
        if (IN(pb + 3) PH_ON(4)) REPS(4) { REFRESH(); __syncthreads(); mlstm_out_phase(F, M); }
        SEAM(pb + 3);
        if (IN(pb + 4) PH_ON(5)) {
            const bool split = l == 1 && (F.G % 16 == 0); const int bx_ = bxo(), slot_ = bx_ >> 3, x_ = bx_ & 7;
            if (!split || (slot_ & 1) == 0) { const int gg = split ? F.G / 2 : F.G, gc = split ? (slot_ >> 1) * 8 + x_ : bx_;
                pg8::Gemm g{(const bf16*)(ws + WS_Y), (const bf16*)(ws + WS_WOUT) + (size_t)l * D * D, D, 0, nullptr}; pg8::StaticOrder S; S.init(T, D, gg, gc);
                EpiResT<true> E{nullptr, xb, ssq, F.lds}; pg8::gemm_phase<EpiResT<true>, pg8::StaticOrder, false>(F.lds, g, S, E, F.wave); }
            else { REFRESH(); __syncthreads(); moe_weights(F, args, x_ * (F.G / 16) + (slot_ >> 1), F.G / 2); __syncthreads(); }
            if (l == 1 && !split) { REFRESH(); __syncthreads(); moe_weights(F, args, F.vcu, F.G); __syncthreads(); } }
        SEAM(pb + 4);
        if (l == 0) {
            if (IN(6) PH_ON(6)) { REFRESH(); rows_to_int8(F); }
            SEAM(6);
            if (IN(7) PH_ON(6)) REPS(6) { pg8::Gemm g{(const bf16*)(ws + WS_XB8D), (const bf16*)(ws + WS_W13), D / 2, 0, nullptr}; pg8::StaticOrder S; S.init(T, 2 * DFFP, F.G, bxo());
                EpiGluI8T<true> E{(bf16*)(ws + WS_HID), DFFP, (const float*)(ws + WS_SA), (const float*)(ws + WS_SWD), nullptr, 0u, F.lds}; pg8::gemm_phase<EpiGluI8T<true>, pg8::StaticOrder, false, 1>(F.lds, g, S, E, F.wave); }
            SEAM(7);
            if (IN(8) PH_ON(7)) { pg8::Gemm g{(const bf16*)(ws + WS_HID), (const bf16*)(ws + WS_W2), DFFP / 2, 0, nullptr}; pg8::StaticOrder S; S.init(T, D, F.G, bxo());
                EpiResT<true> E{nullptr, xb, ssq, F.lds}; pg8::gemm_phase<EpiResT<true>, pg8::StaticOrder, false, 2>(F.lds, g, S, E, F.wave); }
            SEAM(8);
        }
    }
    if (IN(14) PH_ON(13)) REPS(13) { REFRESH(); __syncthreads(); route_tokens(F, args); }
    SEAM(14);
    if (IN(15) PH_ON(14)) { REFRESH(); route_scatter(F); }
    SEAM(15);
    {
        const int* tile0 = (const int*)(ws + WS_TILE); const int* tile1 = tile0 + 256;
        const int S0 = __builtin_amdgcn_readfirstlane(tile0[0]), S1 = __builtin_amdgcn_readfirstlane(tile1[0]);
        unsigned* hidcnt = (unsigned*)(ws + WS_CTL) + CW_HID;
        for (int ph = 0; ph < 4; ++ph) {
            if (IN(16 + ph) PH_ON(15)) {
                int prev_units = 0;
                if (ph >= 1) {
                    const int p = ph - 1, k = p == 0 ? 0 : 1, first = p == 2 ? S1 - 64 : 0, nM = p == 0 ? S0 : (p == 1 ? S1 - 64 : 64), hid0 = p == 2 ? 72 : 0;
                    const int* rowtok = (const int*)(ws + WS_ROWTOK) + k * MAXRT * 256; const float* rowgate = (const float*)(ws + WS_ROWGATE) + k * MAXRT * 256;
                    pg8::Gemm g{(const bf16*)(ws + WS_MHID), (const bf16*)(ws + WS_MW2), DFE / 2, (size_t)D * DFE / 2, nullptr}; pg8::MoeOrder S; S.init(k ? tile1 : tile0, first, nM, hid0, D, F.G, bxo(), 0, 0);
                    EpiMoe2 E{xb, rowtok, rowgate, hidcnt, F.lds}; pg8::gemm_phase<EpiMoe2, pg8::MoeOrder, false, 2>(F.lds, g, S, E, F.wave);
                    prev_units = nM * (D / 256);
                }
                if (ph <= 2) {
                    const int p = ph, k = p == 0 ? 0 : 1, first = p == 2 ? S1 - 64 : 0, nM = p == 0 ? S0 : (p == 1 ? S1 - 64 : 64), hid0 = p == 2 ? 72 : 0;
                    const int* rowtok = (const int*)(ws + WS_ROWTOK) + k * MAXRT * 256;
                    pg8::Gemm g{(const bf16*)(ws + WS_XR8), (const bf16*)(ws + WS_MW13), D / 2, (size_t)2 * DFE * (D / 2), rowtok}; pg8::MoeOrder S; S.init(k ? tile1 : tile0, first, nM, hid0, 2 * DFE, F.G, bxo(), prev_units, 3);
                    EpiGluF8 E{ws + WS_MHID, DFE, hidcnt, p == 1 ? 4u : 0u}; pg8::gemm_phase<EpiGluF8, pg8::MoeOrder, true, 2>(F.lds, g, S, E, F.wave);
                }
            }
            SEAM(16 + ph);
        }
    }
    if (IN(20) PH_ON(19)) { REFRESH(); final_norm(F, args); }
#undef IN
#undef SEAM
}

extern "C" void kernel_launch(void* const* d_in, const int* in_sizes, int n_in, void* d_out, int out_size, void* d_ws, size_t ws_size, hipStream_t stream) {
    static int grid = 0;
    if (grid == 0) {
        if (n_in != 26 || in_sizes[0] != T * D || out_size != T * D || ws_size < WS_END) { fprintf(stderr, "kernel_launch: unexpected shapes / workspace (n_in %d, ws %zu < %zu)\n", n_in, ws_size, (size_t)WS_END); grid = -1; return; }
        int dev = 0, cus = 0, per_cu = 0;
        if (hipGetDevice(&dev) != hipSuccess || hipDeviceGetAttribute(&cus, hipDeviceAttributeMultiprocessorCount, dev) != hipSuccess) { grid = -1; return; }
        if (hipFuncSetAttribute((const void*)trunk_fwd, hipFuncAttributeMaxDynamicSharedMemorySize, LDS_BYTES) != hipSuccess) { fprintf(stderr, "kernel_launch: hipFuncSetAttribute failed\n"); grid = -1; return; }
        if (hipOccupancyMaxActiveBlocksPerMultiprocessor(&per_cu, (const void*)trunk_fwd, 512, LDS_BYTES) != hipSuccess || per_cu < 1) { fprintf(stderr, "kernel_launch: occupancy query says %d\n", per_cu); }
        (void)hipGetLastError();
        grid = cus;
    }
    if (grid < 0) return;
    (void)hipMemsetAsync((char*)d_ws + WS_CTL, 0, CTL_ZERO_BYTES, stream);
    Args a{};
    for (int i = 0; i < 26; ++i) a.in[i] = (const float*)d_in[i];
    a.out = (float*)d_out; a.ws = (unsigned char*)d_ws;
#if MK_PER_PHASE
    for (int p = 0; p < N_PHASES; ++p) { a.ph_lo = p; a.ph_hi = p + 1; hipLaunchKernelGGL(trunk_fwd, dim3(grid), dim3(512), LDS_BYTES, stream, a); }
#else
    a.ph_lo = 0; a.ph_hi = N_PHASES;
    hipLaunchKernelGGL(trunk_fwd, dim3(grid), dim3(512), LDS_BYTES, stream, a);
#endif
}
```
